# Optimizing an MI355X kernel written in HIP

```python
import jax
import jax.numpy as jnp
from jax import lax
import numpy as np

D_MODEL = 2048
BATCH = 4
SEQ = 4096
DEPTH = 1

CONV_DIM = D_MODEL
CONV_WIDTH = 3
HEAD_DIM = 128
N_HEADS = D_MODEL // HEAD_DIM
N_KV_HEADS = 4
ROT_DIM = HEAD_DIM // 4
IDX_HEADS = 16
IDX_DIM = 64
IDX_ROT_DIM = IDX_DIM // 4
TOPK_MAX = 256
Q_BLOCK = 128
ROPE_THETA = 500000.0
MEM_LEN = 256
X_HEADS = 4
X_HEAD_DIM = 128
N_EXPERTS = 32
TOP_K_EXPERTS = 4
D_FF = D_MODEL
SWIGLU_LIMIT = 7.0
SWIGLU_ALPHA = 1.702
EXPERT_BLOCK = 256
NORM_EPS = 1e-6
MAX_POS_OFFSET = 1024

IN_SPLITS = (CONV_DIM, CONV_DIM, CONV_DIM, N_HEADS * HEAD_DIM, N_KV_HEADS * HEAD_DIM, N_KV_HEADS * HEAD_DIM, IDX_HEADS * IDX_DIM, IDX_DIM, IDX_HEADS, CONV_DIM, N_HEADS * HEAD_DIM)
D_IN = sum(IN_SPLITS)

kernel_name = 'hybrid_conv_dsa_memxattn_moe_block'


def rms_norm(x, g):
    x32 = x.astype(jnp.float32)
    y = x32 * lax.rsqrt(jnp.mean(x32 * x32, axis=-1, keepdims=True) + NORM_EPS)
    return (y * g.astype(jnp.float32)).astype(x.dtype)


def split_cols(z, sizes):
    outs, off = [], 0
    for n in sizes:
        outs.append(z[..., off:off + n])
        off += n
    return outs


def rope_partial(x, positions, rot_dim):
    half = rot_dim // 2
    inv_freq = jnp.float32(ROPE_THETA) ** (-(jnp.arange(half, dtype=jnp.float32) * 2.0 / rot_dim))
    ang = positions.astype(jnp.float32)[..., None] * inv_freq
    cos = jnp.cos(ang)[:, :, None, :]
    sin = jnp.sin(ang)[:, :, None, :]
    xr = x[..., :rot_dim].astype(jnp.float32)
    x1, x2 = xr[..., :half], xr[..., half:]
    rot = jnp.concatenate([x1 * cos - x2 * sin, x2 * cos + x1 * sin], axis=-1).astype(x.dtype)
    return jnp.concatenate([rot, x[..., rot_dim:]], axis=-1)


def causal_depthwise_conv(u, w):
    c = u.shape[-1]
    return lax.conv_general_dilated(
        u, w[:, None, :].astype(u.dtype), window_strides=(1,),
        padding=[(CONV_WIDTH - 1, 0)], dimension_numbers=('NWC', 'WIO', 'NWC'),
        feature_group_count=c)


def dsa_attention(q, k, v, q_idx, k_idx, w_idx):
    b, s = q.shape[0], q.shape[1]
    topk = min(TOPK_MAX, s // 4)
    nb = s // Q_BLOCK
    grp = N_HEADS // N_KV_HEADS
    key_pos = jnp.arange(s)
    scale = HEAD_DIM ** -0.5

    def to_blocks(t):
        return t.reshape((b, nb, Q_BLOCK) + t.shape[2:]).swapaxes(0, 1)

    def block(args):
        qb, qib, wb, start = args
        qpos = start + jnp.arange(Q_BLOCK)
        causal = key_pos[None, :] <= qpos[:, None]
        logits = jnp.einsum('bqhd,bsd->bqhs', qib, k_idx, preferred_element_type=jnp.float32)
        score = jnp.einsum('bqhs,bqh->bqs', jax.nn.relu(logits), wb.astype(jnp.float32))
        score = jnp.where(causal[None], score, -jnp.inf)
        _, sel = lax.top_k(score, topk)
        kg = jax.vmap(lambda kk, ii: kk[ii])(k, sel)
        vg = jax.vmap(lambda vv, ii: vv[ii])(v, sel)
        qg = qb.reshape(b, Q_BLOCK, N_KV_HEADS, grp, HEAD_DIM)
        att = jnp.einsum('bqgnd,bqkgd->bqgnk', qg, kg, preferred_element_type=jnp.float32) * scale
        valid = (sel <= qpos[None, :, None])[:, :, None, None, :]
        p = jax.nn.softmax(jnp.where(valid, att, -jnp.inf), axis=-1)
        o = jnp.einsum('bqgnk,bqkgd->bqgnd', p.astype(vg.dtype), vg)
        return o.reshape(b, Q_BLOCK, N_HEADS * HEAD_DIM)

    starts = jnp.arange(nb) * Q_BLOCK
    out = lax.map(block, (to_blocks(q), to_blocks(q_idx), to_blocks(w_idx), starts))
    return out.swapaxes(0, 1).reshape(b, s, N_HEADS * HEAD_DIM)


def memory_cross_attention(h, mem_n, wq, wk, wv, wo):
    b, s = h.shape[0], h.shape[1]
    m = mem_n.shape[1]
    q = (h @ wq).reshape(b, s, X_HEADS, X_HEAD_DIM)
    k = (mem_n @ wk).reshape(b, m, X_HEADS, X_HEAD_DIM)
    v = (mem_n @ wv).reshape(b, m, X_HEADS, X_HEAD_DIM)
    att = jnp.einsum('bshd,bmhd->bhsm', q, k, preferred_element_type=jnp.float32) * (X_HEAD_DIM ** -0.5)
    p = jax.nn.softmax(att, axis=-1)
    o = jnp.einsum('bhsm,bmhd->bshd', p.astype(v.dtype), v).reshape(b, s, X_HEADS * X_HEAD_DIM)
    return o @ wo


def moe_ffn(xf, w_router, b_router, w_gu, b_gu, w_dn, b_dn):
    t, d = xf.shape
    logits = (xf @ w_router + b_router).astype(jnp.float32)
    top_val, top_idx = lax.top_k(logits, TOP_K_EXPERTS)
    gates = jax.nn.softmax(top_val, axis=-1)
    n_slots = t * TOP_K_EXPERTS
    flat_e = top_idx.reshape(-1)
    flat_tok = jnp.arange(n_slots, dtype=jnp.int32) // TOP_K_EXPERTS
    flat_g = gates.reshape(-1)
    order = jnp.argsort(flat_e)
    sorted_e = flat_e[order]
    counts = jnp.bincount(flat_e, length=N_EXPERTS)
    padded = (counts + EXPERT_BLOCK - 1) // EXPERT_BLOCK * EXPERT_BLOCK
    start = jnp.cumsum(counts) - counts
    pstart = jnp.cumsum(padded) - padded
    dest = pstart[sorted_e] + jnp.arange(n_slots) - start[sorted_e]
    n_blocks = -(-n_slots // EXPERT_BLOCK) + N_EXPERTS
    cap = n_blocks * EXPERT_BLOCK
    buf_tok = jnp.full((cap,), t, dtype=jnp.int32).at[dest].set(flat_tok[order])
    buf_g = jnp.zeros((cap,), jnp.float32).at[dest].set(flat_g[order])
    block_e = jnp.minimum(jnp.searchsorted(jnp.cumsum(padded), jnp.arange(n_blocks) * EXPERT_BLOCK, side='right'), N_EXPERTS - 1)
    x_pad = jnp.concatenate([xf, jnp.zeros((1, d), xf.dtype)], axis=0)

    def expert_block(args):
        tok, e = args
        xb = x_pad[tok]
        gu = xb @ w_gu[e] + b_gu[e]
        gate, up = gu[:, :D_FF], gu[:, D_FF:]
        gate = jnp.minimum(gate, SWIGLU_LIMIT)
        up = jnp.clip(up, -SWIGLU_LIMIT, SWIGLU_LIMIT)
        hdn = (up + 1.0) * (gate * jax.nn.sigmoid(SWIGLU_ALPHA * gate))
        return hdn @ w_dn[e] + b_dn[e]

    y = lax.map(expert_block, (buf_tok.reshape(n_blocks, EXPERT_BLOCK), block_e))
    y = y.reshape(cap, d) * buf_g[:, None].astype(y.dtype)
    return jax.ops.segment_sum(y, buf_tok, num_segments=t + 1)[:t]


def setup_inputs(seed: int = 0) -> dict:
    key = jax.random.key(seed)
    ks = jax.random.split(key, 24)
    f32 = jnp.float32
    L = DEPTH

    def nrm(k, shape, scale):
        return jax.random.normal(k, shape, f32) * scale

    def gain(k, shape):
        return 1.0 + 0.02 * jax.random.normal(k, shape, f32)

    x = nrm(ks[0], (BATCH, SEQ, D_MODEL), 1.0)
    mem = nrm(ks[1], (BATCH, MEM_LEN, D_MODEL), 1.0)
    positions = (jax.random.randint(ks[2], (BATCH, 1), 0, MAX_POS_OFFSET, dtype=jnp.int32)
                 + jnp.arange(SEQ, dtype=jnp.int32)[None, :]).astype(jnp.int32)
    return {
        'x': x,
        'mem': mem,
        'positions': positions,
        'norm_mix': gain(ks[3], (L, D_MODEL)),
        'w_in': nrm(ks[4], (L, D_MODEL, D_IN), D_MODEL ** -0.5),
        'conv_w': nrm(ks[5], (L, CONV_WIDTH, CONV_DIM), CONV_WIDTH ** -0.5),
        'w_out': nrm(ks[6], (L, D_MODEL, D_MODEL), D_MODEL ** -0.5),
        'norm_xattn': gain(ks[7], (L, D_MODEL)),
        'norm_mem': gain(ks[8], (L, D_MODEL)),
        'wq_x': nrm(ks[9], (L, D_MODEL, X_HEADS * X_HEAD_DIM), D_MODEL ** -0.5),
        'wk_x': nrm(ks[10], (L, D_MODEL, X_HEADS * X_HEAD_DIM), D_MODEL ** -0.5),
        'wv_x': nrm(ks[11], (L, D_MODEL, X_HEADS * X_HEAD_DIM), D_MODEL ** -0.5),
        'wo_x': nrm(ks[12], (L, X_HEADS * X_HEAD_DIM, D_MODEL), (X_HEADS * X_HEAD_DIM) ** -0.5),
        'norm_ffn': gain(ks[13], (L, D_MODEL)),
        'w_router': nrm(ks[14], (L, D_MODEL, N_EXPERTS), D_MODEL ** -0.5),
        'b_router': nrm(ks[15], (L, N_EXPERTS), 0.01),
        'w_gate_up': nrm(ks[16], (L, N_EXPERTS, D_MODEL, 2 * D_FF), D_MODEL ** -0.5),
        'b_gate_up': nrm(ks[17], (L, N_EXPERTS, 2 * D_FF), 0.01),
        'w_down': nrm(ks[18], (L, N_EXPERTS, D_FF, D_MODEL), D_FF ** -0.5),
        'b_down': nrm(ks[19], (L, N_EXPERTS, D_MODEL), 0.01),
        'norm_final': gain(ks[20], (D_MODEL,)),
    }


def reference(x, mem, positions, norm_mix, w_in, conv_w, w_out, norm_xattn, norm_mem, wq_x, wk_x, wv_x, wo_x, norm_ffn, w_router, b_router, w_gate_up, b_gate_up, w_down, b_down, norm_final):
    b, s, d = x.shape
    h = x
    for l in range(DEPTH):
        u = rms_norm(h, norm_mix[l])
        z = u @ w_in[l]
        (cb, cc, cx, q, k, v, qi, ki, wi, g_conv, g_attn) = split_cols(z, IN_SPLITS)
        y_conv = cb * causal_depthwise_conv(cc * cx, conv_w[l])
        q = rope_partial(q.reshape(b, s, N_HEADS, HEAD_DIM), positions, ROT_DIM)
        k = rope_partial(k.reshape(b, s, N_KV_HEADS, HEAD_DIM), positions, ROT_DIM)
        v = v.reshape(b, s, N_KV_HEADS, HEAD_DIM)
        qi = rope_partial(qi.reshape(b, s, IDX_HEADS, IDX_DIM), positions, IDX_ROT_DIM)
        ki = rope_partial(ki[:, :, None, :], positions, IDX_ROT_DIM)[:, :, 0, :]
        wi = wi * (IDX_HEADS ** -0.5 * IDX_DIM ** -0.5)
        y_attn = dsa_attention(q, k, v, qi, ki, wi)
        merged = jax.nn.sigmoid(g_conv) * y_conv + jax.nn.sigmoid(g_attn) * y_attn
        h = h + merged @ w_out[l]
        h = h + memory_cross_attention(rms_norm(h, norm_xattn[l]), rms_norm(mem, norm_mem[l]),
                                       wq_x[l], wk_x[l], wv_x[l], wo_x[l])
        hf = rms_norm(h, norm_ffn[l]).reshape(b * s, d)
        h = h + moe_ffn(hf, w_router[l], b_router[l], w_gate_up[l], b_gate_up[l],
                        w_down[l], b_down[l]).reshape(b, s, d)
    return rms_norm(h, norm_final)
```

```cpp
#include <hip/hip_runtime.h>
#include <stdio.h>
#include <stdint.h>

#ifndef N_LAUNCH_PER_PHASE
#define N_LAUNCH_PER_PHASE 0
#endif
#ifndef REP_PHASE
#define REP_PHASE -1
#endif
#ifndef MILESTONE
#define MILESTONE 4
#endif

#define LAS __attribute__((address_space(3)))
typedef unsigned short bf16_t;
typedef short bf16x8 __attribute__((ext_vector_type(8)));
typedef float f32x2 __attribute__((ext_vector_type(2)));
typedef float f32x4 __attribute__((ext_vector_type(4)));
typedef float f32x16 __attribute__((ext_vector_type(16)));
typedef unsigned u32x4 __attribute__((ext_vector_type(4)));
typedef unsigned u32x2 __attribute__((ext_vector_type(2)));

constexpr int NB = 4, SEQ = 4096, T = NB * SEQ, DM = 2048, DIN = 14416;
constexpr int NHEAD = 16, HD = 128, NKVH = 4, IHEAD = 16, IDIM = 64, TOPK = 256;
constexpr int MEML = 256, XHEAD = 4;
constexpr int NEXP = 32, DFF = 2048, TOPE = 4;
constexpr float NORM_EPS = 1e-6f;
constexpr int C_CB = 0, C_CC = 2048, C_CX = 4096, C_Q = 6144, C_K = 8192, C_V = 8704, C_QI = 9216, C_KI = 10240, C_WI = 10304, C_GC = 10320, C_GA = 12368;
constexpr int TL_A = 0, TL_P = 16, TL_G = 32, TL_Q = 40, TL_K = 48, TL_V = 50, TL_QI = 52, TL_KI = 56, N1_TILES = 57, N1P = N1_TILES * 256;
constexpr int CAP_ROWS = T * TOPE + NEXP * 256;
constexpr int MAX_MT = CAP_ROWS / 256;

constexpr size_t al256(size_t x) { return (x + 255) & ~(size_t)255; }
constexpr size_t WS_CTL = 0;
constexpr size_t CTL_BAR = 0;
constexpr size_t CTL_CNT = 16384;
constexpr size_t CTL_SS1 = 32768;
constexpr size_t CTL_BYTES = CTL_SS1 + (size_t)T * 4;
constexpr size_t WS_XB = al256(CTL_BYTES);
constexpr size_t WS_RS0 = WS_XB + (size_t)T * DM * 2;
constexpr size_t WS_RSMEM = WS_RS0 + (size_t)T * 4;
constexpr size_t WS_ROPEQK = WS_RSMEM + 4096;
constexpr size_t WS_ROPEI = WS_ROPEQK + (size_t)T * 32 * 4;
constexpr size_t WS_MEMB = WS_ROPEI + (size_t)T * 16 * 4;
constexpr size_t WS_WINT = WS_MEMB + (size_t)NB * MEML * DM * 2;
constexpr size_t WS_WOUTT = WS_WINT + (size_t)N1P * DM * 2;
constexpr size_t WS_WQT = WS_WOUTT + (size_t)DM * DM * 2;
constexpr size_t WS_WKVT = WS_WQT + (size_t)512 * DM * 2;
constexpr size_t WS_WOXT = WS_WKVT + (size_t)1024 * DM * 2;
constexpr size_t WS_WGUT = WS_WOXT + (size_t)DM * 512 * 2;
constexpr size_t WS_WDNT = WS_WGUT + (size_t)NEXP * 4096 * DM * 2;
constexpr size_t WS_WRT = WS_WDNT + (size_t)NEXP * DM * DFF * 2;
constexpr size_t WS_ABUF = WS_WRT + (size_t)NEXP * DM * 4;
constexpr size_t WS_PBUF = WS_ABUF + (size_t)T * DM * 2;
constexpr size_t WS_GABUF = WS_PBUF + (size_t)T * DM * 2;
constexpr size_t WS_QB = WS_GABUF + (size_t)T * DM * 2;
constexpr size_t WS_KB = WS_QB + (size_t)T * DM * 2;
constexpr size_t WS_VB = WS_KB + (size_t)T * 512 * 2;
constexpr size_t WS_QIB = WS_VB + (size_t)T * 512 * 2;
constexpr size_t WS_KIB = WS_QIB + (size_t)T * 1024 * 2;
constexpr size_t WS_WIB = WS_KIB + (size_t)T * 64 * 2;
constexpr size_t WS_MASK = WS_WIB + (size_t)T * 16 * 4;
constexpr size_t WS_YATT = WS_MASK + (size_t)T * 128 * 4;
constexpr size_t WS_MERGED = WS_YATT + (size_t)T * DM * 2;
constexpr size_t WS_H1 = WS_MERGED + (size_t)T * DM * 2;
constexpr size_t WS_H1B = WS_H1 + (size_t)T * DM * 4;
constexpr size_t WS_QX = WS_H1B + (size_t)T * DM * 2;
constexpr size_t WS_KX = WS_QX + (size_t)T * 512 * 2;
constexpr size_t WS_VX = WS_KX + (size_t)NB * MEML * 512 * 2;
constexpr size_t WS_OX = WS_VX + (size_t)NB * MEML * 512 * 2;
constexpr size_t WS_H2 = WS_OX + (size_t)T * 512 * 2;
constexpr size_t WS_H2B = WS_H2 + (size_t)T * DM * 4;
constexpr size_t WS_SLOTE = WS_H2B + (size_t)T * DM * 2;
constexpr size_t WS_SLOTR = WS_SLOTE + (size_t)T * 4 * 4;
constexpr size_t WS_SLOTG = WS_SLOTR + (size_t)T * 4 * 4;
constexpr size_t WS_RS2 = WS_SLOTG + (size_t)T * 4 * 4;
constexpr size_t WS_POS = WS_RS2 + (size_t)T * 4;
constexpr size_t WS_RSS = WS_POS + (size_t)T * 4 * 4;
constexpr size_t WS_GWS = WS_RSS + (size_t)CAP_ROWS * 4;
constexpr size_t WS_TILEE = WS_GWS + (size_t)CAP_ROWS * 4;
constexpr size_t WS_ASORT = WS_TILEE + 2048;
constexpr size_t WS_HDN = WS_ASORT + (size_t)CAP_ROWS * DM * 2;
constexpr size_t WS_YS = WS_HDN + (size_t)CAP_ROWS * DFF * 2;
constexpr size_t WS_TIE = WS_YS + (size_t)CAP_ROWS * DM * 2;
constexpr size_t WS_XB8 = WS_TIE;
constexpr size_t WS_END = WS_TIE + (size_t)256 * 8 * 128 * 64 * 4;

__device__ __forceinline__ unsigned cvt_pk_bf16(float lo, float hi) { unsigned r; asm volatile("v_cvt_pk_bf16_f32 %0, %1, %2" : "=v"(r) : "v"(lo), "v"(hi)); return r; }
__device__ __forceinline__ u32x2 pack_fp8x8(float a0, float a1, float a2, float a3, float a4, float a5, float a6, float a7) {
    int lo = 0, hi = 0;
    lo = __builtin_amdgcn_cvt_pk_fp8_f32(a0, a1, lo, false); lo = __builtin_amdgcn_cvt_pk_fp8_f32(a2, a3, lo, true);
    hi = __builtin_amdgcn_cvt_pk_fp8_f32(a4, a5, hi, false); hi = __builtin_amdgcn_cvt_pk_fp8_f32(a6, a7, hi, true);
    return (u32x2){(unsigned)lo, (unsigned)hi};
}
constexpr float W8_SCALE = 64.0f;
__device__ __forceinline__ float bf2f(unsigned short b) { return __uint_as_float(((unsigned)b) << 16); }
__device__ __forceinline__ float bf_lo(unsigned w) { return __uint_as_float(w << 16); }
__device__ __forceinline__ float bf_hi(unsigned w) { return __uint_as_float(w & 0xffff0000u); }
__device__ __forceinline__ float sigmoidf_(float x) { return __builtin_amdgcn_rcpf(1.0f + __expf(-x)); }
__device__ __forceinline__ int lane_id() { int x; asm volatile("v_mbcnt_lo_u32_b32 %0, -1, 0\n\tv_mbcnt_hi_u32_b32 %0, -1, %0" : "=v"(x)); return x; }
__device__ __forceinline__ float wave_sum(float v) {
#pragma unroll
    for (int o = 32; o >= 1; o >>= 1) v += __shfl_xor(v, o);
    return v;
}

#define XB_TMO      128
#define XB_XCNT(j)  (256  + 64 * (j))
#define XB_XSUB(j)  (1280 + 64 * (j))
#define XB_XGEN(j)  (2304 + 64 * (j))
#define XB_TOP      3328
#define XB_TOPGEN   3392
#define XCD_BAR_WORDS 3456
#define XB_SPIN_CAP (1u << 18)

__device__ __forceinline__ unsigned xb_ld(unsigned* p)              { return __hip_atomic_load(p, __ATOMIC_RELAXED, __HIP_MEMORY_SCOPE_AGENT); }
__device__ __forceinline__ unsigned xb_add(unsigned* p, unsigned v) { return __hip_atomic_fetch_add(p, v, __ATOMIC_RELAXED, __HIP_MEMORY_SCOPE_AGENT); }
__device__ __forceinline__ unsigned xb_xcc_id() { return (unsigned)__builtin_amdgcn_s_getreg((3 << 11) | 20) & 0xFu; }
#define XB_SPIN(cond, bar) do { unsigned _sp = 0; while (cond) { __builtin_amdgcn_s_sleep(1); \
    if ((++_sp & 255u) == 0u) { if (xb_ld(&(bar)[XB_TMO])) break; if (_sp > XB_SPIN_CAP) { atomicAdd(&(bar)[XB_TMO], 1u); break; } } } } while (0)

struct XcdBarrier { unsigned* bar; unsigned x; volatile LAS unsigned* st; int wv; };

__device__ __forceinline__ XcdBarrier xcd_barrier_post(unsigned* bar, volatile LAS unsigned* st, int wv) {
    XcdBarrier b; b.bar = bar; b.x = xb_xcc_id(); b.st = st; b.wv = wv;
    if (wv == 0 && lane_id() == 0) (void)xb_add(&bar[XB_XCNT(b.x)], 1u);
    return b;
}
__device__ __forceinline__ void xcd_barrier_complete(unsigned* bar, unsigned x, unsigned& nloc, unsigned& nx) {
    const unsigned G = gridDim.x * gridDim.y * gridDim.z;
    unsigned sum, cnt, mine, sp = 0u;
    for (;;) {
        sum = 0u; cnt = 0u; mine = 0u;
#pragma unroll
        for (unsigned j = 0; j < 16; ++j) { const unsigned c = xb_ld(&bar[XB_XCNT(j)]); sum += c; cnt += (c > 0u) ? 1u : 0u; mine = (j == x) ? c : mine; }
        if (sum == G) break;
        __builtin_amdgcn_s_sleep(1);
        if ((++sp & 255u) == 0u) { if (xb_ld(&bar[XB_TMO])) break; if (sp > XB_SPIN_CAP) { atomicAdd(&bar[XB_TMO], 1u); break; } }
    }
    nloc = mine > 0u ? mine : 1u; nx = cnt > 0u ? cnt : 1u;
}
__device__ __forceinline__ void xcd_barrier(const XcdBarrier& b) {
    asm volatile("s_waitcnt vmcnt(0)" ::: "memory");
    __syncthreads();
    if (b.wv == 0 && lane_id() == 0) {
        unsigned* bar = b.bar;
        __builtin_amdgcn_s_waitcnt(0);
        unsigned nloc = b.st[0], nx = b.st[1];
        if (nloc == 0u) { xcd_barrier_complete(bar, b.x, nloc, nx); b.st[0] = nloc; b.st[1] = nx; }
        const unsigned old = xb_add(&bar[XB_XSUB(b.x)], 1u);
        const unsigned gen = old / nloc;
        if (old + 1u == (gen + 1u) * nloc) {
            __builtin_amdgcn_fence(__ATOMIC_RELEASE, "agent");
            asm volatile("s_waitcnt vmcnt(0)" ::: "memory");
            const unsigned og = xb_add(&bar[XB_TOP], 1u);
            const unsigned tg = og / nx;
            if (og + 1u == (tg + 1u) * nx) xb_add(&bar[XB_TOPGEN], 1u);
            else XB_SPIN(xb_ld(&bar[XB_TOPGEN]) == tg, bar);
            __builtin_amdgcn_fence(__ATOMIC_ACQUIRE, "agent");
            xb_add(&bar[XB_XGEN(b.x)], 1u);
            asm volatile("s_waitcnt vmcnt(0)" ::: "memory");
        } else {
            XB_SPIN(xb_ld(&bar[XB_XGEN(b.x)]) == gen, bar);
            __builtin_amdgcn_fence(__ATOMIC_ACQUIRE, "agent");
            asm volatile("s_waitcnt vmcnt(0)" ::: "memory");
        }
    }
    __syncthreads();
}

constexpr int LDS_CT = 131072;
namespace pg8 {
constexpr int BM = 256, BK = 64, HALF = 128, HTB = HALF * BK * 2, STAGE_BYTES = 8 * HTB, NXCD = 8, WGM = 8;
__device__ __forceinline__ int lds_byte(int r, int c) { const int st = (r >> 4) * 2 + (c >> 5), rr = r & 15, cc = c & 31, ob = rr * 64 + cc * 2; return st * 1024 + (ob ^ (((ob >> 9) & 1) << 5)); }
__device__ __forceinline__ void stage_rc(int b, int& R, int& C) { const int st = b / 1024, sb = b % 1024, swz = sb ^ (((sb >> 9) & 1) << 5); R = (st >> 1) * 16 + swz / 64; C = (st & 1) * 32 + (swz % 64) / 2; }
__device__ __forceinline__ int perm32(int rho) { const int n = rho >> 4, i = rho & 15; return 8 * (i >> 2) + 4 * n + (i & 3); }

struct Unit { const char* a; const char* b; int pm, pn, kind, aux; };

__device__ __forceinline__ void tile_of(int L, int nM, int nN, int& pm, int& pn) {
    const int nwg = nM * nN; int wgid = L;
    { const int q = nwg / NXCD, r = nwg % NXCD, xcd = wgid % NXCD, off = wgid / NXCD; wgid = (xcd < r ? xcd * (q + 1) : r * (q + 1) + (xcd - r) * q) + off; }
    const int nig = WGM * nN, gid = wgid / nig, fm = gid * WGM, gsz = (nM - fm) < WGM ? (nM - fm) : WGM;
    pm = fm + ((wgid % nig) % gsz); pn = (wgid % nig) / gsz;
}


struct SideNone { static constexpr bool ON = false; };
struct SideConv {
    static constexpr bool ON = true;
    const float* src; unsigned char* dst; int gu; int j0, jn; int G, c;
    __device__ __forceinline__ void decode(int j, size_t& soff, int& sld, size_t& doff) const {
        if (gu) { const int e = j >> 11, r = j & 2047, nt = r >> 4, kt = r & 15, n0 = nt * 32, w = n0 & 255, tile = n0 >> 8;
            const int sc = (w < 128) ? 128 * tile + w : 2048 + 128 * tile + (w - 128);
            sld = 4096; soff = (size_t)e * 2048 * 4096 + (size_t)(kt * 128) * 4096 + sc; doff = (size_t)e * 4096 * 2048 + (size_t)n0 * 2048 + kt * 128; }
        else { const int e = j >> 10, r = j & 1023, nt = r >> 4, kt = r & 15, n0 = nt * 32;
            sld = 2048; soff = (size_t)e * 2048 * 2048 + (size_t)(kt * 128) * 2048 + n0; doff = (size_t)e * 2048 * 2048 + (size_t)n0 * 2048 + kt * 128; }
    }
    __device__ __forceinline__ size_t issue(int j, LAS unsigned char* tile, int wid, int lane) const {
        size_t soff, doff; int sld; decode(j, soff, sld, doff);
        const float* sp = src + soff + (size_t)(16 * wid + (lane >> 3)) * sld + (lane & 7) * 4;
        __builtin_amdgcn_global_load_lds((const unsigned*)sp, (LAS unsigned*)(tile + (2 * wid) * 1040), 16, 0, 2);
        __builtin_amdgcn_global_load_lds((const unsigned*)(sp + (size_t)8 * sld), (LAS unsigned*)(tile + (2 * wid + 1) * 1040), 16, 0, 2);
        return doff;
    }
    __device__ __forceinline__ void consume(const LAS unsigned char* tile, size_t doff, int wid, int lane) const {
        float sv[8];
#pragma unroll
        for (int j = 0; j < 8; ++j) sv[j] = *(const LAS float*)(tile + (lane & 15) * 1040 + j * 128 + (4 * wid + (lane >> 4)) * 4);
        __builtin_nontemporal_store(pack_fp8x8(sv[0] * W8_SCALE, sv[1] * W8_SCALE, sv[2] * W8_SCALE, sv[3] * W8_SCALE, sv[4] * W8_SCALE, sv[5] * W8_SCALE, sv[6] * W8_SCALE, sv[7] * W8_SCALE),
                                    (u32x2*)(dst + doff + (size_t)(4 * wid + (lane >> 4)) * 2048 + 8 * (lane & 15)));
    }
    __device__ __forceinline__ void leftover(int done, int wid, int lane) const {
        for (int q = done; j0 + q * G + c < jn; q += 4) {
            float v[4][8]; size_t doff[4]; bool ok[4];
#pragma unroll
            for (int u = 0; u < 4; ++u) {
                const int j = j0 + (q + u) * G + c; ok[u] = j < jn;
                size_t soff; int sld; decode(ok[u] ? j : j0 + q * G + c, soff, sld, doff[u]);
                const float* sp = src + soff + (size_t)(16 * wid + 8 * (lane >> 5)) * sld + (lane & 31);
#pragma unroll
                for (int r = 0; r < 8; ++r) v[u][r] = __builtin_nontemporal_load(sp + (size_t)r * sld);
            }
#pragma unroll
            for (int u = 0; u < 4; ++u)
                if (ok[u]) *(u32x2*)(dst + doff[u] + (size_t)(lane & 31) * 2048 + 16 * wid + 8 * (lane >> 5)) = pack_fp8x8(v[u][0] * W8_SCALE, v[u][1] * W8_SCALE, v[u][2] * W8_SCALE, v[u][3] * W8_SCALE, v[u][4] * W8_SCALE, v[u][5] * W8_SCALE, v[u][6] * W8_SCALE, v[u][7] * W8_SCALE);
        }
    }
};

typedef int i32x4_ __attribute__((ext_vector_type(4)));
typedef int i32x8_ __attribute__((ext_vector_type(8)));
template <class Epi, class Sched, class Side = SideNone, bool FP8 = false>
__device__ __forceinline__ int gemm_phase(LAS unsigned char* lds, const int RB, const Sched& S, const Epi& E, const int wid, const Side& SD = Side{}) {
    const int lane = lane_id(), tid = wid * 64 + lane, wr = wid >> 2, wc = wid & 3, fr = lane & 15, fq = lane >> 4;
    const int nt = RB / 128;
    unsigned voffA[2], voffB[2];
#pragma unroll
    for (int i = 0; i < 2; ++i) { int R, C; stage_rc(tid * 16 + i * 8192, R, C); const int Rb = (R & ~31) + perm32(R & 31);
        voffA[i] = (unsigned)(R * RB + C * 2); voffB[i] = (unsigned)(Rb * RB + C * 2); }
    const size_t kstep = (size_t)(BK * 2);
    const size_t hstep = (size_t)HALF * RB;
    const unsigned ldsw = (unsigned)wid * 1024u;
    const int aoff = lds_byte(wr * 64 + fr, fq * 8), boff = lds_byte(wc * 32 + fr, fq * 8);
#define PG8_SA(b, h) (((b) * 2 + (h)) * HTB)
#define PG8_SB(b, h) ((4 + (b) * 2 + (h)) * HTB)
#define PG8_STAGE(bufoff, gbase, voff) do { _Pragma("unroll") for (int _i = 0; _i < 2; ++_i) \
        __builtin_amdgcn_global_load_lds((const unsigned*)((const char*)(gbase) + (voff)[_i]), (LAS unsigned*)(lds + (bufoff) + ldsw + _i * 8192), 16, 0, 0); } while (0)
#define PG8_LDA(dst, b, h) do { if constexpr (FP8) { _Pragma("unroll") for (int m = 0; m < 4; ++m) dst##8[m] = __builtin_shufflevector(*(const LAS i32x4_*)(lds + PG8_SA(b, h) + aoff + m * 2048), *(const LAS i32x4_*)(lds + PG8_SA(b, h) + aoff + m * 2048 + 1024), 0, 1, 2, 3, 4, 5, 6, 7); } \
        else { _Pragma("unroll") for (int m = 0; m < 4; ++m) _Pragma("unroll") for (int k = 0; k < 2; ++k) dst[m][k] = *(const LAS bf16x8*)(lds + PG8_SA(b, h) + aoff + m * 2048 + k * 1024); } } while (0)
#define PG8_LDB(dst, b, h) do { if constexpr (FP8) { _Pragma("unroll") for (int n = 0; n < 2; ++n) dst##8[n] = __builtin_shufflevector(*(const LAS i32x4_*)(lds + PG8_SB(b, h) + boff + n * 2048), *(const LAS i32x4_*)(lds + PG8_SB(b, h) + boff + n * 2048 + 1024), 0, 1, 2, 3, 4, 5, 6, 7); } \
        else { _Pragma("unroll") for (int n = 0; n < 2; ++n) _Pragma("unroll") for (int k = 0; k < 2; ++k) dst[n][k] = *(const LAS bf16x8*)(lds + PG8_SB(b, h) + boff + n * 2048 + k * 1024); } } while (0)
#define PG8_CAT(X) X
#define PG8_MMA(ai, bj, At, Bt) do { if constexpr (FP8) __builtin_amdgcn_sched_barrier(0); __builtin_amdgcn_s_setprio(1); _Pragma("unroll") for (int m = 0; m < 4; ++m) _Pragma("unroll") for (int n = 0; n < 2; ++n) { \
        if constexpr (FP8) asm volatile("v_mfma_scale_f32_16x16x128_f8f6f4 %0, %1, %2, %0, %3, %3 op_sel_hi:[0,0,0]" : "+v"(acc[ai][bj][m][n]) : "v"(Bt##8[n]), "v"(At##8[m]), "v"(mx_one));   \
        else { _Pragma("unroll") for (int k = 0; k < 2; ++k) acc[ai][bj][m][n] = __builtin_amdgcn_mfma_f32_16x16x32_bf16(Bt[n][k], At[m][k], acc[ai][bj][m][n], 0, 0, 0); } } \
        __builtin_amdgcn_s_setprio(0); if constexpr (FP8) __builtin_amdgcn_sched_barrier(0); } while (0)
#define PG8_WAIT_V(n) asm volatile("s_waitcnt vmcnt(" #n ")" ::: "memory")
#define PG8_WAIT_L(n) asm volatile("s_waitcnt lgkmcnt(" #n ")" ::: "memory")
#define PG8_BAR __builtin_amdgcn_s_barrier()
#define PG8_SCHED __builtin_amdgcn_sched_barrier(0)
    Unit cur, nxt; int ui = 0;
    int sq = 0; bool s_have = false; size_t s_doff = 0;
    if (!S.next(0, cur)) return 0;
    f32x4 acc[2][2][4][2];
#pragma unroll
    for (int a = 0; a < 2; ++a)
#pragma unroll
        for (int b = 0; b < 2; ++b)
#pragma unroll
            for (int m = 0; m < 4; ++m)
#pragma unroll
                for (int n = 0; n < 2; ++n) acc[a][b][m][n] = (f32x4){0.f, 0.f, 0.f, 0.f};
    bf16x8 At[4][2], B0[2][2], B1[2][2];
    const int mx_one = 0x7F7F7F7F;
    i32x8_ At8[4], B08[2], B18[2];
    const char* cA = cur.a; const char* cB = cur.b;
    PG8_STAGE(PG8_SB(0, 0), cB, voffB); PG8_STAGE(PG8_SA(0, 0), cA, voffA); PG8_STAGE(PG8_SB(0, 1), cB + hstep, voffB); PG8_STAGE(PG8_SA(0, 1), cA + hstep, voffA);
    if (wr == 1) PG8_BAR;
    PG8_WAIT_V(4); PG8_BAR;
    PG8_STAGE(PG8_SB(1, 0), cB + kstep, voffB); PG8_STAGE(PG8_SA(1, 0), cA + kstep, voffA); PG8_STAGE(PG8_SB(1, 1), cB + hstep + kstep, voffB);
    PG8_WAIT_V(6); PG8_BAR;
    for (;;) {
        const bool has_next = S.next(ui + 1, nxt);
        const char* nA = has_next ? nxt.a : cA; const char* nB = has_next ? nxt.b : cB;
        const int lzp = lane_id(); const typename Epi::Pre pre = E.pre(cur, wr, wc, lzp & 15, lzp >> 4);
        for (int t = 0; t < nt; t += 2) {
            const bool last = (t == nt - 2);
            const char* a1 = cA + (size_t)(t + 1) * kstep;
            const char* a2 = last ? nA : cA + (size_t)(t + 2) * kstep; const char* b2 = last ? nB : cB + (size_t)(t + 2) * kstep;
            const char* a3 = a2 + kstep; const char* b3 = b2 + kstep;
            PG8_LDB(B0, 0, 0); PG8_SCHED; PG8_LDA(At, 0, 0); PG8_STAGE(PG8_SA(1, 1), a1 + hstep, voffA);
            PG8_WAIT_L(8); PG8_BAR; PG8_WAIT_L(0); PG8_MMA(0, 0, At, B0); PG8_BAR; PG8_SCHED;
            PG8_LDB(B1, 0, 1);
            float sv[8]; const bool s_st = Side::ON && s_have;
            if constexpr (Side::ON) { if (s_st) {
#pragma unroll
                for (int j = 0; j < 8; ++j) sv[j] = *(const LAS float*)(lds + LDS_CT + (lane & 15) * 1040 + j * 128 + (4 * wid + (lane >> 4)) * 4); } }
            PG8_STAGE(PG8_SB(0, 0), b2, voffB);
            PG8_BAR; PG8_WAIT_L(0);
            u32x2 sw; if constexpr (Side::ON) { if (s_st) sw = pack_fp8x8(sv[0] * W8_SCALE, sv[1] * W8_SCALE, sv[2] * W8_SCALE, sv[3] * W8_SCALE, sv[4] * W8_SCALE, sv[5] * W8_SCALE, sv[6] * W8_SCALE, sv[7] * W8_SCALE); }
            PG8_MMA(0, 1, At, B1); PG8_BAR;
            PG8_LDA(At, 0, 1);
            if constexpr (Side::ON) { if (s_st) __builtin_nontemporal_store(sw, (u32x2*)(SD.dst + s_doff + (size_t)(4 * wid + (lane >> 4)) * 2048 + 8 * (lane & 15))); }
            PG8_STAGE(PG8_SA(0, 0), a2, voffA);
            PG8_BAR; PG8_WAIT_L(0); PG8_MMA(1, 0, At, B0); PG8_BAR; PG8_SCHED;
            PG8_STAGE(PG8_SB(0, 1), b2 + hstep, voffB);
            if (Side::ON && s_st) { PG8_WAIT_V(7); } else { PG8_WAIT_V(6); }
            PG8_BAR; PG8_MMA(1, 1, At, B1); PG8_BAR;
            PG8_LDB(B0, 1, 0); PG8_SCHED; PG8_LDA(At, 1, 0);
            if constexpr (Side::ON) {
                s_have = false;
                if (SD.j0 + sq * SD.G + SD.c < SD.jn) { size_t soff; int sld; SD.decode(SD.j0 + sq * SD.G + SD.c, soff, sld, s_doff);
                    const float* sp = SD.src + soff + (size_t)(16 * wid + (lane >> 3)) * sld + (lane & 7) * 4;
                    __builtin_amdgcn_global_load_lds((const unsigned*)sp, (LAS unsigned*)(lds + LDS_CT + (2 * wid) * 1040), 16, 0, 2);
                    __builtin_amdgcn_global_load_lds((const unsigned*)(sp + (size_t)8 * sld), (LAS unsigned*)(lds + LDS_CT + (2 * wid + 1) * 1040), 16, 0, 2);
                    s_have = true; ++sq; }
            }
            PG8_STAGE(PG8_SA(0, 1), a2 + hstep, voffA);
            PG8_WAIT_L(8); PG8_BAR; PG8_WAIT_L(0); PG8_MMA(0, 0, At, B0); PG8_BAR; PG8_SCHED;
            PG8_LDB(B1, 1, 1); PG8_STAGE(PG8_SB(1, 0), b3, voffB);
            PG8_BAR; PG8_WAIT_L(0); PG8_MMA(0, 1, At, B1); PG8_BAR;
            PG8_LDA(At, 1, 1); PG8_STAGE(PG8_SA(1, 0), a3, voffA);
            PG8_BAR; PG8_WAIT_L(0); PG8_MMA(1, 0, At, B0); PG8_BAR; PG8_SCHED;
            PG8_STAGE(PG8_SB(1, 1), b3 + hstep, voffB);
            PG8_WAIT_V(6); PG8_BAR; PG8_MMA(1, 1, At, B1); PG8_BAR;
        }
        if constexpr (FP8) asm volatile("s_nop 15\n s_nop 7" ::: "memory");
        { const int lz = lane_id(); E(acc, cur, wr, wc, lz & 15, lz >> 4, pre); }
        if (!has_next) break;
#pragma unroll
        for (int a = 0; a < 2; ++a)
#pragma unroll
            for (int b = 0; b < 2; ++b)
#pragma unroll
                for (int m = 0; m < 4; ++m)
#pragma unroll
                    for (int n = 0; n < 2; ++n) acc[a][b][m][n] = (f32x4){0.f, 0.f, 0.f, 0.f};
        cur = nxt; cA = nA; cB = nB; ++ui;
    }
    PG8_WAIT_V(0);
    if (wr == 0) PG8_BAR;
    PG8_BAR;
    if constexpr (Side::ON) { if (s_have) {
        float sv[8];
#pragma unroll
        for (int j = 0; j < 8; ++j) sv[j] = *(const LAS float*)(lds + LDS_CT + (lane & 15) * 1040 + j * 128 + (4 * wid + (lane >> 4)) * 4);
        *(u32x2*)(SD.dst + s_doff + (size_t)(4 * wid + (lane >> 4)) * 2048 + 8 * (lane & 15)) =
            pack_fp8x8(sv[0] * W8_SCALE, sv[1] * W8_SCALE, sv[2] * W8_SCALE, sv[3] * W8_SCALE, sv[4] * W8_SCALE, sv[5] * W8_SCALE, sv[6] * W8_SCALE, sv[7] * W8_SCALE); } }
#undef PG8_SA
#undef PG8_SB
#undef PG8_STAGE
#undef PG8_LDA
#undef PG8_LDB
#undef PG8_MMA
#undef PG8_WAIT_V
#undef PG8_WAIT_L
#undef PG8_BAR
#undef PG8_SCHED
#undef PG8_CAT
    return sq;
}
}
using pg8::Unit;

struct Args { const void* in[21]; float* out; unsigned char* ws; int ph_lo, ph_hi; };
enum { IN_X = 0, IN_MEM, IN_POS, IN_NORM_MIX, IN_W_IN, IN_CONV_W, IN_W_OUT, IN_NORM_XATTN, IN_NORM_MEM, IN_WQ_X, IN_WK_X, IN_WV_X, IN_WO_X, IN_NORM_FFN,
       IN_W_ROUTER, IN_B_ROUTER, IN_W_GU, IN_B_GU, IN_W_DN, IN_B_DN, IN_NORM_FINAL };
constexpr int LDS_BYTES = 163840;
constexpr int LDS_MISC = 155648;

struct Frame {
    const Args* a; unsigned char* ws; LAS unsigned char* lds; int wave, G, bid;
    __device__ __forceinline__ int lane_() const { return lane_id(); }
    __device__ __forceinline__ int tid_() const { return wave * 64 + lane_id(); }
    template <class Tp> __device__ __forceinline__ Tp* W(size_t off) const { return (Tp*)(ws + off); }
    template <class Tp> __device__ __forceinline__ const Tp* I(int k) const { return (const Tp*)a->in[k]; }
};

__constant__ float c_invfreq[16] = {1.000000000e+00f, 4.403665960e-01f, 1.939227432e-01f, 8.539710194e-02f, 3.760603070e-02f, 1.656044088e-02f, 7.292664610e-03f, 3.211446106e-03f,
                                    1.414213562e-03f, 6.227724371e-04f, 2.742481884e-04f, 1.207697351e-04f, 5.318295734e-05f, 2.341999971e-05f, 1.031338525e-05f, 4.541670478e-06f};

__device__ __forceinline__ int win_src_col(int c) {
    const int tile = c >> 8, w = c & 255;
    if (tile < TL_P) { const int i = tile - TL_A; return w < 128 ? C_CB + 128 * i + w : C_GC + 128 * i + (w - 128); }
    if (tile < TL_G) { const int i = tile - TL_P; return w < 128 ? C_CC + 128 * i + w : C_CX + 128 * i + (w - 128); }
    if (tile < TL_Q) return C_GA + 256 * (tile - TL_G) + w;
    if (tile < TL_V) {
        const int col = (tile < TL_K) ? 256 * (tile - TL_Q) + w : 256 * (tile - TL_K) + w; const int base = (tile < TL_K) ? C_Q : C_K;
        const int d = col & 127; int pd = d;
        if (d < 32) { const int f = d >> 3, r = d & 7; pd = (r < 4) ? 4 * f + r : 16 + 4 * f + (r - 4); }
        return base + (col & ~127) + pd;
    }
    if (tile < TL_QI) return C_V + 256 * (tile - TL_V) + w;
    if (tile < TL_KI) { const int col = 256 * (tile - TL_QI) + w; const int d = col & 63; int pd = d;
        if (d < 16) { const int f = d >> 3, r = d & 7; pd = (r < 4) ? 4 * f + r : 8 + 4 * f + (r - 4); }
        return C_QI + (col & ~63) + pd; }
    if (w < 64) { int pd = w; if (w < 16) { const int f = w >> 3, r = w & 7; pd = (r < 4) ? 4 * f + r : 8 + 4 * f + (r - 4); } return C_KI + pd; }
    if (w < 80) return C_WI + (w - 64);
    return -1;
}

enum { MAP_ID = 0, MAP_WIN = 1, MAP_KV = 2, MAP_GU = 3 };
struct TJob { const float* src; const float* src2; const float* scale; bf16_t* dst; int src_ld, K, n0, k0, map, f8; };
__device__ __forceinline__ void tjob_load(const TJob& J, int wave, int lane, f32x4 (&R)[8]) {
    const int n = J.n0 + 32 * wave + (lane & 7) * 4;
    const float* sp = J.src; int sc = n;
    if (J.map == MAP_WIN) sc = win_src_col(n);
    else if (J.map == MAP_KV) { if (n >= 512) { sp = J.src2; sc = n - 512; } }
    else if (J.map == MAP_GU) { const int tile = n >> 8, w = n & 255; sc = (w < 128) ? 128 * tile + w : 2048 + 128 * tile + (w - 128); }
    const float* p = sp + (size_t)(J.k0 + 8 * (lane >> 3)) * J.src_ld + (sc >= 0 ? sc : 0);
#pragma unroll
    for (int j = 0; j < 8; ++j) { R[j] = (sc >= 0) ? __builtin_nontemporal_load((const f32x4*)(p + (size_t)j * J.src_ld)) : (f32x4){0.f, 0.f, 0.f, 0.f}; }
}
__device__ __forceinline__ void tjob_store(const TJob& J, int wave, int lane, const f32x4 (&R)[8]) {
    const int n = J.n0 + 32 * wave + (lane & 7) * 4, k = J.k0 + 8 * (lane >> 3);
    f32x4 s0 = (f32x4){1.f, 1.f, 1.f, 1.f}, s1 = s0;
    if (J.scale) { s0 = *(const f32x4*)(J.scale + k); s1 = *(const f32x4*)(J.scale + k + 4); }
    if (J.f8) {
        s0 *= W8_SCALE; s1 *= W8_SCALE;
#pragma unroll
        for (int c = 0; c < 4; ++c)
            __builtin_nontemporal_store(pack_fp8x8(R[0][c] * s0[0], R[1][c] * s0[1], R[2][c] * s0[2], R[3][c] * s0[3], R[4][c] * s1[0], R[5][c] * s1[1], R[6][c] * s1[2], R[7][c] * s1[3]),
                                        (u32x2*)((unsigned char*)J.dst + (size_t)(n + c) * J.K + k));
        return;
    }
#pragma unroll
    for (int c = 0; c < 4; ++c) {
        u32x4 w;
        w.x = cvt_pk_bf16(R[0][c] * s0[0], R[1][c] * s0[1]); w.y = cvt_pk_bf16(R[2][c] * s0[2], R[3][c] * s0[3]);
        w.z = cvt_pk_bf16(R[4][c] * s1[0], R[5][c] * s1[1]); w.w = cvt_pk_bf16(R[6][c] * s1[2], R[7][c] * s1[3]);
        __builtin_nontemporal_store(w, (u32x4*)(J.dst + (size_t)(n + c) * J.K + k));
    }
}

__device__ __forceinline__ void row_cvt(const float* src, bf16_t* dst, float* rs, int lane, unsigned char* dst8 = nullptr) {
    float ss = 0.f;
#pragma unroll
    for (int i = 0; i < 4; ++i) {
        const int c = (i * 64 + lane) * 8;
        const f32x4 a = *(const f32x4*)(src + c), b = *(const f32x4*)(src + c + 4);
        ss += a[0] * a[0] + a[1] * a[1] + a[2] * a[2] + a[3] * a[3] + b[0] * b[0] + b[1] * b[1] + b[2] * b[2] + b[3] * b[3];
        u32x4 w; w.x = cvt_pk_bf16(a[0], a[1]); w.y = cvt_pk_bf16(a[2], a[3]); w.z = cvt_pk_bf16(b[0], b[1]); w.w = cvt_pk_bf16(b[2], b[3]);
        *(u32x4*)(dst + c) = w;
        if (dst8) *(u32x2*)(dst8 + c) = pack_fp8x8(a[0], a[1], a[2], a[3], b[0], b[1], b[2], b[3]);
    }
    ss = wave_sum(ss);
    if (lane == 0) *rs = __builtin_amdgcn_rsqf(ss * (1.0f / DM) + NORM_EPS);
}

constexpr int SJ_GU = NEXP * 32 * 64, SJ_GU_P1 = 256 * 160, SJ_GU_P2 = SJ_GU_P1 + 256 * 64, SJ_DN = NEXP * 32 * 32;
constexpr int J_WIN = N1_TILES * 32, J_WOUT = 8 * 32, J_WQ = 2 * 32, J_WKV = 4 * 32, J_WOX = 8 * 8, J_GU = 16 * 32, J_DN = 8 * 32;
constexpr int TJ0 = J_WIN, TJ1 = TJ0 + J_WOUT, TJ2 = TJ1 + J_WQ, TJ3 = TJ2 + J_WKV, TJ_EARLY = TJ3 + J_WOX, TJ5 = TJ_EARLY + NEXP * J_GU, TJ_ALL = TJ5 + NEXP * J_DN;
__device__ __forceinline__ TJob tjob_decode(const Frame& F, int j) {
    TJob J; J.src2 = nullptr; J.scale = nullptr; J.src_ld = DM; J.K = DM; J.map = MAP_ID; J.f8 = 0;
    if (j < TJ0) { const int nt = j >> 5, kt = j & 31; J.src = F.I<float>(IN_W_IN); J.src_ld = DIN; J.scale = F.I<float>(IN_NORM_MIX); J.dst = F.W<bf16_t>(WS_WINT); J.map = MAP_WIN; J.n0 = nt * 256; J.k0 = kt * 64; J.f8 = nt < TL_P || (nt >= TL_G && nt < TL_QI); if (J.f8) J.dst += (size_t)nt * 128 * DM; }
    else if (j < TJ1) { const int q = j - TJ0, nt = q >> 5, kt = q & 31; J.src = F.I<float>(IN_W_OUT); J.dst = F.W<bf16_t>(WS_WOUTT); J.n0 = nt * 256; J.k0 = kt * 64; }
    else if (j < TJ2) { const int q = j - TJ1, nt = q >> 5, kt = q & 31; J.src = F.I<float>(IN_WQ_X); J.src_ld = 512; J.scale = F.I<float>(IN_NORM_XATTN); J.dst = F.W<bf16_t>(WS_WQT); J.n0 = nt * 256; J.k0 = kt * 64; }
    else if (j < TJ3) { const int q = j - TJ2, nt = q >> 5, kt = q & 31; J.src = F.I<float>(IN_WK_X); J.src2 = F.I<float>(IN_WV_X); J.src_ld = 512; J.scale = F.I<float>(IN_NORM_MEM); J.dst = F.W<bf16_t>(WS_WKVT); J.map = MAP_KV; J.n0 = nt * 256; J.k0 = kt * 64; }
    else if (j < TJ_EARLY) { const int q = j - TJ3, nt = q >> 3, kt = q & 7; J.src = F.I<float>(IN_WO_X); J.dst = F.W<bf16_t>(WS_WOXT); J.K = 512; J.n0 = nt * 256; J.k0 = kt * 64; }
    else if (j < TJ5) { const int q = j - TJ_EARLY, e = q / J_GU, r = q % J_GU, nt = r >> 5, kt = r & 31;
        J.src = F.I<float>(IN_W_GU) + (size_t)e * DM * 4096; J.src_ld = 4096; J.scale = F.I<float>(IN_NORM_FFN); J.dst = F.W<bf16_t>(WS_WGUT) + (size_t)e * 4096 * DM; J.map = MAP_GU; J.n0 = nt * 256; J.k0 = kt * 64; }
    else { const int q = j - TJ5, e = q / J_DN, r = q % J_DN, nt = r >> 5, kt = r & 31;
        J.src = F.I<float>(IN_W_DN) + (size_t)e * DFF * DM; J.dst = F.W<bf16_t>(WS_WDNT) + (size_t)e * DM * DFF; J.K = DFF; J.n0 = nt * 256; J.k0 = kt * 64; }
    return J;
}
template <int NS>
__device__ __forceinline__ void convert_weights(const Frame& F, int jlo, int jhi, int first, int step) {
    f32x4 R[NS][8]; TJob J[NS]; int jj[NS];
    const int wv = F.wave, ln = F.lane_();
    int j = jlo + first;
#pragma unroll
    for (int s = 0; s < NS - 1; ++s) { jj[s] = j; if (j < jhi) { J[s] = tjob_decode(F, j); tjob_load(J[s], wv, ln, R[s]); } j += step; }
    for (;;) {
        bool done = false;
#pragma unroll
        for (int s = 0; s < NS; ++s) {
            if (!done) {
                constexpr int dummy = 0; (void)dummy;
                const int sl = (s + NS - 1) % NS;
                jj[sl] = j; if (j < jhi) { J[sl] = tjob_decode(F, j); tjob_load(J[sl], wv, ln, R[sl]); } j += step;
                if (jj[s] >= jhi) done = true; else tjob_store(J[s], wv, ln, R[s]);
            }
        }
        if (done) break;
    }
}

__device__ __forceinline__ void p0_prologue(const Frame& F) {
    const int G = F.G, bid = F.bid;
    convert_weights<3>(F, 0, TJ_EARLY, bid, G);
    for (int r = bid * 8 + F.wave; r < T + NB * MEML; r += G * 8) {
        if (r < T) row_cvt(F.I<float>(IN_X) + (size_t)r * DM, F.W<bf16_t>(WS_XB) + (size_t)r * DM, F.W<float>(WS_RS0) + r, F.lane_(), F.W<unsigned char>(WS_XB8) + (size_t)r * DM);
        else { const int m = r - T; row_cvt(F.I<float>(IN_MEM) + (size_t)m * DM, F.W<bf16_t>(WS_MEMB) + (size_t)m * DM, F.W<float>(WS_RSMEM) + m, F.lane_()); }
    }
    for (int i = bid * 512 + F.tid_(); i < T * 24; i += G * 512) {
        const int t = i / 24, f = i % 24;
        const float inv = f < 16 ? c_invfreq[f] : c_invfreq[2 * (f - 16)];
        const float ang = (float)F.I<int>(IN_POS)[t] * inv;
        double rev = (double)ang * 0.15915494309189533577; rev -= __builtin_rint(rev);
        const float rv = (float)rev;
        const float sn = __builtin_amdgcn_sinf(rv), cs = __builtin_amdgcn_cosf(rv);
        if (f < 16) { F.W<float>(WS_ROPEQK)[t * 32 + f] = cs; F.W<float>(WS_ROPEQK)[t * 32 + 16 + f] = sn; }
        else { F.W<float>(WS_ROPEI)[t * 16 + (f - 16)] = cs; F.W<float>(WS_ROPEI)[t * 16 + 8 + (f - 16)] = sn; }
    }
    for (int i = bid * 512 + F.tid_(); i < NEXP * DM; i += G * 512) {
        const int e = i / DM, k = i % DM;
        F.W<float>(WS_WRT)[i] = F.I<float>(IN_NORM_FFN)[k] * F.I<float>(IN_W_ROUTER)[k * NEXP + e];
    }
}

enum { KD_A = 0, KD_P, KD_G, KD_Q, KD_K, KD_V, KD_QI, KD_KI, KD_KVX };
struct SchedG1F {
    int G, c; const char* xb8; const char* wint;
    static constexpr int NT8 = TL_P + (TL_QI - TL_G);
    __device__ __forceinline__ bool next(int i, Unit& u) const {
        int L = i * G + c;
        if (G == 256) {
            if (i == 8) { if (c >= 176) return false; L = 2048 + c; }
            else if (i == 9) { if (c >= 80) return false; L = 2224 + c; }
            else if (i > 9) return false;
        }
        if (L >= 64 * NT8) return false;
        int pm, pn; pg8::tile_of(L, 64, NT8, pm, pn); if (pn >= TL_P) pn += TL_G - TL_P; u.pm = pm; u.pn = pn; u.a = xb8 + (size_t)pm * 256 * DM; u.b = wint + (size_t)pn * 256 * DM * 2;
        u.kind = pn < TL_P ? KD_A : pn < TL_Q ? KD_G : pn < TL_K ? KD_Q : pn < TL_V ? KD_K : KD_V; u.aux = 0; return true;
    }
};
struct SchedG1 {
    int G, c; const char* xb; const char* wint; const char* memb; const char* wkvt;
    __device__ __forceinline__ bool next(int i, Unit& u) const {
        constexpr int NT = N1_TILES - SchedG1F::NT8;
        const int L = i * G + c; constexpr int NW1 = 64 * NT;
        if (L < NW1) { int pm, pn; pg8::tile_of(L, 64, NT, pm, pn); pn = pn < TL_G - TL_P ? TL_P + pn : TL_QI + (pn - (TL_G - TL_P)); u.pm = pm; u.pn = pn; u.a = xb + (size_t)pm * 256 * DM * 2; u.b = wint + (size_t)pn * 256 * DM * 2;
            u.kind = pn < TL_P ? KD_A : pn < TL_G ? KD_P : pn < TL_Q ? KD_G : pn < TL_K ? KD_Q : pn < TL_V ? KD_K : pn < TL_QI ? KD_V : pn < TL_KI ? KD_QI : KD_KI; u.aux = 0; return true; }
        const int q = L - NW1; if (q >= 16) return false;
        u.pm = q & 3; u.pn = q >> 2; u.a = memb + (size_t)u.pm * 256 * DM * 2; u.b = wkvt + (size_t)u.pn * 256 * DM * 2; u.kind = KD_KVX; u.aux = 0; return true;
    }
};
__device__ __forceinline__ void st_bf16x8(bf16_t* p, const f32x4& a, const f32x4& b) {
    u32x4 w; w.x = cvt_pk_bf16(a[0], a[1]); w.y = cvt_pk_bf16(a[2], a[3]); w.z = cvt_pk_bf16(b[0], b[1]); w.w = cvt_pk_bf16(b[2], b[3]);
    *(u32x4*)p = w;
}
struct EpiG1 {
    const float* rs0; const float* rsmem; const float* ropeqk; const float* ropei;
    bf16_t* abuf; bf16_t* pbuf; bf16_t* gabuf; bf16_t* qb; bf16_t* kb; bf16_t* vb; bf16_t* qib; bf16_t* kib; float* wib; bf16_t* kx; bf16_t* vx; float sc;
    struct Pre { };
    __device__ __forceinline__ Pre pre(const Unit&, int, int, int, int) const { return Pre{}; }
    __device__ __forceinline__ void operator()(const f32x4 (&acc)[2][2][4][2], const Unit& u, int wr, int wc, int fr, int fq, const Pre&) const {
        const int kind = u.kind, pn = u.pn;
        const int cw = 32 * wc + 8 * fq;
        const int rowb = u.pm * 256 + wr * 64 + fr;
        float rsv[8];
        { const float* rsp = (kind == KD_KVX) ? rsmem : rs0;
#pragma unroll
          for (int q = 0; q < 8; ++q) rsv[q] = rsp[rowb + (q >> 2) * 128 + (q & 3) * 16] * sc; }
        const bool rotqk = (kind == KD_Q || kind == KD_K) && (wc == 0);
        const bool roti = (kind == KD_QI && ((wc & 1) == 0) && fq < 2) || (kind == KD_KI && wc == 0 && fq < 2);
#pragma unroll
        for (int ai = 0; ai < 2; ++ai) {
            f32x4 cs[4], sn[4];
#pragma unroll
            for (int q = 0; q < 4; ++q) { cs[q] = (f32x4){1.f, 1.f, 1.f, 1.f}; sn[q] = (f32x4){0.f, 0.f, 0.f, 0.f}; }
            if (rotqk) {
#pragma unroll
                for (int q = 0; q < 4; ++q) { const float* tp = ropeqk + (size_t)(rowb + ai * 128 + q * 16) * 32 + 4 * fq; cs[q] = *(const f32x4*)tp; sn[q] = *(const f32x4*)(tp + 16); }
            } else if (roti) {
#pragma unroll
                for (int q = 0; q < 4; ++q) { const float* tp = ropei + (size_t)(rowb + ai * 128 + q * 16) * 16 + 4 * fq; cs[q] = *(const f32x4*)tp; sn[q] = *(const f32x4*)(tp + 8); }
            }
#pragma unroll
            for (int m = 0; m < 4; ++m) {
                const int row = rowb + ai * 128 + m * 16, q = m;
                const float rs = rsv[ai * 4 + m];
                if (kind == KD_KVX) {
                    bf16_t* o = (pn < 2 ? kx : vx) + (size_t)row * 512 + 256 * (pn & 1) + cw;
#pragma unroll
                    for (int bj = 0; bj < 2; ++bj) st_bf16x8(o + 128 * bj, acc[ai][bj][m][0] * rs, acc[ai][bj][m][1] * rs);
                } else if (kind == KD_A) {
                    f32x4 o0, o1;
#pragma unroll
                    for (int j = 0; j < 4; ++j) { o0[j] = acc[ai][0][m][0][j] * rs * sigmoidf_(acc[ai][1][m][0][j] * rs); o1[j] = acc[ai][0][m][1][j] * rs * sigmoidf_(acc[ai][1][m][1][j] * rs); }
                    st_bf16x8(abuf + (size_t)row * DM + 128 * (pn - TL_A) + cw, o0, o1);
                } else if (kind == KD_P) {
                    const float r2 = rs * rs;
                    st_bf16x8(pbuf + (size_t)row * DM + 128 * (pn - TL_P) + cw, acc[ai][0][m][0] * acc[ai][1][m][0] * r2, acc[ai][0][m][1] * acc[ai][1][m][1] * r2);
                } else if (kind == KD_G) {
#pragma unroll
                    for (int bj = 0; bj < 2; ++bj) { f32x4 o0, o1;
#pragma unroll
                        for (int j = 0; j < 4; ++j) { o0[j] = sigmoidf_(acc[ai][bj][m][0][j] * rs); o1[j] = sigmoidf_(acc[ai][bj][m][1][j] * rs); }
                        st_bf16x8(gabuf + (size_t)row * DM + 256 * (pn - TL_G) + 128 * bj + cw, o0, o1); }
                } else if (kind == KD_Q || kind == KD_K) {
                    bf16_t* o = (kind == KD_Q) ? qb + (size_t)row * DM + 256 * (pn - TL_Q) + cw : kb + (size_t)row * 512 + 256 * (pn - TL_K) + cw;
#pragma unroll
                    for (int bj = 0; bj < 2; ++bj) {
                        const f32x4 x1 = acc[ai][bj][m][0] * rs, x2 = acc[ai][bj][m][1] * rs;
                        if (rotqk) st_bf16x8(o + 128 * bj, x1 * cs[q] - x2 * sn[q], x2 * cs[q] + x1 * sn[q]);
                        else st_bf16x8(o + 128 * bj, x1, x2);
                    }
                } else if (kind == KD_V) {
#pragma unroll
                    for (int bj = 0; bj < 2; ++bj) st_bf16x8(vb + (size_t)row * 512 + 256 * (pn - TL_V) + 128 * bj + cw, acc[ai][bj][m][0] * rs, acc[ai][bj][m][1] * rs);
                } else if (kind == KD_QI) {
#pragma unroll
                    for (int bj = 0; bj < 2; ++bj) {
                        const f32x4 x1 = acc[ai][bj][m][0] * rs, x2 = acc[ai][bj][m][1] * rs;
                        bf16_t* o = qib + (size_t)row * 1024 + 256 * (pn - TL_QI) + 128 * bj + cw;
                        if (roti) st_bf16x8(o, x1 * cs[q] - x2 * sn[q], x2 * cs[q] + x1 * sn[q]); else st_bf16x8(o, x1, x2);
                    }
                } else {
                    const f32x4 x1 = acc[ai][0][m][0] * rs, x2 = acc[ai][0][m][1] * rs;
                    if (wc < 2) {
                        if (roti) st_bf16x8(kib + (size_t)row * 64 + cw, x1 * cs[q] - x2 * sn[q], x2 * cs[q] + x1 * sn[q]);
                        else st_bf16x8(kib + (size_t)row * 64 + cw, x1, x2);
                    } else if (wc == 2 && fq < 2) {
                        *(f32x4*)(wib + (size_t)row * 16 + 8 * fq) = x1 * 0.03125f; *(f32x4*)(wib + (size_t)row * 16 + 8 * fq + 4) = x2 * 0.03125f;
                    }
                }
            }
        }
    }
};

struct SchedDense { int G, c, nM, nN; const char* A; const char* Bt; size_t tstep;
    __device__ __forceinline__ bool next(int i, Unit& u) const {
        const int L = i * G + c; if (L >= nM * nN) return false;
        int pm, pn; pg8::tile_of(L, nM, nN, pm, pn); u.pm = pm; u.pn = pn; u.a = A + (size_t)pm * tstep; u.b = Bt + (size_t)pn * tstep; u.kind = 0; u.aux = 0; return true; }
};
template <bool RF32>
struct EpiResid { const void* resid; bf16_t* hb; float* ss;
    struct Pre { };
    __device__ __forceinline__ Pre pre(const Unit&, int, int, int, int) const { return Pre{}; }
    __device__ __forceinline__ void operator()(const f32x4 (&acc)[2][2][4][2], const Unit& u, int wr, int wc, int fr, int fq, const Pre&) const {
        const size_t off0 = (size_t)(u.pm * 256 + wr * 64 + fr) * DM + u.pn * 256 + 32 * wc + 8 * fq;
#pragma unroll
        for (int ai = 0; ai < 2; ++ai) {
            f32x4 r0[4][2], r1[4][2];
#pragma unroll
            for (int m = 0; m < 4; ++m)
#pragma unroll
                for (int bj = 0; bj < 2; ++bj) {
                    const size_t off = off0 + (size_t)(ai * 128 + m * 16) * DM + 128 * bj;
                    if (RF32) { r0[m][bj] = *(const f32x4*)((const float*)resid + off); r1[m][bj] = *(const f32x4*)((const float*)resid + off + 4); }
                    else { const u32x4 rb = *(const u32x4*)((const bf16_t*)resid + off);
                        r0[m][bj] = (f32x4){bf_lo(rb.x), bf_hi(rb.x), bf_lo(rb.y), bf_hi(rb.y)}; r1[m][bj] = (f32x4){bf_lo(rb.z), bf_hi(rb.z), bf_lo(rb.w), bf_hi(rb.w)}; }
                }
#pragma unroll
            for (int m = 0; m < 4; ++m) {
                const int row = u.pm * 256 + ai * 128 + wr * 64 + m * 16 + fr; float sq = 0.f;
#pragma unroll
                for (int bj = 0; bj < 2; ++bj) {
                    const size_t off = off0 + (size_t)(ai * 128 + m * 16) * DM + 128 * bj;
                    const f32x4 v0 = acc[ai][bj][m][0] + r0[m][bj], v1 = acc[ai][bj][m][1] + r1[m][bj];
                    st_bf16x8(hb + off, v0, v1);
                    sq += v0[0] * v0[0] + v0[1] * v0[1] + v0[2] * v0[2] + v0[3] * v0[3] + v1[0] * v1[0] + v1[1] * v1[1] + v1[2] * v1[2] + v1[3] * v1[3];
                }
                if (ss) { sq += __shfl_xor(sq, 16); sq += __shfl_xor(sq, 32); if (fq == 0) atomicAdd(ss + row, sq); }
            }
        }
    }
};

struct EpiScaleBf16 { const float* ss; bf16_t* out; int ldo;
    struct Pre { float rsv[8]; };
    __device__ __forceinline__ Pre pre(const Unit& u, int wr, int wc, int fr, int fq) const {
        Pre p;
#pragma unroll
        for (int q = 0; q < 8; ++q) p.rsv[q] = ss[u.pm * 256 + (q >> 2) * 128 + wr * 64 + (q & 3) * 16 + fr];
        return p;
    }
    __device__ __forceinline__ void operator()(const f32x4 (&acc)[2][2][4][2], const Unit& u, int wr, int wc, int fr, int fq, const Pre& pr) const {
        const float (&rsv)[8] = pr.rsv;
#pragma unroll
        for (int ai = 0; ai < 2; ++ai)
#pragma unroll
            for (int m = 0; m < 4; ++m) {
                const int row = u.pm * 256 + ai * 128 + wr * 64 + m * 16 + fr; const float rs = __builtin_amdgcn_rsqf(rsv[ai * 4 + m] * (1.0f / DM) + NORM_EPS);
#pragma unroll
                for (int bj = 0; bj < 2; ++bj) st_bf16x8(out + (size_t)row * ldo + u.pn * 256 + 128 * bj + 32 * wc + 8 * fq, acc[ai][bj][m][0] * rs, acc[ai][bj][m][1] * rs);
            }
    }
};

namespace att {
constexpr int D = 128, NW = 8, QBLK = 32, KVBLK = 64, QB = NW * QBLK;
constexpr int SHM_V = KVBLK * D * 2, SHM_K = KVBLK * D * 2;
constexpr int LDS_QOFF = 2 * SHM_V + 2 * SHM_K + NW * 64 * 4;
constexpr int LDS_BYTES_ATT = LDS_QOFF + NW * 8192;
static_assert(LDS_BYTES_ATT <= 135168, "attention LDS map");
constexpr float SCALE = 0.08838834764831845f;
constexpr float THR = 8.f;
typedef short s16x4 __attribute__((ext_vector_type(4)));
#define KSWZ(row, colB) ((row) * 256 + ((colB) ^ (((row) & 7) << 4)))
#define SBAR() __builtin_amdgcn_sched_barrier(0)
__device__ __forceinline__ int v_st(int k, int c) { const int kk = (k & ~0xC) | ((k & 4) << 1) | ((k & 8) >> 1); return ((kk >> 3) * 4 + (c >> 5)) * 512 + ((kk & 7) * 32 + (c & 31)) * 2; }
__device__ __forceinline__ int v_rd_base(int lane) { return ((lane & 3) << 3) | (((lane >> 2) & 3) << 6) | (((lane >> 4) & 1) << 5) | (((lane >> 5) & 1) << 8); }
constexpr int v_rd_off(int d0, int ks, int half) { return d0 * 512 + ks * 4096 + half * 2048; }
__device__ __forceinline__ int crow(int r, int hi) { return (r & 3) + 8 * (r >> 2) + 4 * hi; }
__device__ __forceinline__ bf16x8 load8(const bf16_t* p) { return *reinterpret_cast<const bf16x8*>(p); }
__device__ __forceinline__ void mask_tile(f32x16& p0, f32x16& p1, int dq, unsigned W) {
    const float NEG = -__builtin_inff();
#pragma unroll
    for (int r = 0; r < 16; ++r) {
        const int c = (r & 3) + 8 * (r >> 2);
        if ((unsigned)(dq - c) >= W) p0[r] = NEG;
        if ((unsigned)(dq - c - 32) >= W) p1[r] = NEG;
    }
}
template <bool SEL>
__device__ __forceinline__ void partialSM(f32x16& p0, f32x16& p1, float& m_reg, float& mn, float& alpha, unsigned selw) {
    float pmax = p0[0];
#pragma unroll
    for (int r = 1; r < 16; ++r) pmax = fmaxf(pmax, p0[r]);
#pragma unroll
    for (int r = 0; r < 16; ++r) pmax = fmaxf(pmax, p1[r]);
    { auto rr = __builtin_amdgcn_permlane32_swap(__float_as_uint(pmax), __float_as_uint(pmax), false, false);
      pmax = fmaxf(__uint_as_float(rr[0]), __uint_as_float(rr[1])); }
    constexpr float C2 = 1.4426950408889634f * SCALE;
    if (__builtin_expect(__all((pmax - m_reg) * SCALE <= THR), 1)) { mn = m_reg; alpha = 1.f; }
    else { mn = fmaxf(m_reg, pmax); alpha = __builtin_amdgcn_exp2f((m_reg - mn) * C2); m_reg = mn; }
    const float mnL = -mn * C2;
#pragma unroll
    for (int r = 0; r < 16; ++r) p0[r] = fmaf(p0[r], C2, mnL);
#pragma unroll
    for (int r = 0; r < 16; ++r) p1[r] = fmaf(p1[r], C2, mnL);
#pragma unroll
    for (int r = 0; r < 16; ++r) p0[r] = __builtin_amdgcn_exp2f(p0[r]);
    if (SEL) {
#pragma unroll
        for (int r = 0; r < 16; ++r) p0[r] = __uint_as_float(__float_as_uint(p0[r]) & (unsigned)__builtin_amdgcn_sbfe((int)selw, r, 1));
    }
}
template <bool SEL>
__device__ __forceinline__ void finishSM(f32x16& p0, f32x16& p1, float alpha, float& l_reg, bf16x8& pa0, bf16x8& pa1, bf16x8& pa2, bf16x8& pa3, unsigned selw) {
#pragma unroll
    for (int r = 0; r < 16; ++r) p1[r] = __builtin_amdgcn_exp2f(p1[r]);
    if (SEL) {
#pragma unroll
        for (int r = 0; r < 16; ++r) p1[r] = __uint_as_float(__float_as_uint(p1[r]) & (unsigned)__builtin_amdgcn_sbfe((int)selw, 16 + r, 1));
    }
    float ps = 0;
#pragma unroll
    for (int r = 0; r < 16; ++r) ps += p0[r];
#pragma unroll
    for (int r = 0; r < 16; ++r) ps += p1[r];
    { auto rr = __builtin_amdgcn_permlane32_swap(__float_as_uint(ps), __float_as_uint(ps), false, false);
      ps = __uint_as_float(rr[0]) + __uint_as_float(rr[1]); }
    l_reg = l_reg * alpha + ps;
#define PK4(P, B_, OUT) do { unsigned a0 = cvt_pk_bf16(P[B_+0], P[B_+1]), a1 = cvt_pk_bf16(P[B_+2], P[B_+3]);                          \
        unsigned b0 = cvt_pk_bf16(P[B_+4], P[B_+5]), b1 = cvt_pk_bf16(P[B_+6], P[B_+7]);                                             \
        auto r0 = __builtin_amdgcn_permlane32_swap(a0, b0, false, false); auto r1 = __builtin_amdgcn_permlane32_swap(a1, b1, false, false); \
        u32x4 w = {r0[0], r1[0], r0[1], r1[1]}; OUT = *reinterpret_cast<bf16x8*>(&w); } while (0)
    PK4(p0, 0, pa0); PK4(p0, 8, pa1); PK4(p1, 0, pa2); PK4(p1, 8, pa3);
#undef PK4
}
template <int KB, int QREG>
__device__ __forceinline__ void qkt(f32x16& p0, f32x16& p1, const char* K_lds, int r32, int hi, const bf16x8* qr, const char* qlds) {
    p0 = f32x16{}; p1 = f32x16{};
    const char* kb[4];
#pragma unroll
    for (int dd = 0; dd < 4; ++dd) kb[dd] = K_lds + KB * SHM_K + KSWZ(r32, (dd * 16 + hi * 8) * 2);
#pragma unroll
    for (int d0 = 0; d0 < 8; ++d0) { const char* a = kb[d0 & 3] + (d0 >> 2) * 128;
        bf16x8 b0 = *reinterpret_cast<const bf16x8*>(a);
        bf16x8 b1 = *reinterpret_cast<const bf16x8*>(a + 32 * 256);
        const bf16x8 qf = (d0 < QREG) ? qr[d0 < QREG ? d0 : 0] : *reinterpret_cast<const bf16x8*>(qlds + (d0 - QREG) * 1024);
        p0 = __builtin_amdgcn_mfma_f32_32x32x16_bf16(b0, qf, p0, 0, 0, 0);
        p1 = __builtin_amdgcn_mfma_f32_32x32x16_bf16(b1, qf, p1, 0, 0, 0); }
}
template <int VB>
__device__ __forceinline__ void pv_tile(f32x16* o, int vb0, bf16x8 pa0, bf16x8 pa1, bf16x8 pa2, bf16x8 pa3) {
#define TRRD(dst, off) asm volatile("ds_read_b64_tr_b16 %0, %1 offset:%2" : "=&v"(dst) : "v"(vb0), "i"(off) : "memory")
#define PV_D0(d0) do { s16x4 l0, l1, l2, l3, h0, h1, h2, h3; constexpr int b_ = VB * SHM_V + v_rd_off(d0, 0, 0); \
        TRRD(l0, b_); TRRD(h0, b_ + 2048); TRRD(l1, b_ + 4096); TRRD(h1, b_ + 6144); TRRD(l2, b_ + 8192); TRRD(h2, b_ + 10240); TRRD(l3, b_ + 12288); TRRD(h3, b_ + 14336); \
        asm volatile("s_waitcnt lgkmcnt(0)" ::: "memory"); SBAR(); \
        o[d0] = __builtin_amdgcn_mfma_f32_32x32x16_bf16(pa0, (bf16x8){l0[0], l0[1], l0[2], l0[3], h0[0], h0[1], h0[2], h0[3]}, o[d0], 0, 0, 0);   \
        o[d0] = __builtin_amdgcn_mfma_f32_32x32x16_bf16(pa1, (bf16x8){l1[0], l1[1], l1[2], l1[3], h1[0], h1[1], h1[2], h1[3]}, o[d0], 0, 0, 0);   \
        o[d0] = __builtin_amdgcn_mfma_f32_32x32x16_bf16(pa2, (bf16x8){l2[0], l2[1], l2[2], l2[3], h2[0], h2[1], h2[2], h2[3]}, o[d0], 0, 0, 0);   \
        o[d0] = __builtin_amdgcn_mfma_f32_32x32x16_bf16(pa3, (bf16x8){l3[0], l3[1], l3[2], l3[3], h3[0], h3[1], h3[2], h3[3]}, o[d0], 0, 0, 0); } while (0)
    PV_D0(0); PV_D0(1); PV_D0(2); PV_D0(3);
#undef PV_D0
#undef TRRD
}
struct BlockRef { const bf16_t* Q; const bf16_t* K; const bf16_t* V; bf16_t* O; const unsigned* M; int P0; };
struct MergeArgs { unsigned char* ws; const float* cw; };
struct Seam { bf16x8 qr[8]; bf16x8 st_v0, st_v1, st_k0, st_k1; };
__device__ __forceinline__ int swa_jlo(int P0, int W) { const int lowk = P0 - W + 1; return lowk > 0 ? lowk / KVBLK : 0; }
#define ROW(p, k0, rr) ((p) + (size_t)((k0) + (rr)) * KS + sc)
#define VMW() asm volatile("s_waitcnt vmcnt(0)" ::: "memory")
#define VMWN(n) asm volatile("s_waitcnt vmcnt(%0)" :: "i"(n) : "memory")
#define SLOAD_H(Kp, Vp, k0) do { S.st_v0 = load8(ROW(Vp, k0, sr)); S.st_v1 = load8(ROW(Vp, k0, 32 + sr));              \
                         S.st_k0 = load8(ROW(Kp, k0, sr)); S.st_k1 = load8(ROW(Kp, k0, 32 + sr)); } while (0)
#define SWRITE_HK(bf) do { *(bf16x8*)(K_lds + (bf) * SHM_K + kws) = S.st_k0; *(bf16x8*)(K_lds + (bf) * SHM_K + kws + 32 * 256) = S.st_k1; } while (0)
#define SWRITE_HV(bf) do { *(bf16x8*)(V_lds + (bf) * SHM_V + vst0) = S.st_v0; *(bf16x8*)(V_lds + (bf) * SHM_V + vst1) = S.st_v1; } while (0)
#define SWRITE_H(bf) do { SWRITE_HV(bf); SWRITE_HK(bf); } while (0)
template <int QS, int KS>
__device__ __forceinline__ void attn_prime(const BlockRef& cur, int W, char* lds, Seam& S, const int wid) {
    const int lane = lane_id(), tid = wid * 64 + lane, r32 = lane & 31, hi = lane >> 5;
    const int sr = tid >> 4, sc = (tid & 15) * 8, kws = KSWZ(sr, sc * 2); char* K_lds = lds + 2 * SHM_V;
    const int kb0 = swa_jlo(cur.P0, W) * KVBLK;
#pragma unroll
    for (int d0 = 0; d0 < 8; ++d0) S.qr[d0] = load8(cur.Q + (size_t)(wid * QBLK + r32) * QS + d0 * 16 + hi * 8);
    SLOAD_H(cur.K, cur.V, kb0); VMW(); SWRITE_HK(0);
    __syncthreads();
}
template <int QS, int KS, int OS, bool SEL, int QREG, bool MERGE>
__device__ __forceinline__ void attn_block(const BlockRef& cur, const BlockRef& nxt, int skv, int W, char* lds, Seam& S, const MergeArgs& MG, const int wid) {
    const int lane = lane_id(), tid = wid * 64 + lane, r32 = lane & 31, hi = lane >> 5;
    const int j_lo = swa_jlo(cur.P0, W);
    int j_hi = (cur.P0 + QB - 1) / KVBLK + 1; if (j_hi > skv / KVBLK) j_hi = skv / KVBLK;
    const int NT = j_hi - j_lo;
    const int kbn = swa_jlo(nxt.P0, W) * KVBLK;
    const int qlo = cur.P0 + wid * QBLK, qm = qlo + r32 - 4 * hi;
    char* V_lds = lds; char* K_lds = lds + 2 * SHM_V;
    float* ws = (float*)(lds + 2 * SHM_V + 2 * SHM_K) + wid * 64; float* li_l = ws, * al_l = ws + 32;
    float m_reg = -1e30f, l_reg = 0; f32x16 o[4] = {};
    const int sr = tid >> 4, sc = (tid & 15) * 8, vst0 = v_st(sr, sc), vst1 = v_st(32 + sr, sc), kws = KSWZ(sr, sc * 2);
    const int vb0 = (int)(uintptr_t)V_lds + v_rd_base(lane);
    const bf16_t* Kh = cur.K; const bf16_t* Vh = cur.V;
    const unsigned moff = (unsigned)((wid * QBLK + r32) * 128 + hi);
#define RESC(a) do { if (__any((a) < 1.f)) { if (hi == 0) al_l[r32] = (a); asm volatile("s_waitcnt lgkmcnt(0)" ::: "memory");              \
                     for (int d_ = 0; d_ < 4; ++d_) for (int r = 0; r < 16; ++r) o[d_][r] *= al_l[crow(r, hi)]; } } while (0)
#define KBASE(t) ((j_lo + (t)) * KVBLK)
#define MLOAD(t) (SEL ? cur.M[moff + 2u * (unsigned)(j_lo + (t))] : 0u)
#define MASKT(P0_, P1_, t) do { } while (0)
    constexpr int NQL = 8;
#define SEAM_K0() do { VMWN(NQL); SWRITE_HK(0); SBAR(); } while (0)
    f32x16 pA0, pA1, pB0, pB1; float mnA, mnB, alA, alB; bf16x8 pa0, pa1, pa2, pa3; unsigned mwA = 0u, mwB = 0u;
    const char* qlds = lds + LDS_QOFF + wid * 8192 + lane * 16;
    if (QREG < 8) {
#pragma unroll
        for (int d0 = QREG; d0 < 8; ++d0) *(bf16x8*)(lds + LDS_QOFF + wid * 8192 + lane * 16 + (d0 - QREG) * 1024) = S.qr[d0];
    }
    SWRITE_HV(0); SBAR();
    mwA = MLOAD(0);
    if (NT > 1) { SLOAD_H(Kh, Vh, KBASE(1)); }
    SBAR(); qkt<0, QREG>(pA0, pA1, K_lds, r32, hi, S.qr, qlds);
    MASKT(pA0, pA1, 0); partialSM<SEL>(pA0, pA1, m_reg, mnA, alA, mwA);
    if (NT > 1) { VMW(); SWRITE_H(1); }
    __syncthreads();
#define HALF_STEP(PX0, PX1, mnX, alX, mwX, PY0, PY1, alY, mwY, t, KB, VB, SB) do {                                            \
        SBAR(); qkt<KB, QREG>(PX0, PX1, K_lds, r32, hi, S.qr, qlds);                                                                     \
        finishSM<SEL>(PY0, PY1, alY, l_reg, pa0, pa1, pa2, pa3, mwY); SBAR();                                                 \
        mwX = MLOAD(t);                                                                                                       \
        if ((t) + 1 < NT) { SLOAD_H(Kh, Vh, KBASE((t) + 1)); SBAR(); }                                                        \
        pv_tile<VB>(o, vb0, pa0, pa1, pa2, pa3); MASKT(PX0, PX1, (t)); partialSM<SEL>(PX0, PX1, m_reg, mnX, alX, mwX);        \
        __syncthreads();                                                                                                      \
        if ((t) + 1 < NT) { VMW(); SWRITE_H(SB); }                                                                            \
        RESC(alX); __syncthreads(); } while (0)
    for (int t = 1; t + 1 < NT; t += 2) {
        HALF_STEP(pB0, pB1, mnB, alB, mwB, pA0, pA1, alA, mwA, t, 1, 0, 0);
        HALF_STEP(pA0, pA1, mnA, alA, mwA, pB0, pB1, alB, mwB, t + 1, 0, 1, 1);
    }
    const bool even = (NT & 1) == 0;
    if (even) { SBAR(); mwB = MLOAD(NT - 1); qkt<1, QREG>(pB0, pB1, K_lds, r32, hi, S.qr, qlds); SBAR(); }
    SLOAD_H(nxt.K, nxt.V, kbn); SBAR();
#pragma unroll
    for (int d0 = 0; d0 < 8; ++d0) S.qr[d0] = load8(nxt.Q + (size_t)(wid * QBLK + r32) * QS + d0 * 16 + hi * 8);
    SBAR();
    finishSM<SEL>(pA0, pA1, alA, l_reg, pa0, pa1, pa2, pa3, mwA); SBAR();
    pv_tile<0>(o, vb0, pa0, pa1, pa2, pa3);
    if (even) { MASKT(pB0, pB1, NT - 1); partialSM<SEL>(pB0, pB1, m_reg, mnB, alB, mwB); __syncthreads(); RESC(alB);
        finishSM<SEL>(pB0, pB1, alB, l_reg, pa0, pa1, pa2, pa3, mwB); SBAR(); pv_tile<1>(o, vb0, pa0, pa1, pa2, pa3); }
    SBAR(); SEAM_K0();
    if (hi == 0) li_l[r32] = l_reg; asm volatile("s_waitcnt lgkmcnt(0)" ::: "memory");
    float rli[16];
#pragma unroll
    for (int r = 0; r < 16; ++r) rli[r] = __builtin_amdgcn_rcpf(li_l[crow(r, hi)]);
    {
        char* stg = lds + LDS_QOFF + wid * 8192;
#pragma unroll
        for (int r = 0; r < 16; ++r) { const int orow = crow(r, hi);
#pragma unroll
            for (int d0 = 0; d0 < 4; ++d0) { const float v = o[d0][r] * rli[r];
                const float vn = __shfl_xor(v, 1);
                if ((r32 & 1) == 0) *(unsigned*)(stg + orow * 256 + (d0 * 32 + r32) * 2) = cvt_pk_bf16(v, vn); } }
        asm volatile("s_waitcnt lgkmcnt(0)" ::: "memory");
        const int ch = lane & 15, rq = lane >> 4;
        if (!MERGE) {
            bf16_t* Ow = cur.O + (size_t)(wid * QBLK) * OS + ch * 8;
#pragma unroll
            for (int p = 0; p < 8; ++p) { const int row = 4 * p + rq; *(u32x4*)(Ow + (size_t)row * OS) = *(const u32x4*)(stg + row * 256 + ch * 16); }
        } else {
            const bf16_t* Obase = (const bf16_t*)(MG.ws + WS_YATT); const bf16_t* MA = (const bf16_t*)(MG.ws + WS_ABUF); const bf16_t* MP = (const bf16_t*)(MG.ws + WS_PBUF);
            const bf16_t* MGA = (const bf16_t*)(MG.ws + WS_GABUF); bf16_t* MOUT = (bf16_t*)(MG.ws + WS_MERGED);
            const size_t eoff = (size_t)(cur.O - Obase) + (size_t)(wid * QBLK) * OS + ch * 8;
            const int colg = (int)((cur.O - Obase) % OS) + ch * 8;
            float w0[8], w1[8], w2[8];
#pragma unroll
            for (int j = 0; j < 8; ++j) { w0[j] = MG.cw[colg + j]; w1[j] = MG.cw[OS + colg + j]; w2[j] = MG.cw[2 * OS + colg + j]; }
            u32x4 ca, cga, cp2, cp1, cp0, na, nga, np2, np1, np0;
#define MG_LOAD(p_, A_, GA_, P2_, P1_, P0_) do { const int row_ = 4 * (p_) + rq, spos_ = cur.P0 + wid * QBLK + row_; const size_t e_ = eoff + (size_t)row_ * OS; \
                A_ = *(const u32x4*)(MA + e_); GA_ = *(const u32x4*)(MGA + e_); P2_ = *(const u32x4*)(MP + e_); \
                P1_ = (u32x4){0u, 0u, 0u, 0u}; P0_ = (u32x4){0u, 0u, 0u, 0u}; \
                if (spos_ >= 1) P1_ = *(const u32x4*)(MP + e_ - OS); if (spos_ >= 2) P0_ = *(const u32x4*)(MP + e_ - 2 * OS); } while (0)
            MG_LOAD(0, ca, cga, cp2, cp1, cp0);
#pragma unroll 1
            for (int p = 0; p < 8; ++p) {
                const int row = 4 * p + rq;
                const size_t e = eoff + (size_t)row * OS;
                const u32x4 y = *(const u32x4*)(stg + row * 256 + ch * 16);
                if (p < 7) MG_LOAD(p + 1, na, nga, np2, np1, np0);
                float ov[8];
#pragma unroll
                for (int j = 0; j < 4; ++j) {
                    ov[2 * j] = bf_lo(ca[j]) * (w0[2 * j] * bf_lo(cp0[j]) + w1[2 * j] * bf_lo(cp1[j]) + w2[2 * j] * bf_lo(cp2[j])) + bf_lo(cga[j]) * bf_lo(y[j]);
                    ov[2 * j + 1] = bf_hi(ca[j]) * (w0[2 * j + 1] * bf_hi(cp0[j]) + w1[2 * j + 1] * bf_hi(cp1[j]) + w2[2 * j + 1] * bf_hi(cp2[j])) + bf_hi(cga[j]) * bf_hi(y[j]);
                }
                u32x4 wv_; wv_.x = cvt_pk_bf16(ov[0], ov[1]); wv_.y = cvt_pk_bf16(ov[2], ov[3]); wv_.z = cvt_pk_bf16(ov[4], ov[5]); wv_.w = cvt_pk_bf16(ov[6], ov[7]);
                *(u32x4*)(MOUT + e) = wv_;
                ca = na; cga = nga; cp2 = np2; cp1 = np1; cp0 = np0;
            }
#undef MG_LOAD
        }
    }
    __syncthreads();
#undef RESC
#undef KBASE
#undef MLOAD
#undef MASKT
#undef SEAM_K0
#undef HALF_STEP
}
#undef ROW
#undef VMW
#undef VMWN
#undef SLOAD_H
#undef SWRITE_HK
#undef SWRITE_HV
#undef SWRITE_H

enum { ORDER_NATURAL = 0, ORDER_PAIRED = 2, ORDER_XCD = 4, ORDER_LPT = 8 };
struct AttnItem { int bh, qb0, qb1; };
__device__ __forceinline__ AttnItem attn_decode(int L, int nb, int nh, int nhkv, int nqb, int nx, int order) {
    const int G = nh / nhkv; AttnItem it; int x;
    if ((order & ORDER_XCD) && (nb * nhkv) % 8 == 0) { const int xcd = L & 7, k = L >> 3, per = G * nx, gi = k / per, r = k - gi * per;
        it.bh = (gi * 8 + xcd) * G + r / nx; x = r % nx; }
    else { it.bh = L / nx; x = L - it.bh * nx; }
    if (order & ORDER_PAIRED) { it.qb0 = x; it.qb1 = nqb - 1 - x; }
    else { it.qb0 = it.qb1 = x; }
    return it;
}
struct AttnTensors { const bf16_t* Q; const bf16_t* K; const bf16_t* V; bf16_t* O; const unsigned* M; };
template <int QS, int KS, int OS>
__device__ __forceinline__ BlockRef attn_ref(const AttnItem& it, int pass, const AttnTensors& X, int nh, int nhkv, int sq, int skv, int p0base) {
    const int qb = pass ? it.qb1 : it.qb0, b = it.bh / nh, h = it.bh - b * nh, kvh = h / (nh / nhkv);
    BlockRef r; const size_t t0 = (size_t)b * sq + (size_t)qb * QB;
    r.Q = X.Q + t0 * QS + h * D; r.O = X.O + t0 * OS + h * D;
    r.K = X.K + (size_t)b * skv * KS + kvh * D; r.V = X.V + (size_t)b * skv * KS + kvh * D;
    r.M = X.M ? X.M + t0 * 128 : nullptr; r.P0 = p0base + qb * QB;
    return r;
}
__device__ __forceinline__ int attn_kmax(int stride, int order, int nb, int nh, int nhkv, int nqb, int nx) {
    if (order & ORDER_LPT) { const int G = nh / nhkv, rg = (G * nqb + stride - 1) / stride; return rg * (nb * nhkv / 8); }
    return (nx * nb * nh + stride - 1) / stride;
}
__device__ __forceinline__ bool attn_item_at(int k, int first, int stride, int order, int nb, int nh, int nhkv, int nqb, int nx, AttnItem& it) {
    if (order & ORDER_LPT) {
        const int x = first & 7, slot = first >> 3, G = nh / nhkv, nblk = G * nqb, rg = (nblk + stride - 1) / stride;
        const int gi = k / rg, kk = k - gi * rg, sl = (gi & 1) ? stride - 1 - slot : slot;
        const int pos = (kk & 1) ? stride - 1 - sl : sl, s = kk * stride + pos;
        if (s >= nblk) return false;
        it.bh = (gi * 8 + x) * G + (s % G); it.qb0 = it.qb1 = nqb - 1 - s / G; return true;
    }
    const int L = first + k * stride; if (L >= nx * nb * nh) return false;
    it = attn_decode(L, nb, nh, nhkv, nqb, nx, order); return true;
}
template <int QS, int KS, int OS, bool SEL, int QREG, bool MERGE>
__device__ __forceinline__ void attn_phase(char* lds, const AttnTensors& X, const MergeArgs& MG, int nb, int nh, int nhkv, int sq, int skv, int p0base, int order, int stride, int first, const int wid) {
    const int W = 1 << 30;
    const int nqb = sq / QB, nx = (order & ORDER_PAIRED) ? nqb / 2 : nqb;
    AttnItem it; int k = 0, pass = 0; const int kmax = attn_kmax(stride, order, nb, nh, nhkv, nqb, nx);
    while (k < kmax && !attn_item_at(k, first, stride, order, nb, nh, nhkv, nqb, nx, it)) ++k;
    if (k >= kmax) return;
    BlockRef cur = attn_ref<QS, KS, OS>(it, 0, X, nh, nhkv, sq, skv, p0base);
    Seam S;
    attn_prime<QS, KS>(cur, W, lds, S, wid);
    for (;;) {
        const bool more_pass = pass == 0 && it.qb1 != it.qb0;
        AttnItem itn = it; int passn = pass + 1, kn = k; bool last = false;
        if (!more_pass) { passn = 0; kn = k + 1; while (kn < kmax && !attn_item_at(kn, first, stride, order, nb, nh, nhkv, nqb, nx, itn)) ++kn; if (kn >= kmax) { last = true; itn = it; kn = k; } }
        const BlockRef nxt = last ? cur : attn_ref<QS, KS, OS>(itn, passn, X, nh, nhkv, sq, skv, p0base);
        attn_block<QS, KS, OS, SEL, QREG, MERGE>(cur, nxt, skv, W, lds, S, MG, wid);
        if (last) break;
        cur = nxt; it = itn; pass = passn; k = kn;
    }
    asm volatile("s_waitcnt vmcnt(0)" ::: "memory");
    __syncthreads();
}
}


namespace ix {
constexpr int KCH = 256;
constexpr int BUFB = KCH * 128;
template <int CTRL> __device__ __forceinline__ int dpp_mov(int v) { return __builtin_amdgcn_update_dpp(0, v, CTRL, 0xF, 0xF, true); }
__device__ __forceinline__ int half_sum(int v) {
    v += dpp_mov<0xB1>(v); v += dpp_mov<0x4E>(v); v += dpp_mov<0x141>(v); v += dpp_mov<0x140>(v);
    return v + __shfl_xor(v, 16);
}
__device__ __forceinline__ float half_min(float v) {
    v = fminf(v, __int_as_float(dpp_mov<0xB1>(__float_as_int(v)))); v = fminf(v, __int_as_float(dpp_mov<0x4E>(__float_as_int(v))));
    v = fminf(v, __int_as_float(dpp_mov<0x141>(__float_as_int(v)))); v = fminf(v, __int_as_float(dpp_mov<0x140>(__float_as_int(v))));
    return fminf(v, __shfl_xor(v, 16));
}
__device__ __forceinline__ float half_max(float v) {
    v = fmaxf(v, __int_as_float(dpp_mov<0xB1>(__float_as_int(v)))); v = fmaxf(v, __int_as_float(dpp_mov<0x4E>(__float_as_int(v))));
    v = fmaxf(v, __int_as_float(dpp_mov<0x141>(__float_as_int(v)))); v = fmaxf(v, __int_as_float(dpp_mov<0x140>(__float_as_int(v))));
    return fmaxf(v, __shfl_xor(v, 16));
}
__device__ __forceinline__ int excl_scan64(int v, int lane, int& total) {
    int s = v;
#pragma unroll
    for (int o = 1; o <= 32; o <<= 1) { const int t = __shfl_up(s, o); s += (lane >= o) ? t : 0; }
    total = __shfl(s, 63);
    return s - v;
}
__device__ __forceinline__ void tie_fix(unsigned& ge0, unsigned& ge1, unsigned gt0, unsigned gt1, int need, int lane) {
    unsigned eq0 = ge0 & ~gt0, eq1 = ge1 & ~gt1;
    const int c0 = __popc(eq0), c1 = __popc(eq1);
    int tot0, tot1; const int pre0 = excl_scan64(c0, lane, tot0); const int pre1 = tot0 + excl_scan64(c1, lane, tot1);
    int t0 = need - pre0; t0 = t0 < 0 ? 0 : (t0 > c0 ? c0 : t0);
    int t1 = need - pre1; t1 = t1 < 0 ? 0 : (t1 > c1 ? c1 : t1);
    while (__popc(eq0) > t0) eq0 &= ~(0x80000000u >> __clz(eq0));
    while (__popc(eq1) > t1) eq1 &= ~(0x80000000u >> __clz(eq1));
    ge0 = gt0 | eq0; ge1 = gt1 | eq1;
}
__device__ __forceinline__ unsigned nib16(unsigned w, int hi) {
    unsigned x = (w >> (4 * hi)) & 0x0F0F0F0Fu; x = (x | (x >> 4)) & 0x00FF00FFu; x = (x | (x >> 8)) & 0xFFFFu; return x;
}
__device__ __forceinline__ void store_row(unsigned* row, unsigned g0, unsigned g1, int lane) {
    const int hi = lane & 1, e = lane & ~1;
    const unsigned a0 = __shfl(g0, e), b0 = __shfl(g0, e + 1), a1 = __shfl(g1, e), b1 = __shfl(g1, e + 1);
    row[lane] = nib16(a0, hi) | (nib16(b0, hi) << 16);
    row[64 + lane] = nib16(a1, hi) | (nib16(b1, hi) << 16);
}
constexpr int LDS_SIDE = 65536;
__device__ __forceinline__ void indexer_phase(const Frame& F, const bf16_t* QI, const bf16_t* KI, const float* WI, unsigned* MASK, const pg8::SideConv& SD) {
    const int tid = F.tid_(), lane = F.lane_(), w = F.wave, r = lane & 31, hi = lane >> 5;
    LAS unsigned char* lds = F.lds;
    const float NEG = -__builtin_inff();
    int sq = 0, spar = 0; bool pend0 = false, pend1 = false; size_t pd0 = 0, pd1 = 0;
    for (int rnd = 0; rnd < 4; ++rnd) {
        const int p = (rnd & 1) ? (F.G - 1 - F.bid) : F.bid; const int sidx = rnd * F.G + p;
        if (sidx >= NB * (SEQ / 16)) continue;
        const int qg = (SEQ / 16 - 1) - (sidx >> 2), b = sidx & 3;
        const int q0 = qg * 16, nkeys = q0 + 16, nkt = (nkeys + 31) >> 5, nch = (nkeys + KCH - 1) / KCH;
        const size_t tb = (size_t)b * SEQ;
        const int tq = q0 + 2 * w + hi;
        bf16x8 afr[4];
        { const int qsel = (r >> 2) & 1, head = (r & 3) + 4 * (r >> 3);
          const bf16_t* qp = QI + (tb + q0 + 2 * w + qsel) * 1024 + head * 64 + 8 * hi;
#pragma unroll
          for (int s = 0; s < 4; ++s) afr[s] = *(const bf16x8*)(qp + 16 * s); }
        f32x4 wv[4];
#pragma unroll
        for (int i = 0; i < 4; ++i) wv[i] = *(const f32x4*)(WI + (tb + tq) * 16 + 4 * i);
        float sc[128];
#pragma unroll
        for (int i = 0; i < 128; ++i) sc[i] = NEG;
        const int skey = 8 * w + (lane >> 3), ssl = lane & 7;
        const bf16_t* ksrc = KI + (tb + skey) * 64 + ((ssl ^ ((skey >> 1) & 7)) * 8);
#define IX_STAGE(chunk, buf) do { _Pragma("unroll") for (int i = 0; i < 4; ++i) \
            __builtin_amdgcn_global_load_lds((const unsigned*)(ksrc + ((size_t)(chunk) * KCH + 64 * i) * 64), (LAS unsigned*)(lds + (buf) * BUFB + (64 * i + 8 * w) * 128), 16, 0, 0); } while (0)
        for (int rep22 = 0; rep22 < (REP_PHASE == 22 ? 2 : 1); ++rep22) {
        IX_STAGE(0, 0);
        asm volatile("s_waitcnt vmcnt(0)" ::: "memory");
        __syncthreads();
        int boff[4];
#pragma unroll
        for (int s = 0; s < 4; ++s) boff[s] = r * 128 + (((2 * s + hi) ^ ((r >> 1) & 7)) * 16);
        for (int c = 0; c < nch; ++c) {
            const bool more = (c + 1 < nch);
            if (more) IX_STAGE(c + 1, (c + 1) & 1);
            {   LAS unsigned char* told = lds + LDS_SIDE + (spar ^ 1) * 2 * 16640; LAS unsigned char* tnew = lds + LDS_SIDE + spar * 2 * 16640;
                if (pend0) SD.consume(told, pd0, w, lane);
                if (pend1) SD.consume(told + 16640, pd1, w, lane);
                const int ja = SD.j0 + sq * SD.G + SD.c, jb = ja + SD.G;
                pend0 = ja < SD.jn; pend1 = jb < SD.jn;
                if (pend0) { pd0 = SD.issue(ja, tnew, w, lane); ++sq; }
                if (pend1) { pd1 = SD.issue(jb, tnew + 16640, w, lane); ++sq; }
                spar ^= 1; }
            LAS unsigned char* kb = lds + (c & 1) * BUFB;
#pragma unroll
            for (int g = 0; g < 2; ++g) {
                float s4[4];
#pragma unroll
                for (int k4 = 0; k4 < 4; ++k4) {
                    const int k = g * 4 + k4, kt = c * 8 + k;
                    s4[k4] = NEG;
                    if (kt < nkt) {
                        f32x16 acc = {};
#pragma unroll
                        for (int s = 0; s < 4; ++s) { const bf16x8 bfr = *(const LAS bf16x8*)(kb + k * 4096 + boff[s]);
                            acc = __builtin_amdgcn_mfma_f32_32x32x16_bf16(afr[s], bfr, acc, 0, 0, 0); }
                        float s0 = 0.f;
#pragma unroll
                        for (int h = 0; h < 16; ++h) s0 = fmaf(wv[h >> 2][h & 3], fmaxf(acc[h], 0.f), s0);
                        s4[k4] = (kt * 32 + r <= tq) ? s0 : NEG;
                    }
                }
#define IX_INS(cc) case cc: _Pragma("unroll") for (int k = 0; k < 4; ++k) sc[(cc) * 4 + k] = s4[k]; break;
                switch (c * 2 + g) { IX_INS(0) IX_INS(1) IX_INS(2) IX_INS(3) IX_INS(4) IX_INS(5) IX_INS(6) IX_INS(7) IX_INS(8) IX_INS(9) IX_INS(10) IX_INS(11) IX_INS(12) IX_INS(13) IX_INS(14) IX_INS(15)
                                     IX_INS(16) IX_INS(17) IX_INS(18) IX_INS(19) IX_INS(20) IX_INS(21) IX_INS(22) IX_INS(23) IX_INS(24) IX_INS(25) IX_INS(26) IX_INS(27) IX_INS(28) IX_INS(29) IX_INS(30) IX_INS(31) default: break; }
#undef IX_INS
            }
            asm volatile("s_waitcnt vmcnt(0)" ::: "memory");
            __syncthreads();
        }
        }
#undef IX_STAGE
        float tau = -3.0e38f; int tiemode = 0, need = 0;
        for (int rep20 = 0; rep20 < (REP_PHASE == 20 ? 2 : 1); ++rep20) {
            tiemode = 0; need = 0;
            float lo = 0.f, hiv = 0.f; int done = (tq + 1 <= TOPK) ? 1 : 0;
            if (!done) {
                float mn = __builtin_inff(), mx = NEG;
#pragma unroll
                for (int c = 0; c < 16; ++c) if (c < nch) {
#pragma unroll
                    for (int k = 0; k < 8; ++k) { const float v = sc[c * 8 + k]; mx = fmaxf(mx, v); mn = fminf(mn, (v == NEG) ? __builtin_inff() : v); } }
                lo = half_min(mn); mx = half_max(mx);
                hiv = mx + fabsf(mx) * 1e-6f + 1e-30f;
            }
            for (int it = 0; it < 64 && __any(!done); ++it) {
                const unsigned ul = __float_as_uint(lo), uh = __float_as_uint(hiv);
                const unsigned kl = (ul & 0x80000000u) ? ~ul : (ul | 0x80000000u), kh = (uh & 0x80000000u) ? ~uh : (uh | 0x80000000u);
                const bool adj = (kh - kl) <= 1u;
                const unsigned km = kl + ((kh - kl) >> 1);
                const float kmid = __uint_as_float((km & 0x80000000u) ? (km ^ 0x80000000u) : ~km);
                const float fmid = 0.5f * (lo + hiv);
                const float mid = (it < 24 && fmid > lo && fmid < hiv) ? fmid : kmid;
                const float piv = adj ? hiv : mid;
                int cnt = 0;
#pragma unroll
                for (int c = 0; c < 16; ++c) if (c < nch) {
#pragma unroll
                    for (int k = 0; k < 8; ++k) cnt += (sc[c * 8 + k] >= piv) ? 1 : 0; }
                cnt = half_sum(cnt);
                if (!done) {
                    if (adj) { tau = lo; tiemode = 1; need = TOPK - cnt; done = 1; }
                    else if (cnt == TOPK) { tau = mid; done = 1; }
                    else if (cnt > TOPK) lo = mid; else hiv = mid;
                }
            }
        }
        unsigned wA0 = 0u, wA1 = 0u, wB0 = 0u, wB1 = 0u;
#define IX_BAL(RA, RB, KT, LN, OP) { const unsigned long long bl_ = __ballot(sc[KT] OP tau); \
            asm volatile("s_nop 1\n\tv_writelane_b32 %0, %2, %4\n\tv_writelane_b32 %1, %3, %4" : "+v"(RA), "+v"(RB) : "s"((unsigned)bl_), "s"((unsigned)(bl_ >> 32)), "n"(LN)); }
#define IX_REP8(M, RA, RB, b, o, OP) M(RA, RB, (b) + 0, (b) - (o) + 0, OP) M(RA, RB, (b) + 1, (b) - (o) + 1, OP) M(RA, RB, (b) + 2, (b) - (o) + 2, OP) M(RA, RB, (b) + 3, (b) - (o) + 3, OP) \
                                     M(RA, RB, (b) + 4, (b) - (o) + 4, OP) M(RA, RB, (b) + 5, (b) - (o) + 5, OP) M(RA, RB, (b) + 6, (b) - (o) + 6, OP) M(RA, RB, (b) + 7, (b) - (o) + 7, OP)
#define IX_REP64(M, RA, RB, b, OP) IX_REP8(M, RA, RB, (b) + 0, b, OP) IX_REP8(M, RA, RB, (b) + 8, b, OP) IX_REP8(M, RA, RB, (b) + 16, b, OP) IX_REP8(M, RA, RB, (b) + 24, b, OP) \
                                   IX_REP8(M, RA, RB, (b) + 32, b, OP) IX_REP8(M, RA, RB, (b) + 40, b, OP) IX_REP8(M, RA, RB, (b) + 48, b, OP) IX_REP8(M, RA, RB, (b) + 56, b, OP)
        IX_REP64(IX_BAL, wA0, wB0, 0, >=)
        IX_REP64(IX_BAL, wA1, wB1, 64, >=)
        if (__any(tiemode)) {
            unsigned gA0 = 0u, gA1 = 0u, gB0 = 0u, gB1 = 0u;
            IX_REP64(IX_BAL, gA0, gB0, 0, >)
            IX_REP64(IX_BAL, gA1, gB1, 64, >)
            const int tieA = __builtin_amdgcn_readlane(tiemode, 0), tieB = __builtin_amdgcn_readlane(tiemode, 32);
            const int needA = __builtin_amdgcn_readlane(need, 0), needB = __builtin_amdgcn_readlane(need, 32);
            if (tieA) tie_fix(wA0, wA1, gA0, gA1, needA, lane);
            if (tieB) tie_fix(wB0, wB1, gB0, gB1, needB, lane);
        }
        unsigned* ra = MASK + (tb + q0 + 2 * w) * 128;
        store_row(ra, wA0, wA1, lane);
        store_row(ra + 128, wB0, wB1, lane);
#undef IX_BAL
#undef IX_REP8
#undef IX_REP64
        __syncthreads();
    }
    {   LAS unsigned char* told = lds + LDS_SIDE + (spar ^ 1) * 2 * 16640;
        if (pend0) SD.consume(told, pd0, w, lane);
        if (pend1) SD.consume(told + 16640, pd1, w, lane); }
    SD.leftover(sq, w, lane);
}
}


#ifdef PROBE_MASK
__device__ __forceinline__ void probe_mask_check(const Frame& F) {
    const unsigned* MASK = F.W<unsigned>(WS_MASK); unsigned* flag = F.W<unsigned>(WS_CTL + CTL_CNT + 1024);
    for (int t = F.bid * 8 + F.wave; t < T; t += F.G * 8) {
        const int s = t & (SEQ - 1);
        int cnt = 0, bad = 0;
#pragma unroll
        for (int i = 0; i < 2; ++i) {
            const int o = i * 64 + F.lane_(); const unsigned w = MASK[(size_t)t * 128 + o];
            cnt += __popc(w);
            const int tile = o >> 1, hi = o & 1;
#pragma unroll
            for (int b = 0; b < 32; ++b) if ((w >> b) & 1u) { const int r = b & 15; const int key = tile * 64 + (b >> 4) * 32 + (r & 3) + 8 * (r >> 2) + 4 * hi; if (key > s) bad = 1; }
        }
        cnt = (int)wave_sum((float)cnt);
        const int want = (s + 1 < TOPK) ? s + 1 : TOPK;
        if (cnt != want) bad = 1;
        if (__any(bad) && F.lane_() == 0) atomicAdd(flag, 1u);
    }
}
#endif
__device__ __forceinline__ void p4_merge(const Frame& F) {
    const bf16_t* A = F.W<bf16_t>(WS_ABUF); const bf16_t* P = F.W<bf16_t>(WS_PBUF); const bf16_t* GA = F.W<bf16_t>(WS_GABUF); const bf16_t* Y = F.W<bf16_t>(WS_YATT);
    bf16_t* M = F.W<bf16_t>(WS_MERGED); const float* cw = F.I<float>(IN_CONV_W);
    for (int r = F.bid * 2 + (F.tid_() >> 8); r < T; r += F.G * 2) {
        const int c = (F.tid_() & 255) * 8, s = r & (SEQ - 1);
        const u32x4 a = *(const u32x4*)(A + (size_t)r * DM + c), p2 = *(const u32x4*)(P + (size_t)r * DM + c);
        u32x4 p1 = (u32x4){0u, 0u, 0u, 0u}, p0 = (u32x4){0u, 0u, 0u, 0u};
        if (s >= 1) p1 = *(const u32x4*)(P + (size_t)(r - 1) * DM + c);
        if (s >= 2) p0 = *(const u32x4*)(P + (size_t)(r - 2) * DM + c);
#if MILESTONE >= 4
        const u32x4 ga = *(const u32x4*)(GA + (size_t)r * DM + c), y = *(const u32x4*)(Y + (size_t)r * DM + c);
#else
        const u32x4 ga = (u32x4){0u, 0u, 0u, 0u}, y = (u32x4){0u, 0u, 0u, 0u}; (void)GA; (void)Y;
#endif
        float o[8];
#pragma unroll
        for (int j = 0; j < 4; ++j) {
            const float w0l = cw[c + 2 * j], w1l = cw[DM + c + 2 * j], w2l = cw[2 * DM + c + 2 * j];
            const float w0h = cw[c + 2 * j + 1], w1h = cw[DM + c + 2 * j + 1], w2h = cw[2 * DM + c + 2 * j + 1];
            o[2 * j] = bf_lo(a[j]) * (w0l * bf_lo(p0[j]) + w1l * bf_lo(p1[j]) + w2l * bf_lo(p2[j])) + bf_lo(ga[j]) * bf_lo(y[j]);
            o[2 * j + 1] = bf_hi(a[j]) * (w0h * bf_hi(p0[j]) + w1h * bf_hi(p1[j]) + w2h * bf_hi(p2[j])) + bf_hi(ga[j]) * bf_hi(y[j]);
        }
        u32x4 w; w.x = cvt_pk_bf16(o[0], o[1]); w.y = cvt_pk_bf16(o[2], o[3]); w.z = cvt_pk_bf16(o[4], o[5]); w.w = cvt_pk_bf16(o[6], o[7]);
        *(u32x4*)(M + (size_t)r * DM + c) = w;
    }
}


__device__ __forceinline__ void p9_route(const Frame& F, const bf16_t* h) {
    const float* wrt = F.W<float>(WS_WRT); const float* br = F.I<float>(IN_B_ROUTER);
    unsigned* cnt = F.W<unsigned>(WS_CTL + CTL_CNT);
    int* slot_e = F.W<int>(WS_SLOTE); int* slot_r = F.W<int>(WS_SLOTR); float* slot_g = F.W<float>(WS_SLOTG); float* rs2o = F.W<float>(WS_RS2);
    LAS float* part = (LAS float*)F.lds;
    LAS float* ssp = (LAS float*)(F.lds + 16384);
    const int lane = F.lane_(), w = F.wave, tg = w & 3, kh = w >> 2, tok = lane & 15, kq = lane >> 4;
    for (int u = F.bid; u < T / 64; u += F.G) {
        const int t0 = u * 64 + tg * 16;
        const bf16_t* hp = h + (size_t)(t0 + tok) * DM + kh * 1024 + 4 * kq;
        const float* w0 = wrt + (size_t)tok * DM + kh * 1024 + 4 * kq;
        const float* w1 = w0 + (size_t)16 * DM;
        f32x4 acc0 = (f32x4){0.f, 0.f, 0.f, 0.f}, acc1 = (f32x4){0.f, 0.f, 0.f, 0.f}; float ss = 0.f;
#pragma unroll 4
        for (int s = 0; s < 64; ++s) {
            const u32x2 ab = *(const u32x2*)(hp + 16 * s); const f32x4 a = (f32x4){bf_lo(ab.x), bf_hi(ab.x), bf_lo(ab.y), bf_hi(ab.y)};
            const f32x4 b0 = *(const f32x4*)(w0 + 16 * s), b1 = *(const f32x4*)(w1 + 16 * s);
            ss += a[0] * a[0] + a[1] * a[1] + a[2] * a[2] + a[3] * a[3];
#pragma unroll
            for (int j = 0; j < 4; ++j) { acc0 = __builtin_amdgcn_mfma_f32_16x16x4f32(a[j], b0[j], acc0, 0, 0, 0); acc1 = __builtin_amdgcn_mfma_f32_16x16x4f32(a[j], b1[j], acc1, 0, 0, 0); }
        }
        ss += __shfl_xor(ss, 16); ss += __shfl_xor(ss, 32);
        if (kq == 0) ssp[kh * 64 + tg * 16 + tok] = ss;
#pragma unroll
        for (int i = 0; i < 4; ++i) { part[(kh * 64 + tg * 16 + 4 * kq + i) * 32 + tok] = acc0[i]; part[(kh * 64 + tg * 16 + 4 * kq + i) * 32 + 16 + tok] = acc1[i]; }
        __syncthreads();
        if (F.tid_() < 64) {
            const int t = u * 64 + F.tid_();
            const float rs = __builtin_amdgcn_rsqf((ssp[F.tid_()] + ssp[64 + F.tid_()]) * (1.0f / DM) + NORM_EPS);
            float lg[32];
#pragma unroll
            for (int e = 0; e < 32; ++e) lg[e] = (part[F.tid_() * 32 + e] + part[(64 + F.tid_()) * 32 + e]) * rs + br[e];
            unsigned chosen = 0u; float tv[4]; int ti[4];
#pragma unroll
            for (int p = 0; p < 4; ++p) {
                float best = -__builtin_inff(); int bi = 0;
#pragma unroll
                for (int e = 0; e < 32; ++e) { const bool ok = !((chosen >> e) & 1u) && (lg[e] > best); best = ok ? lg[e] : best; bi = ok ? e : bi; }
                chosen |= 1u << bi; tv[p] = best; ti[p] = bi;
            }
            const float e1 = __expf(tv[1] - tv[0]), e2 = __expf(tv[2] - tv[0]), e3 = __expf(tv[3] - tv[0]);
            const float inv = 1.0f / (1.0f + e1 + e2 + e3);
            const float gt[4] = {inv, e1 * inv, e2 * inv, e3 * inv};
            rs2o[t] = rs;
#pragma unroll
            for (int p = 0; p < 4; ++p) {
                const unsigned rk = atomicAdd(cnt + ti[p], 1u);
                slot_e[t * 4 + p] = ti[p]; slot_r[t * 4 + p] = (int)rk; slot_g[t * 4 + p] = gt[p];
            }
        }
        __syncthreads();
    }
}

__device__ __forceinline__ void p10_gather(const Frame& F, const bf16_t* hb) {
    LAS int* off = (LAS int*)F.lds;
    const unsigned* cnt = F.W<unsigned>(WS_CTL + CTL_CNT);
    int* tile_e = F.W<int>(WS_TILEE);
    if (F.tid_() == 0) { int o = 0; for (int e = 0; e < NEXP; ++e) { off[e] = o; o += ((int)cnt[e] + 255) & ~255; } off[NEXP] = o; }
    __syncthreads();
    if (F.bid == 0) {
        const int nmt = off[NEXP] >> 8;
        for (int m = F.tid_(); m < nmt; m += 512) { int e = 0; for (int q = 1; q < NEXP; ++q) e = (off[q] <= m * 256) ? q : e; tile_e[m] = e; }
        if (F.tid_() == 0) tile_e[511] = nmt;
    }
    const int* slot_e = F.W<int>(WS_SLOTE); const int* slot_r = F.W<int>(WS_SLOTR); const float* slot_g = F.W<float>(WS_SLOTG); const float* rs2 = F.W<float>(WS_RS2);
    int* pos = F.W<int>(WS_POS); float* rss = F.W<float>(WS_RSS); float* gws = F.W<float>(WS_GWS); unsigned char* as = F.W<unsigned char>(WS_ASORT); const float* gffn = F.I<float>(IN_NORM_FFN);
    for (int t = F.bid * 8 + F.wave; t < T; t += F.G * 8) {
        u32x2 v[4];
#pragma unroll
        for (int i = 0; i < 4; ++i) { const int c = (i * 64 + F.lane_()) * 8;
            const u32x4 hv = *(const u32x4*)(hb + (size_t)t * DM + c); const f32x4 g0 = *(const f32x4*)(gffn + c), g1 = *(const f32x4*)(gffn + c + 4);
            v[i] = pack_fp8x8(bf_lo(hv.x) * g0[0], bf_hi(hv.x) * g0[1], bf_lo(hv.y) * g0[2], bf_hi(hv.y) * g0[3], bf_lo(hv.z) * g1[0], bf_hi(hv.z) * g1[1], bf_lo(hv.w) * g1[2], bf_hi(hv.w) * g1[3]); }
        const float rs = rs2[t];
        const u32x4 se = *(const u32x4*)(slot_e + t * 4), sr = *(const u32x4*)(slot_r + t * 4); const f32x4 sg = *(const f32x4*)(slot_g + t * 4);
        int pp[4];
#pragma unroll
        for (int k = 0; k < 4; ++k) pp[k] = off[se[k]] + (int)sr[k];
#pragma unroll
        for (int k = 0; k < 4; ++k) {
            const int p = pp[k];
#pragma unroll
            for (int i = 0; i < 4; ++i) *(u32x2*)(as + (size_t)p * DM + (i * 64 + F.lane_()) * 8) = v[i];
            if (F.lane_() == 0) { rss[p] = rs; gws[p] = sg[k]; }
        }
        if (F.lane_() == 0) *(u32x4*)(pos + t * 4) = (u32x4){(unsigned)pp[0], (unsigned)pp[1], (unsigned)pp[2], (unsigned)pp[3]};
    }
}

struct SchedMoE { int G, c, nM, nN; const char* A; const char* Bt; const LAS int* tile_e; size_t tstep, estep;
    __device__ __forceinline__ bool next(int i, Unit& u) const {
        const int L = i * G + c; if (L >= nM * nN) return false;
        int pm, pn; pg8::tile_of(L, nM, nN, pm, pn); const int e = tile_e[pm];
        u.pm = pm; u.pn = pn; u.a = A + (size_t)pm * tstep; u.b = Bt + (size_t)e * estep + (size_t)pn * tstep; u.kind = 0; u.aux = e; return true; }
};
struct EpiSwiglu { const float* rss; const float* bgu; unsigned char* hdn;
    struct Pre { };
    __device__ __forceinline__ Pre pre(const Unit&, int, int, int, int) const { return Pre{}; }
    __device__ __forceinline__ void operator()(const f32x4 (&acc)[2][2][4][2], const Unit& u, int wr, int wc, int fr, int fq, const Pre&) const {
        const int cw = 128 * u.pn + 32 * wc + 8 * fq; const float* bg = bgu + (size_t)u.aux * 4096 + cw;
        const f32x4 bg0 = *(const f32x4*)bg, bg1 = *(const f32x4*)(bg + 4), bu0 = *(const f32x4*)(bg + 2048), bu1 = *(const f32x4*)(bg + 2052);
        float rsv[8];
#pragma unroll
        for (int q = 0; q < 8; ++q) rsv[q] = rss[u.pm * 256 + (q >> 2) * 128 + wr * 64 + (q & 3) * 16 + fr];
#pragma unroll
        for (int ai = 0; ai < 2; ++ai)
#pragma unroll
            for (int m = 0; m < 4; ++m) {
                const int row = u.pm * 256 + ai * 128 + wr * 64 + m * 16 + fr; const float rs = rsv[ai * 4 + m] * (1.0f / W8_SCALE);
                f32x4 o[2];
#pragma unroll
                for (int n = 0; n < 2; ++n)
#pragma unroll
                    for (int j = 0; j < 4; ++j) {
                        float g = acc[ai][0][m][n][j] * rs + (n ? bg1[j] : bg0[j]); float up = acc[ai][1][m][n][j] * rs + (n ? bu1[j] : bu0[j]);
                        g = fminf(g, 7.0f); up = fminf(fmaxf(up, -7.0f), 7.0f);
                        o[n][j] = (up + 1.0f) * g * __builtin_amdgcn_rcpf(1.0f + __expf(-1.702f * g));
                    }
                *(u32x2*)(hdn + (size_t)row * DFF + cw) = pack_fp8x8(o[0][0], o[0][1], o[0][2], o[0][3], o[1][0], o[1][1], o[1][2], o[1][3]);
            }
    }
};
constexpr float YS_SCALE = 16.0f;
struct EpiDown { const float* gws; const float* bdn; unsigned char* ys;
    struct Pre { float gwv[8]; };
    __device__ __forceinline__ Pre pre(const Unit& u, int wr, int wc, int fr, int fq) const {
        Pre p;
#pragma unroll
        for (int q = 0; q < 8; ++q) p.gwv[q] = gws[u.pm * 256 + (q >> 2) * 128 + wr * 64 + (q & 3) * 16 + fr];
        return p;
    }
    __device__ __forceinline__ void operator()(const f32x4 (&acc)[2][2][4][2], const Unit& u, int wr, int wc, int fr, int fq, const Pre& pr) const {
        const int c0 = 256 * u.pn + 32 * wc + 8 * fq; const float* bp = bdn + (size_t)u.aux * DM + c0;
        const f32x4 b00 = *(const f32x4*)bp, b01 = *(const f32x4*)(bp + 4), b10 = *(const f32x4*)(bp + 128), b11 = *(const f32x4*)(bp + 132); const float (&gwv)[8] = pr.gwv;
#pragma unroll
        for (int ai = 0; ai < 2; ++ai)
#pragma unroll
            for (int m = 0; m < 4; ++m) {
                const int row = u.pm * 256 + ai * 128 + wr * 64 + m * 16 + fr; const float gw = gwv[ai * 4 + m] * YS_SCALE;
                constexpr float iw = 1.0f / W8_SCALE;
                const f32x4 o0 = (acc[ai][0][m][0] * iw + b00) * gw, o1 = (acc[ai][0][m][1] * iw + b01) * gw, o2 = (acc[ai][1][m][0] * iw + b10) * gw, o3 = (acc[ai][1][m][1] * iw + b11) * gw;
                *(u32x2*)(ys + (size_t)row * DM + c0) = pack_fp8x8(o0[0], o0[1], o0[2], o0[3], o1[0], o1[1], o1[2], o1[3]);
                *(u32x2*)(ys + (size_t)row * DM + c0 + 128) = pack_fp8x8(o2[0], o2[1], o2[2], o2[3], o3[0], o3[1], o3[2], o3[3]);
            }
    }
};

__device__ __forceinline__ void p_final(const Frame& F, const bf16_t* h) {
    const float* g = F.I<float>(IN_NORM_FINAL); const unsigned char* ys = F.W<unsigned char>(WS_YS); const int* pos = F.W<int>(WS_POS);
    const int ln = F.lane_();
    u32x4 pnext = (u32x4){0u, 0u, 0u, 0u};
    { const int r0 = F.bid * 8 + F.wave; if (r0 < T) pnext = *(const u32x4*)(pos + r0 * 4); }
    for (int r = F.bid * 8 + F.wave; r < T; r += F.G * 8) {
        f32x4 v[8]; float ss = 0.f;
        const int ps0 = (int)pnext.x, ps1 = (int)pnext.y, ps2 = (int)pnext.z, ps3 = (int)pnext.w;
        { const int rn = r + F.G * 8; if (rn < T) pnext = *(const u32x4*)(pos + rn * 4); }
#pragma unroll
        for (int i = 0; i < 4; ++i) {
            const int c = (i * 64 + ln) * 8;
            const u32x4 hh = *(const u32x4*)(h + (size_t)r * DM + c);
            const u32x2 y0 = *(const u32x2*)(ys + (size_t)ps0 * DM + c), y1 = *(const u32x2*)(ys + (size_t)ps1 * DM + c), y2 = *(const u32x2*)(ys + (size_t)ps2 * DM + c), y3 = *(const u32x2*)(ys + (size_t)ps3 * DM + c);
            f32x4 a, b;
            constexpr float iy = 1.0f / YS_SCALE;
#define FIN_Y(W, HI) ((__builtin_amdgcn_cvt_pk_f32_fp8((int)y0.W, HI) + __builtin_amdgcn_cvt_pk_f32_fp8((int)y1.W, HI)) + (__builtin_amdgcn_cvt_pk_f32_fp8((int)y2.W, HI) + __builtin_amdgcn_cvt_pk_f32_fp8((int)y3.W, HI)))
            { const f32x2 s0 = FIN_Y(x, false), s1 = FIN_Y(x, true), s2 = FIN_Y(y, false), s3 = FIN_Y(y, true);
              a[0] = bf_lo(hh.x) + s0[0] * iy; a[1] = bf_hi(hh.x) + s0[1] * iy; a[2] = bf_lo(hh.y) + s1[0] * iy; a[3] = bf_hi(hh.y) + s1[1] * iy;
              b[0] = bf_lo(hh.z) + s2[0] * iy; b[1] = bf_hi(hh.z) + s2[1] * iy; b[2] = bf_lo(hh.w) + s3[0] * iy; b[3] = bf_hi(hh.w) + s3[1] * iy; }
#undef FIN_Y
            v[2 * i] = a; v[2 * i + 1] = b;
            ss += a[0] * a[0] + a[1] * a[1] + a[2] * a[2] + a[3] * a[3] + b[0] * b[0] + b[1] * b[1] + b[2] * b[2] + b[3] * b[3];
        }
        ss = wave_sum(ss);
        float rs = __builtin_amdgcn_rsqf(ss * (1.0f / DM) + NORM_EPS);
#ifdef PROBE_MASK
        if (F.W<unsigned>(WS_CTL + CTL_CNT + 1024)[0] != 0u) rs = __builtin_nanf("");
#endif
#pragma unroll
        for (int i = 0; i < 4; ++i) {
            const int c = (i * 64 + ln) * 8;
            const f32x4 g0 = *(const f32x4*)(g + c), g1 = *(const f32x4*)(g + c + 4);
            *(f32x4*)(F.a->out + (size_t)r * DM + c) = v[2 * i] * rs * g0; *(f32x4*)(F.a->out + (size_t)r * DM + c + 4) = v[2 * i + 1] * rs * g1;
        }
    }
}

constexpr int N_PHASES = 14;
__global__ void __launch_bounds__(512, 2) fwd_kernel(Args args) {
    extern __shared__ __attribute__((aligned(16))) unsigned char lds_raw[];
    Frame F; F.a = &args; F.ws = args.ws; F.lds = (LAS unsigned char*)lds_raw;
    F.wave = __builtin_amdgcn_readfirstlane(threadIdx.x >> 6); F.G = gridDim.x; F.bid = blockIdx.x;
    volatile LAS unsigned* misc = (volatile LAS unsigned*)(F.lds + LDS_MISC);
    if (F.tid_() < 64) misc[F.tid_()] = 0u;
    __syncthreads();
    XcdBarrier bar; bar.bar = F.W<unsigned>(WS_CTL + CTL_BAR); bar.x = 0; bar.st = misc; bar.wv = F.wave;
#if !N_LAUNCH_PER_PHASE
    bar = xcd_barrier_post(F.W<unsigned>(WS_CTL + CTL_BAR), misc, F.wave);
#define GRID_BAR() xcd_barrier(bar)
#else
#define GRID_BAR() do { } while (0)
#endif
    const int lo = args.ph_lo, hi = args.ph_hi;
#ifndef ONLY_PHASE
#define ONLY_PHASE -1
#endif
#define IN(k) ((ONLY_PHASE < 0 || ONLY_PHASE == (k)) && lo <= (k) && (k) < hi)
#define BOTH(k) (IN(k) && IN((k) + 1))

    if (IN(0)) { p0_prologue(F); if (BOTH(0)) GRID_BAR(); }
#if REP_PHASE == 0
    if (IN(0)) { p0_prologue(F); if (BOTH(0)) GRID_BAR(); }
#endif
    if (IN(1)) {
        SchedG1F S8{F.G, F.bid, F.W<char>(WS_XB8), F.W<char>(WS_WINT)};
        SchedG1 S{F.G, F.G - 1 - F.bid, F.W<char>(WS_XB), F.W<char>(WS_WINT), F.W<char>(WS_MEMB), F.W<char>(WS_WKVT)};
        EpiG1 E{F.W<float>(WS_RS0), F.W<float>(WS_RSMEM), F.W<float>(WS_ROPEQK), F.W<float>(WS_ROPEI), F.W<bf16_t>(WS_ABUF), F.W<bf16_t>(WS_PBUF), F.W<bf16_t>(WS_GABUF),
                F.W<bf16_t>(WS_QB), F.W<bf16_t>(WS_KB), F.W<bf16_t>(WS_VB), F.W<bf16_t>(WS_QIB), F.W<bf16_t>(WS_KIB), F.W<float>(WS_WIB), F.W<bf16_t>(WS_KX), F.W<bf16_t>(WS_VX), 1.0f / W8_SCALE};
        pg8::SideConv SD{F.I<float>(IN_W_GU), F.W<unsigned char>(WS_WGUT), 1, 0, SJ_GU_P1, F.G, F.bid};
        const int sdone8 = pg8::gemm_phase<EpiG1, SchedG1F, pg8::SideConv, true>(F.lds, DM, S8, E, F.wave, SD);
        E.sc = 1.0f; SD.j0 += sdone8 * F.G;
        const int sdone = pg8::gemm_phase(F.lds, DM * 2, S, E, F.wave, SD);
        SD.leftover(sdone, F.wave, F.lane_());
        if (BOTH(1)) GRID_BAR();
    }
#if REP_PHASE == 1
    if (IN(1)) {
        SchedG1F S8{F.G, F.bid, F.W<char>(WS_XB8), F.W<char>(WS_WINT)};
        SchedG1 S{F.G, F.G - 1 - F.bid, F.W<char>(WS_XB), F.W<char>(WS_WINT), F.W<char>(WS_MEMB), F.W<char>(WS_WKVT)};
        EpiG1 E{F.W<float>(WS_RS0), F.W<float>(WS_RSMEM), F.W<float>(WS_ROPEQK), F.W<float>(WS_ROPEI), F.W<bf16_t>(WS_ABUF), F.W<bf16_t>(WS_PBUF), F.W<bf16_t>(WS_GABUF),
                F.W<bf16_t>(WS_QB), F.W<bf16_t>(WS_KB), F.W<bf16_t>(WS_VB), F.W<bf16_t>(WS_QIB), F.W<bf16_t>(WS_KIB), F.W<float>(WS_WIB), F.W<bf16_t>(WS_KX), F.W<bf16_t>(WS_VX), 1.0f / W8_SCALE};
        pg8::SideConv SD{F.I<float>(IN_W_GU), F.W<unsigned char>(WS_WGUT), 1, 0, SJ_GU_P1, F.G, F.bid};
        const int sdone8 = pg8::gemm_phase<EpiG1, SchedG1F, pg8::SideConv, true>(F.lds, DM, S8, E, F.wave, SD);
        E.sc = 1.0f; SD.j0 += sdone8 * F.G;
        const int sdone = pg8::gemm_phase(F.lds, DM * 2, S, E, F.wave, SD);
        SD.leftover(sdone, F.wave, F.lane_());
        if (BOTH(1)) GRID_BAR();
    }
#endif
#if MILESTONE >= 4
    if (IN(2)) { pg8::SideConv SD{F.I<float>(IN_W_GU), F.W<unsigned char>(WS_WGUT), 1, SJ_GU_P1, SJ_GU_P2, F.G, F.bid};
                 ix::indexer_phase(F, F.W<bf16_t>(WS_QIB), F.W<bf16_t>(WS_KIB), F.W<float>(WS_WIB), F.W<unsigned>(WS_MASK), SD); if (BOTH(2)) GRID_BAR(); }
#if REP_PHASE == 2
    if (IN(2)) { pg8::SideConv SD{F.I<float>(IN_W_GU), F.W<unsigned char>(WS_WGUT), 1, SJ_GU_P1, SJ_GU_P2, F.G, F.bid};
                 ix::indexer_phase(F, F.W<bf16_t>(WS_QIB), F.W<bf16_t>(WS_KIB), F.W<float>(WS_WIB), F.W<unsigned>(WS_MASK), SD); if (BOTH(2)) GRID_BAR(); }
#endif
    if (IN(3)) {
        att::AttnTensors X{F.W<bf16_t>(WS_QB), F.W<bf16_t>(WS_KB), F.W<bf16_t>(WS_VB), F.W<bf16_t>(WS_YATT), F.W<unsigned>(WS_MASK)};
        att::MergeArgs MG{F.ws, F.I<float>(IN_CONV_W)};
        att::attn_phase<DM, 512, DM, true, 6, true>((char*)lds_raw, X, MG, NB, NHEAD, NKVH, SEQ, SEQ, 0, att::ORDER_PAIRED | att::ORDER_XCD, F.G, F.bid, F.wave);
        if (BOTH(3)) GRID_BAR();
    }
#if REP_PHASE == 3
    if (IN(3)) {
        att::AttnTensors X{F.W<bf16_t>(WS_QB), F.W<bf16_t>(WS_KB), F.W<bf16_t>(WS_VB), F.W<bf16_t>(WS_YATT), F.W<unsigned>(WS_MASK)};
        att::MergeArgs MG{F.ws, F.I<float>(IN_CONV_W)};
        att::attn_phase<DM, 512, DM, true, 6, true>((char*)lds_raw, X, MG, NB, NHEAD, NKVH, SEQ, SEQ, 0, att::ORDER_PAIRED | att::ORDER_XCD, F.G, F.bid, F.wave);
        if (BOTH(3)) GRID_BAR();
    }
#endif
#endif
#ifdef PROBE_MASK
    if (IN(4)) { probe_mask_check(F); GRID_BAR(); }
#endif
    if (IN(5)) {
        SchedDense S{F.G, F.bid, 64, 8, F.W<char>(WS_MERGED), F.W<char>(WS_WOUTT), (size_t)256 * DM * 2};
        EpiResid<true> E{F.I<float>(IN_X), F.W<bf16_t>(WS_H1B), F.W<float>(WS_CTL + CTL_SS1)};
        pg8::SideConv SD{F.I<float>(IN_W_GU), F.W<unsigned char>(WS_WGUT), 1, SJ_GU_P2, SJ_GU, F.G, F.bid};
        const int sdone = pg8::gemm_phase(F.lds, DM * 2, S, E, F.wave, SD);
        SD.leftover(sdone, F.wave, F.lane_());
        if (BOTH(5)) GRID_BAR();
    }
#if REP_PHASE == 5
    if (IN(5)) {
        SchedDense S{F.G, F.bid, 64, 8, F.W<char>(WS_MERGED), F.W<char>(WS_WOUTT), (size_t)256 * DM * 2};
        EpiResid<true> E{F.I<float>(IN_X), F.W<bf16_t>(WS_H1B), nullptr};
        pg8::gemm_phase(F.lds, DM * 2, S, E, F.wave);
        if (BOTH(5)) GRID_BAR();
    }
#endif
#if MILESTONE >= 3
    if (IN(6)) {
        SchedDense S{F.G, F.bid, 64, 2, F.W<char>(WS_H1B), F.W<char>(WS_WQT), (size_t)256 * DM * 2};
        EpiScaleBf16 E{F.W<float>(WS_CTL + CTL_SS1), F.W<bf16_t>(WS_QX), 512};
        pg8::gemm_phase(F.lds, DM * 2, S, E, F.wave);
        if (BOTH(6)) GRID_BAR();
    }
#if REP_PHASE == 6
    if (IN(6)) {
        SchedDense S{F.G, F.bid, 64, 2, F.W<char>(WS_H1B), F.W<char>(WS_WQT), (size_t)256 * DM * 2};
        EpiScaleBf16 E{F.W<float>(WS_CTL + CTL_SS1), F.W<bf16_t>(WS_QX), 512};
        pg8::gemm_phase(F.lds, DM * 2, S, E, F.wave);
        if (BOTH(6)) GRID_BAR();
    }
#endif
    if (IN(7)) {
        att::AttnTensors X{F.W<bf16_t>(WS_QX), F.W<bf16_t>(WS_KX), F.W<bf16_t>(WS_VX), F.W<bf16_t>(WS_OX), nullptr};
        att::attn_phase<512, 512, 512, false, 6, false>((char*)lds_raw, X, att::MergeArgs{}, NB, XHEAD, XHEAD, SEQ, MEML, 1 << 20, att::ORDER_NATURAL, F.G, F.bid, F.wave);
        if (BOTH(7)) GRID_BAR();
    }
#if REP_PHASE == 7
    if (IN(7)) {
        att::AttnTensors X{F.W<bf16_t>(WS_QX), F.W<bf16_t>(WS_KX), F.W<bf16_t>(WS_VX), F.W<bf16_t>(WS_OX), nullptr};
        att::attn_phase<512, 512, 512, false, 6, false>((char*)lds_raw, X, att::MergeArgs{}, NB, XHEAD, XHEAD, SEQ, MEML, 1 << 20, att::ORDER_NATURAL, F.G, F.bid, F.wave);
        if (BOTH(7)) GRID_BAR();
    }
#endif
    if (IN(8)) {
        SchedDense S{F.G, F.bid, 64, 8, F.W<char>(WS_OX), F.W<char>(WS_WOXT), (size_t)256 * 512 * 2};
        EpiResid<false> E{F.W<bf16_t>(WS_H1B), F.W<bf16_t>(WS_H2B), nullptr};
        pg8::gemm_phase(F.lds, 512 * 2, S, E, F.wave);
        if (BOTH(8)) GRID_BAR();
    }
#if REP_PHASE == 8
    if (IN(8)) {
        SchedDense S{F.G, F.bid, 64, 8, F.W<char>(WS_OX), F.W<char>(WS_WOXT), (size_t)256 * 512 * 2};
        EpiResid<false> E{F.W<bf16_t>(WS_H1B), F.W<bf16_t>(WS_H2B), nullptr};
        pg8::gemm_phase(F.lds, 512 * 2, S, E, F.wave);
        if (BOTH(8)) GRID_BAR();
    }
#endif
#endif
    const bf16_t* h2b = F.W<bf16_t>(WS_H2B);
#if MILESTONE >= 2
    if (IN(9)) { p9_route(F, h2b); if (BOTH(9)) GRID_BAR(); }
    if (IN(10)) { p10_gather(F, h2b); if (BOTH(10)) GRID_BAR(); }
#if REP_PHASE == 10
    if (IN(10)) { p10_gather(F, h2b); if (BOTH(10)) GRID_BAR(); }
#endif
    if (IN(11)) {
        const int* te = F.W<int>(WS_TILEE); LAS int* tel = (LAS int*)(F.lds + LDS_MISC + 1024);
        tel[F.tid_()] = te[F.tid_()]; __syncthreads();
        SchedMoE S{F.G, F.bid, tel[511], 16, F.W<char>(WS_ASORT), F.W<char>(WS_WGUT), tel, (size_t)256 * DM, (size_t)4096 * DM};
        EpiSwiglu E{F.W<float>(WS_RSS), F.I<float>(IN_B_GU), F.W<unsigned char>(WS_HDN)};
        pg8::SideConv SD{F.I<float>(IN_W_DN), F.W<unsigned char>(WS_WDNT), 0, 0, SJ_DN, F.G, F.bid};
        const int sdone = pg8::gemm_phase<EpiSwiglu, SchedMoE, pg8::SideConv, true>(F.lds, DM, S, E, F.wave, SD);
        SD.leftover(sdone, F.wave, F.lane_());
        if (BOTH(11)) GRID_BAR();
    }
#if REP_PHASE == 11
    if (IN(11)) {
        const int* te = F.W<int>(WS_TILEE); LAS int* tel = (LAS int*)(F.lds + LDS_MISC + 1024);
        tel[F.tid_()] = te[F.tid_()]; __syncthreads();
        SchedMoE S{F.G, F.bid, tel[511], 16, F.W<char>(WS_ASORT), F.W<char>(WS_WGUT), tel, (size_t)256 * DM, (size_t)4096 * DM};
        EpiSwiglu E{F.W<float>(WS_RSS), F.I<float>(IN_B_GU), F.W<unsigned char>(WS_HDN)};
        pg8::SideConv SD{F.I<float>(IN_W_DN), F.W<unsigned char>(WS_WDNT), 0, 0, SJ_DN, F.G, F.bid};
        const int sdone = pg8::gemm_phase<EpiSwiglu, SchedMoE, pg8::SideConv, true>(F.lds, DM, S, E, F.wave, SD);
        SD.leftover(sdone, F.wave, F.lane_());
        if (BOTH(11)) GRID_BAR();
    }
#endif
    if (IN(12)) {
        const int* te = F.W<int>(WS_TILEE); LAS int* tel = (LAS int*)(F.lds + LDS_MISC + 1024);
        tel[F.tid_()] = te[F.tid_()]; __syncthreads();
        SchedMoE S{F.G, F.bid, tel[511], 8, F.W<char>(WS_HDN), F.W<char>(WS_WDNT), tel, (size_t)256 * DFF, (size_t)DM * DFF};
        EpiDown E{F.W<float>(WS_GWS), F.I<float>(IN_B_DN), F.W<unsigned char>(WS_YS)};
        pg8::gemm_phase<EpiDown, SchedMoE, pg8::SideNone, true>(F.lds, DFF, S, E, F.wave);
        if (BOTH(12)) GRID_BAR();
    }
#if REP_PHASE == 12
    if (IN(12)) {
        const int* te = F.W<int>(WS_TILEE); LAS int* tel = (LAS int*)(F.lds + LDS_MISC + 1024);
        tel[F.tid_()] = te[F.tid_()]; __syncthreads();
        SchedMoE S{F.G, F.bid, tel[511], 8, F.W<char>(WS_HDN), F.W<char>(WS_WDNT), tel, (size_t)256 * DFF, (size_t)DM * DFF};
        EpiDown E{F.W<float>(WS_GWS), F.I<float>(IN_B_DN), F.W<unsigned char>(WS_YS)};
        pg8::gemm_phase<EpiDown, SchedMoE, pg8::SideNone, true>(F.lds, DFF, S, E, F.wave);
        if (BOTH(12)) GRID_BAR();
    }
#endif
    if (IN(13)) { p_final(F, h2b); }
#if REP_PHASE == 13
    if (IN(13)) { p_final(F, h2b); }
#endif
#endif
#undef IN
#undef BOTH
}

extern "C" void kernel_launch(void* const* d_in, const int* in_sizes, int n_in, void* d_out, int out_size, void* d_ws, size_t ws_size, hipStream_t stream) {
    static int grid = 0;
    if (grid == 0) {
        if (n_in != 21 || out_size != T * DM || ws_size < WS_END) { fprintf(stderr, "kernel_launch: unexpected shapes (n_in %d, out %d, ws %zu < %zu)\n", n_in, out_size, ws_size, (size_t)WS_END); grid = -1; return; }
        int dev = 0, cus = 0, per_cu = 0;
        if (hipGetDevice(&dev) != hipSuccess || hipDeviceGetAttribute(&cus, hipDeviceAttributeMultiprocessorCount, dev) != hipSuccess) { grid = -1; return; }
        if (hipFuncSetAttribute((const void*)fwd_kernel, hipFuncAttributeMaxDynamicSharedMemorySize, LDS_BYTES) != hipSuccess) { fprintf(stderr, "kernel_launch: hipFuncSetAttribute failed\n"); grid = -1; return; }
        if (hipOccupancyMaxActiveBlocksPerMultiprocessor(&per_cu, (const void*)fwd_kernel, 512, LDS_BYTES) != hipSuccess || per_cu < 1) { fprintf(stderr, "kernel_launch: occupancy query says %d\n", per_cu); (void)hipGetLastError(); per_cu = 1; }
        grid = cus;
    }
    if (grid < 0) return;
    (void)hipMemsetAsync((char*)d_ws + WS_CTL, 0, CTL_BYTES, stream);
    Args a{};
    for (int i = 0; i < 21; ++i) a.in[i] = d_in[i];
    a.out = (float*)d_out; a.ws = (unsigned char*)d_ws;
#if N_LAUNCH_PER_PHASE
    for (int p = 0; p < N_PHASES; ++p) {
#if MILESTONE == 1
        if (!(p == 0 || p == 1 || p == 4 || p == 5 || p == 13)) continue;
#endif
#if MILESTONE == 2
        if (!(p == 0 || p == 1 || p == 4 || p == 5 || p >= 9)) continue;
#endif
#if MILESTONE == 3
        if (!(p == 0 || p == 1 || p >= 4)) continue;
#endif
        a.ph_lo = p; a.ph_hi = p + 1;
        hipLaunchKernelGGL(fwd_kernel, dim3(grid), dim3(512), LDS_BYTES, stream, a);
    }
#else
    a.ph_lo = 0; a.ph_hi = N_PHASES;
    hipLaunchKernelGGL(fwd_kernel, dim3(grid), dim3(512), LDS_BYTES, stream, a);
#endif
}
```

```cpp
#include <hip/hip_runtime.h>
#include <stdio.h>
#include <stdint.h>

#ifndef N_LAUNCH_PER_PHASE
#define N_LAUNCH_PER_PHASE 0
#endif
#ifndef REP_PHASE
#define REP_PHASE -1
#endif
#ifndef MILESTONE
#define MILESTONE 4
#endif

#define LAS __attribute__((address_space(3)))
typedef unsigned short bf16_t;
typedef short bf16x8 __attribute__((ext_vector_type(8)));
typedef float f32x2 __attribute__((ext_vector_type(2)));
typedef float f32x4 __attribute__((ext_vector_type(4)));
typedef float f32x16 __attribute__((ext_vector_type(16)));
typedef unsigned u32x4 __attribute__((ext_vector_type(4)));
typedef unsigned u32x2 __attribute__((ext_vector_type(2)));

constexpr int NB = 4, SEQ = 4096, T = NB * SEQ, DM = 2048, DIN = 14416;
constexpr int NHEAD = 16, HD = 128, NKVH = 4, IHEAD = 16, IDIM = 64, TOPK = 256;
constexpr int MEML = 256, XHEAD = 4;
constexpr int NEXP = 32, DFF = 2048, TOPE = 4;
constexpr float NORM_EPS = 1e-6f;
constexpr int C_CB = 0, C_CC = 2048, C_CX = 4096, C_Q = 6144, C_K = 8192, C_V = 8704, C_QI = 9216, C_KI = 10240, C_WI = 10304, C_GC = 10320, C_GA = 12368;
constexpr int TL_A = 0, TL_P = 16, TL_G = 32, TL_Q = 40, TL_K = 48, TL_V = 50, TL_QI = 52, TL_KI = 56, N1_TILES = 57, N1P = N1_TILES * 256;
constexpr int CAP_ROWS = T * TOPE + NEXP * 256;
constexpr int MAX_MT = CAP_ROWS / 256;

constexpr size_t al256(size_t x) { return (x + 255) & ~(size_t)255; }
constexpr size_t WS_CTL = 0;
constexpr size_t CTL_BAR = 0;
constexpr size_t CTL_CNT = 16384;
constexpr size_t CTL_SS1 = 32768;
constexpr size_t CTL_BYTES = CTL_SS1 + (size_t)T * 4;
constexpr size_t WS_XB = al256(CTL_BYTES);
constexpr size_t WS_RS0 = WS_XB + (size_t)T * DM * 2;
constexpr size_t WS_RSMEM = WS_RS0 + (size_t)T * 4;
constexpr size_t WS_ROPEQK = WS_RSMEM + 4096;
constexpr size_t WS_ROPEI = WS_ROPEQK + (size_t)T * 32 * 4;
constexpr size_t WS_MEMB = WS_ROPEI + (size_t)T * 16 * 4;
constexpr size_t WS_WINT = WS_MEMB + (size_t)NB * MEML * DM * 2;
constexpr size_t WS_WOUTT = WS_WINT + (size_t)N1P * DM * 2;
constexpr size_t WS_WQT = WS_WOUTT + (size_t)DM * DM * 2;
constexpr size_t WS_WKVT = WS_WQT + (size_t)512 * DM * 2;
constexpr size_t WS_WOXT = WS_WKVT + (size_t)1024 * DM * 2;
constexpr size_t WS_WGUT = WS_WOXT + (size_t)DM * 512 * 2;
constexpr size_t WS_WDNT = WS_WGUT + (size_t)NEXP * 4096 * DM * 2;
constexpr size_t WS_WRT = WS_WDNT + (size_t)NEXP * DM * DFF * 2;
constexpr size_t WS_ABUF = WS_WRT + (size_t)NEXP * DM * 4;
constexpr size_t WS_PBUF = WS_ABUF + (size_t)T * DM * 2;
constexpr size_t WS_GABUF = WS_PBUF + (size_t)T * DM * 2;
constexpr size_t WS_QB = WS_GABUF + (size_t)T * DM * 2;
constexpr size_t WS_KB = WS_QB + (size_t)T * DM * 2;
constexpr size_t WS_VB = WS_KB + (size_t)T * 512 * 2;
constexpr size_t WS_QIB = WS_VB + (size_t)T * 512 * 2;
constexpr size_t WS_KIB = WS_QIB + (size_t)T * 1024 * 2;
constexpr size_t WS_WIB = WS_KIB + (size_t)T * 64 * 2;
constexpr size_t WS_MASK = WS_WIB + (size_t)T * 16 * 4;
constexpr size_t WS_YATT = WS_MASK + (size_t)T * 128 * 4;
constexpr size_t WS_MERGED = WS_YATT + (size_t)T * DM * 2;
constexpr size_t WS_H1 = WS_MERGED + (size_t)T * DM * 2;
constexpr size_t WS_H1B = WS_H1 + (size_t)T * DM * 4;
constexpr size_t WS_QX = WS_H1B + (size_t)T * DM * 2;
constexpr size_t WS_KX = WS_QX + (size_t)T * 512 * 2;
constexpr size_t WS_VX = WS_KX + (size_t)NB * MEML * 512 * 2;
constexpr size_t WS_OX = WS_VX + (size_t)NB * MEML * 512 * 2;
constexpr size_t WS_H2 = WS_OX + (size_t)T * 512 * 2;
constexpr size_t WS_H2B = WS_H2 + (size_t)T * DM * 4;
constexpr size_t WS_SLOTE = WS_H2B + (size_t)T * DM * 2;
constexpr size_t WS_SLOTR = WS_SLOTE + (size_t)T * 4 * 4;
constexpr size_t WS_SLOTG = WS_SLOTR + (size_t)T * 4 * 4;
constexpr size_t WS_RS2 = WS_SLOTG + (size_t)T * 4 * 4;
constexpr size_t WS_POS = WS_RS2 + (size_t)T * 4;
constexpr size_t WS_RSS = WS_POS + (size_t)T * 4 * 4;
constexpr size_t WS_GWS = WS_RSS + (size_t)CAP_ROWS * 4;
constexpr size_t WS_TILEE = WS_GWS + (size_t)CAP_ROWS * 4;
constexpr size_t WS_ASORT = WS_TILEE + 2048;
constexpr size_t WS_HDN = WS_ASORT + (size_t)CAP_ROWS * DM * 2;
constexpr size_t WS_YS = WS_HDN + (size_t)CAP_ROWS * DFF * 2;
constexpr size_t WS_TIE = WS_YS + (size_t)CAP_ROWS * DM * 2;
constexpr size_t WS_XB8 = WS_TIE;
constexpr size_t WS_END = WS_TIE + (size_t)256 * 8 * 128 * 64 * 4;

__device__ __forceinline__ unsigned cvt_pk_bf16(float lo, float hi) { unsigned r; asm volatile("v_cvt_pk_bf16_f32 %0, %1, %2" : "=v"(r) : "v"(lo), "v"(hi)); return r; }
__device__ __forceinline__ u32x2 pack_fp8x8(float a0, float a1, float a2, float a3, float a4, float a5, float a6, float a7) {
    int lo = 0, hi = 0;
    lo = __builtin_amdgcn_cvt_pk_fp8_f32(a0, a1, lo, false); lo = __builtin_amdgcn_cvt_pk_fp8_f32(a2, a3, lo, true);
    hi = __builtin_amdgcn_cvt_pk_fp8_f32(a4, a5, hi, false); hi = __builtin_amdgcn_cvt_pk_fp8_f32(a6, a7, hi, true);
    return (u32x2){(unsigned)lo, (unsigned)hi};
}
constexpr float W8_SCALE = 64.0f;
__device__ __forceinline__ float bf2f(unsigned short b) { return __uint_as_float(((unsigned)b) << 16); }
__device__ __forceinline__ float bf_lo(unsigned w) { return __uint_as_float(w << 16); }
__device__ __forceinline__ float bf_hi(unsigned w) { return __uint_as_float(w & 0xffff0000u); }
__device__ __forceinline__ float sigmoidf_(float x) { return __builtin_amdgcn_rcpf(1.0f + __expf(-x)); }
__device__ __forceinline__ int lane_id() { int x; asm volatile("v_mbcnt_lo_u32_b32 %0, -1, 0\n\tv_mbcnt_hi_u32_b32 %0, -1, %0" : "=v"(x)); return x; }
__device__ __forceinline__ float wave_sum(float v) {
#pragma unroll
    for (int o = 32; o >= 1; o >>= 1) v += __shfl_xor(v, o);
    return v;
}

#define XB_TMO      128
#define XB_XCNT(j)  (256  + 64 * (j))
#define XB_XSUB(j)  (1280 + 64 * (j))
#define XB_XGEN(j)  (2304 + 64 * (j))
#define XB_TOP      3328
#define XB_TOPGEN   3392
#define XCD_BAR_WORDS 3456
#define XB_SPIN_CAP (1u << 18)

__device__ __forceinline__ unsigned xb_ld(unsigned* p)              { return __hip_atomic_load(p, __ATOMIC_RELAXED, __HIP_MEMORY_SCOPE_AGENT); }
__device__ __forceinline__ unsigned xb_add(unsigned* p, unsigned v) { return __hip_atomic_fetch_add(p, v, __ATOMIC_RELAXED, __HIP_MEMORY_SCOPE_AGENT); }
__device__ __forceinline__ unsigned xb_xcc_id() { return (unsigned)__builtin_amdgcn_s_getreg((3 << 11) | 20) & 0xFu; }
#define XB_SPIN(cond, bar) do { unsigned _sp = 0; while (cond) { __builtin_amdgcn_s_sleep(1); \
    if ((++_sp & 255u) == 0u) { if (xb_ld(&(bar)[XB_TMO])) break; if (_sp > XB_SPIN_CAP) { atomicAdd(&(bar)[XB_TMO], 1u); break; } } } } while (0)

struct XcdBarrier { unsigned* bar; unsigned x; volatile LAS unsigned* st; int wv; };

__device__ __forceinline__ XcdBarrier xcd_barrier_post(unsigned* bar, volatile LAS unsigned* st, int wv) {
    XcdBarrier b; b.bar = bar; b.x = xb_xcc_id(); b.st = st; b.wv = wv;
    if (wv == 0 && lane_id() == 0) (void)xb_add(&bar[XB_XCNT(b.x)], 1u);
    return b;
}
__device__ __forceinline__ void xcd_barrier_complete(unsigned* bar, unsigned x, unsigned& nloc, unsigned& nx) {
    const unsigned G = gridDim.x * gridDim.y * gridDim.z;
    unsigned sum, cnt, mine, sp = 0u;
    for (;;) {
        sum = 0u; cnt = 0u; mine = 0u;
#pragma unroll
        for (unsigned j = 0; j < 16; ++j) { const unsigned c = xb_ld(&bar[XB_XCNT(j)]); sum += c; cnt += (c > 0u) ? 1u : 0u; mine = (j == x) ? c : mine; }
        if (sum == G) break;
        __builtin_amdgcn_s_sleep(1);
        if ((++sp & 255u) == 0u) { if (xb_ld(&bar[XB_TMO])) break; if (sp > XB_SPIN_CAP) { atomicAdd(&bar[XB_TMO], 1u); break; } }
    }
    nloc = mine > 0u ? mine : 1u; nx = cnt > 0u ? cnt : 1u;
}
__device__ __forceinline__ void xcd_barrier(const XcdBarrier& b) {
    asm volatile("s_waitcnt vmcnt(0)" ::: "memory");
    __syncthreads();
    if (b.wv == 0 && lane_id() == 0) {
        unsigned* bar = b.bar;
        __builtin_amdgcn_s_waitcnt(0);
        unsigned nloc = b.st[0], nx = b.st[1];
        if (nloc == 0u) { xcd_barrier_complete(bar, b.x, nloc, nx); b.st[0] = nloc; b.st[1] = nx; }
        const unsigned old = xb_add(&bar[XB_XSUB(b.x)], 1u);
        const unsigned gen = old / nloc;
        if (old + 1u == (gen + 1u) * nloc) {
            __builtin_amdgcn_fence(__ATOMIC_RELEASE, "agent");
            asm volatile("s_waitcnt vmcnt(0)" ::: "memory");
            const unsigned og = xb_add(&bar[XB_TOP], 1u);
            const unsigned tg = og / nx;
            if (og + 1u == (tg + 1u) * nx) xb_add(&bar[XB_TOPGEN], 1u);
            else XB_SPIN(xb_ld(&bar[XB_TOPGEN]) == tg, bar);
            __builtin_amdgcn_fence(__ATOMIC_ACQUIRE, "agent");
            xb_add(&bar[XB_XGEN(b.x)], 1u);
            asm volatile("s_waitcnt vmcnt(0)" ::: "memory");
        } else {
            XB_SPIN(xb_ld(&bar[XB_XGEN(b.x)]) == gen, bar);
            __builtin_amdgcn_fence(__ATOMIC_ACQUIRE, "agent");
            asm volatile("s_waitcnt vmcnt(0)" ::: "memory");
        }
    }
    __syncthreads();
}

constexpr int LDS_CT = 131072;
namespace pg8 {
constexpr int BM = 256, BK = 64, HALF = 128, HTB = HALF * BK * 2, STAGE_BYTES = 8 * HTB, NXCD = 8, WGM = 8;
__device__ __forceinline__ int lds_byte(int r, int c) { const int st = (r >> 4) * 2 + (c >> 5), rr = r & 15, cc = c & 31, ob = rr * 64 + cc * 2; return st * 1024 + (ob ^ (((ob >> 9) & 1) << 5)); }
__device__ __forceinline__ void stage_rc(int b, int& R, int& C) { const int st = b / 1024, sb = b % 1024, swz = sb ^ (((sb >> 9) & 1) << 5); R = (st >> 1) * 16 + swz / 64; C = (st & 1) * 32 + (swz % 64) / 2; }
__device__ __forceinline__ int perm32(int rho) { const int n = rho >> 4, i = rho & 15; return 8 * (i >> 2) + 4 * n + (i & 3); }

struct Unit { const char* a; const char* b; int pm, pn, kind, aux; };

__device__ __forceinline__ void tile_of(int L, int nM, int nN, int& pm, int& pn) {
    const int nwg = nM * nN; int wgid = L;
    { const int q = nwg / NXCD, r = nwg % NXCD, xcd = wgid % NXCD, off = wgid / NXCD; wgid = (xcd < r ? xcd * (q + 1) : r * (q + 1) + (xcd - r) * q) + off; }
    const int nig = WGM * nN, gid = wgid / nig, fm = gid * WGM, gsz = (nM - fm) < WGM ? (nM - fm) : WGM;
    pm = fm + ((wgid % nig) % gsz); pn = (wgid % nig) / gsz;
}


struct SideNone { static constexpr bool ON = false; };
struct SideConv {
    static constexpr bool ON = true;
    const float* src; unsigned char* dst; int gu; int j0, jn; int G, c;
    __device__ __forceinline__ void decode(int j, size_t& soff, int& sld, size_t& doff) const {
        if (gu) { const int e = j >> 11, r = j & 2047, nt = r >> 4, kt = r & 15, n0 = nt * 32, w = n0 & 255, tile = n0 >> 8;
            const int sc = (w < 128) ? 128 * tile + w : 2048 + 128 * tile + (w - 128);
            sld = 4096; soff = (size_t)e * 2048 * 4096 + (size_t)(kt * 128) * 4096 + sc; doff = (size_t)e * 4096 * 2048 + (size_t)n0 * 2048 + kt * 128; }
        else { const int e = j >> 10, r = j & 1023, nt = r >> 4, kt = r & 15, n0 = nt * 32;
            sld = 2048; soff = (size_t)e * 2048 * 2048 + (size_t)(kt * 128) * 2048 + n0; doff = (size_t)e * 2048 * 2048 + (size_t)n0 * 2048 + kt * 128; }
    }
    __device__ __forceinline__ size_t issue(int j, LAS unsigned char* tile, int wid, int lane) const {
        size_t soff, doff; int sld; decode(j, soff, sld, doff);
        const float* sp = src + soff + (size_t)(16 * wid + (lane >> 3)) * sld + (lane & 7) * 4;
        __builtin_amdgcn_global_load_lds((const unsigned*)sp, (LAS unsigned*)(tile + (2 * wid) * 1040), 16, 0, 2);
        __builtin_amdgcn_global_load_lds((const unsigned*)(sp + (size_t)8 * sld), (LAS unsigned*)(tile + (2 * wid + 1) * 1040), 16, 0, 2);
        return doff;
    }
    __device__ __forceinline__ void consume(const LAS unsigned char* tile, size_t doff, int wid, int lane) const {
        float sv[8];
#pragma unroll
        for (int j = 0; j < 8; ++j) sv[j] = *(const LAS float*)(tile + (lane & 15) * 1040 + j * 128 + (4 * wid + (lane >> 4)) * 4);
        __builtin_nontemporal_store(pack_fp8x8(sv[0] * W8_SCALE, sv[1] * W8_SCALE, sv[2] * W8_SCALE, sv[3] * W8_SCALE, sv[4] * W8_SCALE, sv[5] * W8_SCALE, sv[6] * W8_SCALE, sv[7] * W8_SCALE),
                                    (u32x2*)(dst + doff + (size_t)(4 * wid + (lane >> 4)) * 2048 + 8 * (lane & 15)));
    }
    __device__ __forceinline__ void leftover(int done, int wid, int lane) const {
        for (int q = done; j0 + q * G + c < jn; q += 4) {
            float v[4][8]; size_t doff[4]; bool ok[4];
#pragma unroll
            for (int u = 0; u < 4; ++u) {
                const int j = j0 + (q + u) * G + c; ok[u] = j < jn;
                size_t soff; int sld; decode(ok[u] ? j : j0 + q * G + c, soff, sld, doff[u]);
                const float* sp = src + soff + (size_t)(16 * wid + 8 * (lane >> 5)) * sld + (lane & 31);
#pragma unroll
                for (int r = 0; r < 8; ++r) v[u][r] = __builtin_nontemporal_load(sp + (size_t)r * sld);
            }
#pragma unroll
            for (int u = 0; u < 4; ++u)
                if (ok[u]) *(u32x2*)(dst + doff[u] + (size_t)(lane & 31) * 2048 + 16 * wid + 8 * (lane >> 5)) = pack_fp8x8(v[u][0] * W8_SCALE, v[u][1] * W8_SCALE, v[u][2] * W8_SCALE, v[u][3] * W8_SCALE, v[u][4] * W8_SCALE, v[u][5] * W8_SCALE, v[u][6] * W8_SCALE, v[u][7] * W8_SCALE);
        }
    }
};

typedef int i32x4_ __attribute__((ext_vector_type(4)));
typedef int i32x8_ __attribute__((ext_vector_type(8)));
template <class Epi, class Sched, class Side = SideNone, bool FP8 = false>
__device__ __forceinline__ int gemm_phase(LAS unsigned char* lds, const int RB, const Sched& S, const Epi& E, const int wid, const Side& SD = Side{}) {
    const int lane = lane_id(), tid = wid * 64 + lane, wr = wid >> 2, wc = wid & 3, fr = lane & 15, fq = lane >> 4;
    const int nt = RB / 128;
    unsigned voffA[2], voffB[2];
#pragma unroll
    for (int i = 0; i < 2; ++i) { int R, C; stage_rc(tid * 16 + i * 8192, R, C); const int Rb = (R & ~31) + perm32(R & 31);
        voffA[i] = (unsigned)(R * RB + C * 2); voffB[i] = (unsigned)(Rb * RB + C * 2); }
    const size_t kstep = (size_t)(BK * 2);
    const size_t hstep = (size_t)HALF * RB;
    const unsigned ldsw = (unsigned)wid * 1024u;
    const int aoff = lds_byte(wr * 64 + fr, fq * 8), boff = lds_byte(wc * 32 + fr, fq * 8);
#define PG8_SA(b, h) (((b) * 2 + (h)) * HTB)
#define PG8_SB(b, h) ((4 + (b) * 2 + (h)) * HTB)
#define PG8_STAGE(bufoff, gbase, voff) do { _Pragma("unroll") for (int _i = 0; _i < 2; ++_i) \
        __builtin_amdgcn_global_load_lds((const unsigned*)((const char*)(gbase) + (voff)[_i]), (LAS unsigned*)(lds + (bufoff) + ldsw + _i * 8192), 16, 0, 0); } while (0)
#define PG8_LDA(dst, b, h) do { if constexpr (FP8) { _Pragma("unroll") for (int m = 0; m < 4; ++m) dst##8[m] = __builtin_shufflevector(*(const LAS i32x4_*)(lds + PG8_SA(b, h) + aoff + m * 2048), *(const LAS i32x4_*)(lds + PG8_SA(b, h) + aoff + m * 2048 + 1024), 0, 1, 2, 3, 4, 5, 6, 7); } \
        else { _Pragma("unroll") for (int m = 0; m < 4; ++m) _Pragma("unroll") for (int k = 0; k < 2; ++k) dst[m][k] = *(const LAS bf16x8*)(lds + PG8_SA(b, h) + aoff + m * 2048 + k * 1024); } } while (0)
#define PG8_LDB(dst, b, h) do { if constexpr (FP8) { _Pragma("unroll") for (int n = 0; n < 2; ++n) dst##8[n] = __builtin_shufflevector(*(const LAS i32x4_*)(lds + PG8_SB(b, h) + boff + n * 2048), *(const LAS i32x4_*)(lds + PG8_SB(b, h) + boff + n * 2048 + 1024), 0, 1, 2, 3, 4, 5, 6, 7); } \
        else { _Pragma("unroll") for (int n = 0; n < 2; ++n) _Pragma("unroll") for (int k = 0; k < 2; ++k) dst[n][k] = *(const LAS bf16x8*)(lds + PG8_SB(b, h) + boff + n * 2048 + k * 1024); } } while (0)
#define PG8_CAT(X) X
#define PG8_MMA(ai, bj, At, Bt) do { if constexpr (FP8) __builtin_amdgcn_sched_barrier(0); __builtin_amdgcn_s_setprio(1); _Pragma("unroll") for (int m = 0; m < 4; ++m) _Pragma("unroll") for (int n = 0; n < 2; ++n) { \
        if constexpr (FP8) asm volatile("v_mfma_scale_f32_16x16x128_f8f6f4 %0, %1, %2, %0, %3, %3 op_sel_hi:[0,0,0]" : "+v"(acc[ai][bj][m][n]) : "v"(Bt##8[n]), "v"(At##8[m]), "v"(mx_one));   \
        else { _Pragma("unroll") for (int k = 0; k < 2; ++k) acc[ai][bj][m][n] = __builtin_amdgcn_mfma_f32_16x16x32_bf16(Bt[n][k], At[m][k], acc[ai][bj][m][n], 0, 0, 0); } } \
        __builtin_amdgcn_s_setprio(0); if constexpr (FP8) __builtin_amdgcn_sched_barrier(0); } while (0)
#define PG8_WAIT_V(n) asm volatile("s_waitcnt vmcnt(" #n ")" ::: "memory")
#define PG8_WAIT_L(n) asm volatile("s_waitcnt lgkmcnt(" #n ")" ::: "memory")
#define PG8_BAR __builtin_amdgcn_s_barrier()
#define PG8_SCHED __builtin_amdgcn_sched_barrier(0)
    Unit cur, nxt; int ui = 0;
    int sq = 0; bool s_have = false; size_t s_doff = 0;
    if (!S.next(0, cur)) return 0;
    f32x4 acc[2][2][4][2];
#pragma unroll
    for (int a = 0; a < 2; ++a)
#pragma unroll
        for (int b = 0; b < 2; ++b)
#pragma unroll
            for (int m = 0; m < 4; ++m)
#pragma unroll
                for (int n = 0; n < 2; ++n) acc[a][b][m][n] = (f32x4){0.f, 0.f, 0.f, 0.f};
    bf16x8 At[4][2], B0[2][2], B1[2][2];
    const int mx_one = 0x7F7F7F7F;
    i32x8_ At8[4], B08[2], B18[2];
    const char* cA = cur.a; const char* cB = cur.b;
    PG8_STAGE(PG8_SB(0, 0), cB, voffB); PG8_STAGE(PG8_SA(0, 0), cA, voffA); PG8_STAGE(PG8_SB(0, 1), cB + hstep, voffB); PG8_STAGE(PG8_SA(0, 1), cA + hstep, voffA);
    if (wr == 1) PG8_BAR;
    PG8_WAIT_V(4); PG8_BAR;
    PG8_STAGE(PG8_SB(1, 0), cB + kstep, voffB); PG8_STAGE(PG8_SA(1, 0), cA + kstep, voffA); PG8_STAGE(PG8_SB(1, 1), cB + hstep + kstep, voffB);
    PG8_WAIT_V(6); PG8_BAR;
    for (;;) {
        const bool has_next = S.next(ui + 1, nxt);
        const char* nA = has_next ? nxt.a : cA; const char* nB = has_next ? nxt.b : cB;
        const int lzp = lane_id(); const typename Epi::Pre pre = E.pre(cur, wr, wc, lzp & 15, lzp >> 4);
        for (int t = 0; t < nt; t += 2) {
            const bool last = (t == nt - 2);
            const char* a1 = cA + (size_t)(t + 1) * kstep;
            const char* a2 = last ? nA : cA + (size_t)(t + 2) * kstep; const char* b2 = last ? nB : cB + (size_t)(t + 2) * kstep;
            const char* a3 = a2 + kstep; const char* b3 = b2 + kstep;
            PG8_LDB(B0, 0, 0); PG8_SCHED; PG8_LDA(At, 0, 0); PG8_STAGE(PG8_SA(1, 1), a1 + hstep, voffA);
            PG8_WAIT_L(8); PG8_BAR; PG8_WAIT_L(0); PG8_MMA(0, 0, At, B0); PG8_BAR; PG8_SCHED;
            PG8_LDB(B1, 0, 1);
            float sv[8]; const bool s_st = Side::ON && s_have;
            if constexpr (Side::ON) { if (s_st) {
#pragma unroll
                for (int j = 0; j < 8; ++j) sv[j] = *(const LAS float*)(lds + LDS_CT + (lane & 15) * 1040 + j * 128 + (4 * wid + (lane >> 4)) * 4); } }
            PG8_STAGE(PG8_SB(0, 0), b2, voffB);
            PG8_BAR; PG8_WAIT_L(0);
            u32x2 sw; if constexpr (Side::ON) { if (s_st) sw = pack_fp8x8(sv[0] * W8_SCALE, sv[1] * W8_SCALE, sv[2] * W8_SCALE, sv[3] * W8_SCALE, sv[4] * W8_SCALE, sv[5] * W8_SCALE, sv[6] * W8_SCALE, sv[7] * W8_SCALE); }
            PG8_MMA(0, 1, At, B1); PG8_BAR;
            PG8_LDA(At, 0, 1);
            if constexpr (Side::ON) { if (s_st) *(u32x2*)(SD.dst + s_doff + (size_t)(4 * wid + (lane >> 4)) * 2048 + 8 * (lane & 15)) = sw; }
            PG8_STAGE(PG8_SA(0, 0), a2, voffA);
            PG8_BAR; PG8_WAIT_L(0); PG8_MMA(1, 0, At, B0); PG8_BAR; PG8_SCHED;
            PG8_STAGE(PG8_SB(0, 1), b2 + hstep, voffB);
            if (Side::ON && s_st) { PG8_WAIT_V(7); } else { PG8_WAIT_V(6); }
            PG8_BAR; PG8_MMA(1, 1, At, B1); PG8_BAR;
            PG8_LDB(B0, 1, 0); PG8_SCHED; PG8_LDA(At, 1, 0);
            if constexpr (Side::ON) {
                s_have = false;
                if (SD.j0 + sq * SD.G + SD.c < SD.jn) { size_t soff; int sld; SD.decode(SD.j0 + sq * SD.G + SD.c, soff, sld, s_doff);
                    const float* sp = SD.src + soff + (size_t)(16 * wid + (lane >> 3)) * sld + (lane & 7) * 4;
                    __builtin_amdgcn_global_load_lds((const unsigned*)sp, (LAS unsigned*)(lds + LDS_CT + (2 * wid) * 1040), 16, 0, 2);
                    __builtin_amdgcn_global_load_lds((const unsigned*)(sp + (size_t)8 * sld), (LAS unsigned*)(lds + LDS_CT + (2 * wid + 1) * 1040), 16, 0, 2);
                    s_have = true; ++sq; }
            }
            PG8_STAGE(PG8_SA(0, 1), a2 + hstep, voffA);
            PG8_WAIT_L(8); PG8_BAR; PG8_WAIT_L(0); PG8_MMA(0, 0, At, B0); PG8_BAR; PG8_SCHED;
            PG8_LDB(B1, 1, 1); PG8_STAGE(PG8_SB(1, 0), b3, voffB);
            PG8_BAR; PG8_WAIT_L(0); PG8_MMA(0, 1, At, B1); PG8_BAR;
            PG8_LDA(At, 1, 1); PG8_STAGE(PG8_SA(1, 0), a3, voffA);
            PG8_BAR; PG8_WAIT_L(0); PG8_MMA(1, 0, At, B0); PG8_BAR; PG8_SCHED;
            PG8_STAGE(PG8_SB(1, 1), b3 + hstep, voffB);
            PG8_WAIT_V(6); PG8_BAR; PG8_MMA(1, 1, At, B1); PG8_BAR;
        }
        if constexpr (FP8) asm volatile("s_nop 15\n s_nop 7" ::: "memory");
        { const int lz = lane_id(); E(acc, cur, wr, wc, lz & 15, lz >> 4, pre); }
        if (!has_next) break;
#pragma unroll
        for (int a = 0; a < 2; ++a)
#pragma unroll
            for (int b = 0; b < 2; ++b)
#pragma unroll
                for (int m = 0; m < 4; ++m)
#pragma unroll
                    for (int n = 0; n < 2; ++n) acc[a][b][m][n] = (f32x4){0.f, 0.f, 0.f, 0.f};
        cur = nxt; cA = nA; cB = nB; ++ui;
    }
    PG8_WAIT_V(0);
    if (wr == 0) PG8_BAR;
    PG8_BAR;
    if constexpr (Side::ON) { if (s_have) {
        float sv[8];
#pragma unroll
        for (int j = 0; j < 8; ++j) sv[j] = *(const LAS float*)(lds + LDS_CT + (lane & 15) * 1040 + j * 128 + (4 * wid + (lane >> 4)) * 4);
        *(u32x2*)(SD.dst + s_doff + (size_t)(4 * wid + (lane >> 4)) * 2048 + 8 * (lane & 15)) =
            pack_fp8x8(sv[0] * W8_SCALE, sv[1] * W8_SCALE, sv[2] * W8_SCALE, sv[3] * W8_SCALE, sv[4] * W8_SCALE, sv[5] * W8_SCALE, sv[6] * W8_SCALE, sv[7] * W8_SCALE); } }
#undef PG8_SA
#undef PG8_SB
#undef PG8_STAGE
#undef PG8_LDA
#undef PG8_LDB
#undef PG8_MMA
#undef PG8_WAIT_V
#undef PG8_WAIT_L
#undef PG8_BAR
#undef PG8_SCHED
#undef PG8_CAT
    return sq;
}
}
using pg8::Unit;

struct Args { const void* in[21]; float* out; unsigned char* ws; int ph_lo, ph_hi; };
enum { IN_X = 0, IN_MEM, IN_POS, IN_NORM_MIX, IN_W_IN, IN_CONV_W, IN_W_OUT, IN_NORM_XATTN, IN_NORM_MEM, IN_WQ_X, IN_WK_X, IN_WV_X, IN_WO_X, IN_NORM_FFN,
       IN_W_ROUTER, IN_B_ROUTER, IN_W_GU, IN_B_GU, IN_W_DN, IN_B_DN, IN_NORM_FINAL };
constexpr int LDS_BYTES = 163840;
constexpr int LDS_MISC = 155648;

struct Frame {
    const Args* a; unsigned char* ws; LAS unsigned char* lds; int wave, G, bid;
    __device__ __forceinline__ int lane_() const { return lane_id(); }
    __device__ __forceinline__ int tid_() const { return wave * 64 + lane_id(); }
    template <class Tp> __device__ __forceinline__ Tp* W(size_t off) const { return (Tp*)(ws + off); }
    template <class Tp> __device__ __forceinline__ const Tp* I(int k) const { return (const Tp*)a->in[k]; }
};

__constant__ float c_invfreq[16] = {1.000000000e+00f, 4.403665960e-01f, 1.939227432e-01f, 8.539710194e-02f, 3.760603070e-02f, 1.656044088e-02f, 7.292664610e-03f, 3.211446106e-03f,
                                    1.414213562e-03f, 6.227724371e-04f, 2.742481884e-04f, 1.207697351e-04f, 5.318295734e-05f, 2.341999971e-05f, 1.031338525e-05f, 4.541670478e-06f};

__device__ __forceinline__ int win_src_col(int c) {
    const int tile = c >> 8, w = c & 255;
    if (tile < TL_P) { const int i = tile - TL_A; return w < 128 ? C_CB + 128 * i + w : C_GC + 128 * i + (w - 128); }
    if (tile < TL_G) { const int i = tile - TL_P; return w < 128 ? C_CC + 128 * i + w : C_CX + 128 * i + (w - 128); }
    if (tile < TL_Q) return C_GA + 256 * (tile - TL_G) + w;
    if (tile < TL_V) {
        const int col = (tile < TL_K) ? 256 * (tile - TL_Q) + w : 256 * (tile - TL_K) + w; const int base = (tile < TL_K) ? C_Q : C_K;
        const int d = col & 127; int pd = d;
        if (d < 32) { const int f = d >> 3, r = d & 7; pd = (r < 4) ? 4 * f + r : 16 + 4 * f + (r - 4); }
        return base + (col & ~127) + pd;
    }
    if (tile < TL_QI) return C_V + 256 * (tile - TL_V) + w;
    if (tile < TL_KI) { const int col = 256 * (tile - TL_QI) + w; const int d = col & 63; int pd = d;
        if (d < 16) { const int f = d >> 3, r = d & 7; pd = (r < 4) ? 4 * f + r : 8 + 4 * f + (r - 4); }
        return C_QI + (col & ~63) + pd; }
    if (w < 64) { int pd = w; if (w < 16) { const int f = w >> 3, r = w & 7; pd = (r < 4) ? 4 * f + r : 8 + 4 * f + (r - 4); } return C_KI + pd; }
    if (w < 80) return C_WI + (w - 64);
    return -1;
}

enum { MAP_ID = 0, MAP_WIN = 1, MAP_KV = 2, MAP_GU = 3 };
struct TJob { const float* src; const float* src2; const float* scale; bf16_t* dst; int src_ld, K, n0, k0, map, f8; };
__device__ __forceinline__ void tjob_load(const TJob& J, int wave, int lane, f32x4 (&R)[8]) {
    const int n = J.n0 + 32 * wave + (lane & 7) * 4;
    const float* sp = J.src; int sc = n;
    if (J.map == MAP_WIN) sc = win_src_col(n);
    else if (J.map == MAP_KV) { if (n >= 512) { sp = J.src2; sc = n - 512; } }
    else if (J.map == MAP_GU) { const int tile = n >> 8, w = n & 255; sc = (w < 128) ? 128 * tile + w : 2048 + 128 * tile + (w - 128); }
    const float* p = sp + (size_t)(J.k0 + 8 * (lane >> 3)) * J.src_ld + (sc >= 0 ? sc : 0);
#pragma unroll
    for (int j = 0; j < 8; ++j) { R[j] = (sc >= 0) ? __builtin_nontemporal_load((const f32x4*)(p + (size_t)j * J.src_ld)) : (f32x4){0.f, 0.f, 0.f, 0.f}; }
}
__device__ __forceinline__ void tjob_store(const TJob& J, int wave, int lane, const f32x4 (&R)[8]) {
    const int n = J.n0 + 32 * wave + (lane & 7) * 4, k = J.k0 + 8 * (lane >> 3);
    f32x4 s0 = (f32x4){1.f, 1.f, 1.f, 1.f}, s1 = s0;
    if (J.scale) { s0 = *(const f32x4*)(J.scale + k); s1 = *(const f32x4*)(J.scale + k + 4); }
    if (J.f8) {
        s0 *= W8_SCALE; s1 *= W8_SCALE;
#pragma unroll
        for (int c = 0; c < 4; ++c)
            __builtin_nontemporal_store(pack_fp8x8(R[0][c] * s0[0], R[1][c] * s0[1], R[2][c] * s0[2], R[3][c] * s0[3], R[4][c] * s1[0], R[5][c] * s1[1], R[6][c] * s1[2], R[7][c] * s1[3]),
                                        (u32x2*)((unsigned char*)J.dst + (size_t)(n + c) * J.K + k));
        return;
    }
#pragma unroll
    for (int c = 0; c < 4; ++c) {
        u32x4 w;
        w.x = cvt_pk_bf16(R[0][c] * s0[0], R[1][c] * s0[1]); w.y = cvt_pk_bf16(R[2][c] * s0[2], R[3][c] * s0[3]);
        w.z = cvt_pk_bf16(R[4][c] * s1[0], R[5][c] * s1[1]); w.w = cvt_pk_bf16(R[6][c] * s1[2], R[7][c] * s1[3]);
        __builtin_nontemporal_store(w, (u32x4*)(J.dst + (size_t)(n + c) * J.K + k));
    }
}

__device__ __forceinline__ void row_cvt(const float* src, bf16_t* dst, float* rs, int lane, unsigned char* dst8 = nullptr) {
    float ss = 0.f;
#pragma unroll
    for (int i = 0; i < 4; ++i) {
        const int c = (i * 64 + lane) * 8;
        const f32x4 a = *(const f32x4*)(src + c), b = *(const f32x4*)(src + c + 4);
        ss += a[0] * a[0] + a[1] * a[1] + a[2] * a[2] + a[3] * a[3] + b[0] * b[0] + b[1] * b[1] + b[2] * b[2] + b[3] * b[3];
        u32x4 w; w.x = cvt_pk_bf16(a[0], a[1]); w.y = cvt_pk_bf16(a[2], a[3]); w.z = cvt_pk_bf16(b[0], b[1]); w.w = cvt_pk_bf16(b[2], b[3]);
        *(u32x4*)(dst + c) = w;
        if (dst8) *(u32x2*)(dst8 + c) = pack_fp8x8(a[0], a[1], a[2], a[3], b[0], b[1], b[2], b[3]);
    }
    ss = wave_sum(ss);
    if (lane == 0) *rs = __builtin_amdgcn_rsqf(ss * (1.0f / DM) + NORM_EPS);
}

constexpr int SJ_GU = NEXP * 32 * 64, SJ_GU_P1 = 256 * 160, SJ_GU_P2 = SJ_GU_P1 + 256 * 64, SJ_DN = NEXP * 32 * 32, SJ_DN_P6 = 128 * 32;
constexpr int J_WIN = N1_TILES * 32, J_WOUT = 8 * 32, J_WQ = 2 * 32, J_WKV = 4 * 32, J_WOX = 8 * 8, J_GU = 16 * 32, J_DN = 8 * 32;
constexpr int TJ0 = J_WIN, TJ1 = TJ0 + J_WOUT, TJ2 = TJ1 + J_WQ, TJ3 = TJ2 + J_WKV, TJ_EARLY = TJ3 + J_WOX, TJ5 = TJ_EARLY + NEXP * J_GU, TJ_ALL = TJ5 + NEXP * J_DN;
__device__ __forceinline__ TJob tjob_decode(const Frame& F, int j) {
    TJob J; J.src2 = nullptr; J.scale = nullptr; J.src_ld = DM; J.K = DM; J.map = MAP_ID; J.f8 = 0;
    if (j < TJ0) { const int nt = j >> 5, kt = j & 31; J.src = F.I<float>(IN_W_IN); J.src_ld = DIN; J.scale = F.I<float>(IN_NORM_MIX); J.dst = F.W<bf16_t>(WS_WINT); J.map = MAP_WIN; J.n0 = nt * 256; J.k0 = kt * 64; J.f8 = nt < TL_P || (nt >= TL_G && nt < TL_QI); if (J.f8) J.dst += (size_t)nt * 128 * DM; }
    else if (j < TJ1) { const int q = j - TJ0, nt = q >> 5, kt = q & 31; J.src = F.I<float>(IN_W_OUT); J.dst = F.W<bf16_t>(WS_WOUTT); J.n0 = nt * 256; J.k0 = kt * 64; }
    else if (j < TJ2) { const int q = j - TJ1, nt = q >> 5, kt = q & 31; J.src = F.I<float>(IN_WQ_X); J.src_ld = 512; J.scale = F.I<float>(IN_NORM_XATTN); J.dst = F.W<bf16_t>(WS_WQT); J.n0 = nt * 256; J.k0 = kt * 64; }
    else if (j < TJ3) { const int q = j - TJ2, nt = q >> 5, kt = q & 31; J.src = F.I<float>(IN_WK_X); J.src2 = F.I<float>(IN_WV_X); J.src_ld = 512; J.scale = F.I<float>(IN_NORM_MEM); J.dst = F.W<bf16_t>(WS_WKVT); J.map = MAP_KV; J.n0 = nt * 256; J.k0 = kt * 64; }
    else if (j < TJ_EARLY) { const int q = j - TJ3, nt = q >> 3, kt = q & 7; J.src = F.I<float>(IN_WO_X); J.dst = F.W<bf16_t>(WS_WOXT); J.K = 512; J.n0 = nt * 256; J.k0 = kt * 64; }
    else if (j < TJ5) { const int q = j - TJ_EARLY, e = q / J_GU, r = q % J_GU, nt = r >> 5, kt = r & 31;
        J.src = F.I<float>(IN_W_GU) + (size_t)e * DM * 4096; J.src_ld = 4096; J.scale = F.I<float>(IN_NORM_FFN); J.dst = F.W<bf16_t>(WS_WGUT) + (size_t)e * 4096 * DM; J.map = MAP_GU; J.n0 = nt * 256; J.k0 = kt * 64; }
    else { const int q = j - TJ5, e = q / J_DN, r = q % J_DN, nt = r >> 5, kt = r & 31;
        J.src = F.I<float>(IN_W_DN) + (size_t)e * DFF * DM; J.dst = F.W<bf16_t>(WS_WDNT) + (size_t)e * DM * DFF; J.K = DFF; J.n0 = nt * 256; J.k0 = kt * 64; }
    return J;
}
template <int NS>
__device__ __forceinline__ void convert_weights(const Frame& F, int jlo, int jhi, int first, int step) {
    f32x4 R[NS][8]; TJob J[NS]; int jj[NS];
    const int wv = F.wave, ln = F.lane_();
    int j = jlo + first;
#pragma unroll
    for (int s = 0; s < NS - 1; ++s) { jj[s] = j; if (j < jhi) { J[s] = tjob_decode(F, j); tjob_load(J[s], wv, ln, R[s]); } j += step; }
    for (;;) {
        bool done = false;
#pragma unroll
        for (int s = 0; s < NS; ++s) {
            if (!done) {
                constexpr int dummy = 0; (void)dummy;
                const int sl = (s + NS - 1) % NS;
                jj[sl] = j; if (j < jhi) { J[sl] = tjob_decode(F, j); tjob_load(J[sl], wv, ln, R[sl]); } j += step;
                if (jj[s] >= jhi) done = true; else tjob_store(J[s], wv, ln, R[s]);
            }
        }
        if (done) break;
    }
}

__device__ __forceinline__ void p0_prologue(const Frame& F) {
    const int G = F.G, bid = F.bid;
    convert_weights<3>(F, 0, TJ_EARLY, bid, G);
    for (int r = bid * 8 + F.wave; r < T + NB * MEML; r += G * 8) {
        if (r < T) row_cvt(F.I<float>(IN_X) + (size_t)r * DM, F.W<bf16_t>(WS_XB) + (size_t)r * DM, F.W<float>(WS_RS0) + r, F.lane_(), F.W<unsigned char>(WS_XB8) + (size_t)r * DM);
        else { const int m = r - T; row_cvt(F.I<float>(IN_MEM) + (size_t)m * DM, F.W<bf16_t>(WS_MEMB) + (size_t)m * DM, F.W<float>(WS_RSMEM) + m, F.lane_()); }
    }
    for (int i = bid * 512 + F.tid_(); i < T * 24; i += G * 512) {
        const int t = i / 24, f = i % 24;
        const float inv = f < 16 ? c_invfreq[f] : c_invfreq[2 * (f - 16)];
        const float ang = (float)F.I<int>(IN_POS)[t] * inv;
        double rev = (double)ang * 0.15915494309189533577; rev -= __builtin_rint(rev);
        const float rv = (float)rev;
        const float sn = __builtin_amdgcn_sinf(rv), cs = __builtin_amdgcn_cosf(rv);
        if (f < 16) { F.W<float>(WS_ROPEQK)[t * 32 + f] = cs; F.W<float>(WS_ROPEQK)[t * 32 + 16 + f] = sn; }
        else { F.W<float>(WS_ROPEI)[t * 16 + (f - 16)] = cs; F.W<float>(WS_ROPEI)[t * 16 + 8 + (f - 16)] = sn; }
    }
    for (int i = bid * 512 + F.tid_(); i < NEXP * DM; i += G * 512) {
        const int e = i / DM, k = i % DM;
        F.W<float>(WS_WRT)[i] = F.I<float>(IN_NORM_FFN)[k] * F.I<float>(IN_W_ROUTER)[k * NEXP + e];
    }
}

enum { KD_A = 0, KD_P, KD_G, KD_Q, KD_K, KD_V, KD_QI, KD_KI, KD_KVX };
struct SchedG1F {
    int G, c; const char* xb8; const char* wint;
    static constexpr int NT8 = TL_P + (TL_QI - TL_G);
    __device__ __forceinline__ bool next(int i, Unit& u) const {
        int L = i * G + c;
        if (G == 256) {
            if (i == 8) { if (c >= 176) return false; L = 2048 + c; }
            else if (i == 9) { if (c >= 80) return false; L = 2224 + c; }
            else if (i > 9) return false;
        }
        if (L >= 64 * NT8) return false;
        int pm, pn; pg8::tile_of(L, 64, NT8, pm, pn); if (pn >= TL_P) pn += TL_G - TL_P; u.pm = pm; u.pn = pn; u.a = xb8 + (size_t)pm * 256 * DM; u.b = wint + (size_t)pn * 256 * DM * 2;
        u.kind = pn < TL_P ? KD_A : pn < TL_Q ? KD_G : pn < TL_K ? KD_Q : pn < TL_V ? KD_K : KD_V; u.aux = 0; return true;
    }
};
struct SchedG1 {
    int G, c; const char* xb; const char* wint; const char* memb; const char* wkvt;
    __device__ __forceinline__ bool next(int i, Unit& u) const {
        constexpr int NT = N1_TILES - SchedG1F::NT8;
        const int L = i * G + c; constexpr int NW1 = 64 * NT;
        if (L < NW1) { int pm, pn; pg8::tile_of(L, 64, NT, pm, pn); pn = pn < TL_G - TL_P ? TL_P + pn : TL_QI + (pn - (TL_G - TL_P)); u.pm = pm; u.pn = pn; u.a = xb + (size_t)pm * 256 * DM * 2; u.b = wint + (size_t)pn * 256 * DM * 2;
            u.kind = pn < TL_P ? KD_A : pn < TL_G ? KD_P : pn < TL_Q ? KD_G : pn < TL_K ? KD_Q : pn < TL_V ? KD_K : pn < TL_QI ? KD_V : pn < TL_KI ? KD_QI : KD_KI; u.aux = 0; return true; }
        const int q = L - NW1; if (q >= 16) return false;
        u.pm = q & 3; u.pn = q >> 2; u.a = memb + (size_t)u.pm * 256 * DM * 2; u.b = wkvt + (size_t)u.pn * 256 * DM * 2; u.kind = KD_KVX; u.aux = 0; return true;
    }
};
__device__ __forceinline__ void st_bf16x8(bf16_t* p, const f32x4& a, const f32x4& b) {
    u32x4 w; w.x = cvt_pk_bf16(a[0], a[1]); w.y = cvt_pk_bf16(a[2], a[3]); w.z = cvt_pk_bf16(b[0], b[1]); w.w = cvt_pk_bf16(b[2], b[3]);
    *(u32x4*)p = w;
}
struct EpiG1 {
    const float* rs0; const float* rsmem; const float* ropeqk; const float* ropei;
    bf16_t* abuf; bf16_t* pbuf; bf16_t* gabuf; bf16_t* qb; bf16_t* kb; bf16_t* vb; bf16_t* qib; bf16_t* kib; float* wib; bf16_t* kx; bf16_t* vx; float sc;
    struct Pre { };
    __device__ __forceinline__ Pre pre(const Unit&, int, int, int, int) const { return Pre{}; }
    __device__ __forceinline__ void operator()(const f32x4 (&acc)[2][2][4][2], const Unit& u, int wr, int wc, int fr, int fq, const Pre&) const {
        const int kind = u.kind, pn = u.pn;
        const int cw = 32 * wc + 8 * fq;
        const int rowb = u.pm * 256 + wr * 64 + fr;
        float rsv[8];
        { const float* rsp = (kind == KD_KVX) ? rsmem : rs0;
#pragma unroll
          for (int q = 0; q < 8; ++q) rsv[q] = rsp[rowb + (q >> 2) * 128 + (q & 3) * 16] * sc; }
        const bool rotqk = (kind == KD_Q || kind == KD_K) && (wc == 0);
        const bool roti = (kind == KD_QI && ((wc & 1) == 0) && fq < 2) || (kind == KD_KI && wc == 0 && fq < 2);
#pragma unroll
        for (int ai = 0; ai < 2; ++ai) {
            f32x4 cs[4], sn[4];
#pragma unroll
            for (int q = 0; q < 4; ++q) { cs[q] = (f32x4){1.f, 1.f, 1.f, 1.f}; sn[q] = (f32x4){0.f, 0.f, 0.f, 0.f}; }
            if (rotqk) {
#pragma unroll
                for (int q = 0; q < 4; ++q) { const float* tp = ropeqk + (size_t)(rowb + ai * 128 + q * 16) * 32 + 4 * fq; cs[q] = *(const f32x4*)tp; sn[q] = *(const f32x4*)(tp + 16); }
            } else if (roti) {
#pragma unroll
                for (int q = 0; q < 4; ++q) { const float* tp = ropei + (size_t)(rowb + ai * 128 + q * 16) * 16 + 4 * fq; cs[q] = *(const f32x4*)tp; sn[q] = *(const f32x4*)(tp + 8); }
            }
#pragma unroll
            for (int m = 0; m < 4; ++m) {
                const int row = rowb + ai * 128 + m * 16, q = m;
                const float rs = rsv[ai * 4 + m];
                if (kind == KD_KVX) {
                    bf16_t* o = (pn < 2 ? kx : vx) + (size_t)row * 512 + 256 * (pn & 1) + cw;
#pragma unroll
                    for (int bj = 0; bj < 2; ++bj) st_bf16x8(o + 128 * bj, acc[ai][bj][m][0] * rs, acc[ai][bj][m][1] * rs);
                } else if (kind == KD_A) {
                    f32x4 o0, o1;
#pragma unroll
                    for (int j = 0; j < 4; ++j) { o0[j] = acc[ai][0][m][0][j] * rs * sigmoidf_(acc[ai][1][m][0][j] * rs); o1[j] = acc[ai][0][m][1][j] * rs * sigmoidf_(acc[ai][1][m][1][j] * rs); }
                    st_bf16x8(abuf + (size_t)row * DM + 128 * (pn - TL_A) + cw, o0, o1);
                } else if (kind == KD_P) {
                    const float r2 = rs * rs;
                    st_bf16x8(pbuf + (size_t)row * DM + 128 * (pn - TL_P) + cw, acc[ai][0][m][0] * acc[ai][1][m][0] * r2, acc[ai][0][m][1] * acc[ai][1][m][1] * r2);
                } else if (kind == KD_G) {
#pragma unroll
                    for (int bj = 0; bj < 2; ++bj) { f32x4 o0, o1;
#pragma unroll
                        for (int j = 0; j < 4; ++j) { o0[j] = sigmoidf_(acc[ai][bj][m][0][j] * rs); o1[j] = sigmoidf_(acc[ai][bj][m][1][j] * rs); }
                        st_bf16x8(gabuf + (size_t)row * DM + 256 * (pn - TL_G) + 128 * bj + cw, o0, o1); }
                } else if (kind == KD_Q || kind == KD_K) {
                    bf16_t* o = (kind == KD_Q) ? qb + (size_t)row * DM + 256 * (pn - TL_Q) + cw : kb + (size_t)row * 512 + 256 * (pn - TL_K) + cw;
#pragma unroll
                    for (int bj = 0; bj < 2; ++bj) {
                        const f32x4 x1 = acc[ai][bj][m][0] * rs, x2 = acc[ai][bj][m][1] * rs;
                        if (rotqk) st_bf16x8(o + 128 * bj, x1 * cs[q] - x2 * sn[q], x2 * cs[q] + x1 * sn[q]);
                        else st_bf16x8(o + 128 * bj, x1, x2);
                    }
                } else if (kind == KD_V) {
#pragma unroll
                    for (int bj = 0; bj < 2; ++bj) st_bf16x8(vb + (size_t)row * 512 + 256 * (pn - TL_V) + 128 * bj + cw, acc[ai][bj][m][0] * rs, acc[ai][bj][m][1] * rs);
                } else if (kind == KD_QI) {
#pragma unroll
                    for (int bj = 0; bj < 2; ++bj) {
                        const f32x4 x1 = acc[ai][bj][m][0] * rs, x2 = acc[ai][bj][m][1] * rs;
                        bf16_t* o = qib + (size_t)row * 1024 + 256 * (pn - TL_QI) + 128 * bj + cw;
                        if (roti) st_bf16x8(o, x1 * cs[q] - x2 * sn[q], x2 * cs[q] + x1 * sn[q]); else st_bf16x8(o, x1, x2);
                    }
                } else {
                    const f32x4 x1 = acc[ai][0][m][0] * rs, x2 = acc[ai][0][m][1] * rs;
                    if (wc < 2) {
                        if (roti) st_bf16x8(kib + (size_t)row * 64 + cw, x1 * cs[q] - x2 * sn[q], x2 * cs[q] + x1 * sn[q]);
                        else st_bf16x8(kib + (size_t)row * 64 + cw, x1, x2);
                    } else if (wc == 2 && fq < 2) {
                        *(f32x4*)(wib + (size_t)row * 16 + 8 * fq) = x1 * 0.03125f; *(f32x4*)(wib + (size_t)row * 16 + 8 * fq + 4) = x2 * 0.03125f;
                    }
                }
            }
        }
    }
};

struct SchedDense { int G, c, nM, nN; const char* A; const char* Bt; size_t tstep;
    __device__ __forceinline__ bool next(int i, Unit& u) const {
        const int L = i * G + c; if (L >= nM * nN) return false;
        int pm, pn; pg8::tile_of(L, nM, nN, pm, pn); u.pm = pm; u.pn = pn; u.a = A + (size_t)pm * tstep; u.b = Bt + (size_t)pn * tstep; u.kind = 0; u.aux = 0; return true; }
};
template <bool RF32>
struct EpiResid { const void* resid; bf16_t* hb; float* ss;
    struct Pre { };
    __device__ __forceinline__ Pre pre(const Unit&, int, int, int, int) const { return Pre{}; }
    __device__ __forceinline__ void operator()(const f32x4 (&acc)[2][2][4][2], const Unit& u, int wr, int wc, int fr, int fq, const Pre&) const {
        const size_t off0 = (size_t)(u.pm * 256 + wr * 64 + fr) * DM + u.pn * 256 + 32 * wc + 8 * fq;
#pragma unroll
        for (int ai = 0; ai < 2; ++ai) {
            f32x4 r0[4][2], r1[4][2];
#pragma unroll
            for (int m = 0; m < 4; ++m)
#pragma unroll
                for (int bj = 0; bj < 2; ++bj) {
                    const size_t off = off0 + (size_t)(ai * 128 + m * 16) * DM + 128 * bj;
                    if (RF32) { r0[m][bj] = *(const f32x4*)((const float*)resid + off); r1[m][bj] = *(const f32x4*)((const float*)resid + off + 4); }
                    else { const u32x4 rb = *(const u32x4*)((const bf16_t*)resid + off);
                        r0[m][bj] = (f32x4){bf_lo(rb.x), bf_hi(rb.x), bf_lo(rb.y), bf_hi(rb.y)}; r1[m][bj] = (f32x4){bf_lo(rb.z), bf_hi(rb.z), bf_lo(rb.w), bf_hi(rb.w)}; }
                }
#pragma unroll
            for (int m = 0; m < 4; ++m) {
                const int row = u.pm * 256 + ai * 128 + wr * 64 + m * 16 + fr; float sq = 0.f;
#pragma unroll
                for (int bj = 0; bj < 2; ++bj) {
                    const size_t off = off0 + (size_t)(ai * 128 + m * 16) * DM + 128 * bj;
                    const f32x4 v0 = acc[ai][bj][m][0] + r0[m][bj], v1 = acc[ai][bj][m][1] + r1[m][bj];
                    st_bf16x8(hb + off, v0, v1);
                    sq += v0[0] * v0[0] + v0[1] * v0[1] + v0[2] * v0[2] + v0[3] * v0[3] + v1[0] * v1[0] + v1[1] * v1[1] + v1[2] * v1[2] + v1[3] * v1[3];
                }
                if (ss) { sq += __shfl_xor(sq, 16); sq += __shfl_xor(sq, 32); if (fq == 0) atomicAdd(ss + row, sq); }
            }
        }
    }
};

struct EpiScaleBf16 { const float* ss; bf16_t* out; int ldo;
    struct Pre { float rsv[8]; };
    __device__ __forceinline__ Pre pre(const Unit& u, int wr, int wc, int fr, int fq) const {
        Pre p;
#pragma unroll
        for (int q = 0; q < 8; ++q) p.rsv[q] = ss[u.pm * 256 + (q >> 2) * 128 + wr * 64 + (q & 3) * 16 + fr];
        return p;
    }
    __device__ __forceinline__ void operator()(const f32x4 (&acc)[2][2][4][2], const Unit& u, int wr, int wc, int fr, int fq, const Pre& pr) const {
        const float (&rsv)[8] = pr.rsv;
#pragma unroll
        for (int ai = 0; ai < 2; ++ai)
#pragma unroll
            for (int m = 0; m < 4; ++m) {
                const int row = u.pm * 256 + ai * 128 + wr * 64 + m * 16 + fr; const float rs = __builtin_amdgcn_rsqf(rsv[ai * 4 + m] * (1.0f / DM) + NORM_EPS);
#pragma unroll
                for (int bj = 0; bj < 2; ++bj) st_bf16x8(out + (size_t)row * ldo + u.pn * 256 + 128 * bj + 32 * wc + 8 * fq, acc[ai][bj][m][0] * rs, acc[ai][bj][m][1] * rs);
            }
    }
};

namespace att {
constexpr int D = 128, NW = 8, QBLK = 32, KVBLK = 64, QB = NW * QBLK;
constexpr int SHM_V = KVBLK * D * 2, SHM_K = KVBLK * D * 2;
constexpr int LDS_QOFF = 2 * SHM_V + 2 * SHM_K + NW * 64 * 4;
constexpr int LDS_BYTES_ATT = LDS_QOFF + NW * 8192;
static_assert(LDS_BYTES_ATT <= 135168, "attention LDS map");
constexpr float SCALE = 0.08838834764831845f;
constexpr float THR = 8.f;
typedef short s16x4 __attribute__((ext_vector_type(4)));
#define KSWZ(row, colB) ((row) * 256 + ((colB) ^ (((row) & 7) << 4)))
#define SBAR() __builtin_amdgcn_sched_barrier(0)
__device__ __forceinline__ int v_st(int k, int c) { const int kk = (k & ~0xC) | ((k & 4) << 1) | ((k & 8) >> 1); return ((kk >> 3) * 4 + (c >> 5)) * 512 + ((kk & 7) * 32 + (c & 31)) * 2; }
__device__ __forceinline__ int v_rd_base(int lane) { return ((lane & 3) << 3) | (((lane >> 2) & 3) << 6) | (((lane >> 4) & 1) << 5) | (((lane >> 5) & 1) << 8); }
constexpr int v_rd_off(int d0, int ks, int half) { return d0 * 512 + ks * 4096 + half * 2048; }
__device__ __forceinline__ int crow(int r, int hi) { return (r & 3) + 8 * (r >> 2) + 4 * hi; }
__device__ __forceinline__ bf16x8 load8(const bf16_t* p) { return *reinterpret_cast<const bf16x8*>(p); }
__device__ __forceinline__ void mask_tile(f32x16& p0, f32x16& p1, int dq, unsigned W) {
    const float NEG = -__builtin_inff();
#pragma unroll
    for (int r = 0; r < 16; ++r) {
        const int c = (r & 3) + 8 * (r >> 2);
        if ((unsigned)(dq - c) >= W) p0[r] = NEG;
        if ((unsigned)(dq - c - 32) >= W) p1[r] = NEG;
    }
}
template <bool SEL>
__device__ __forceinline__ void partialSM(f32x16& p0, f32x16& p1, float& m_reg, float& mn, float& alpha, unsigned selw) {
    float pmax = p0[0];
#pragma unroll
    for (int r = 1; r < 16; ++r) pmax = fmaxf(pmax, p0[r]);
#pragma unroll
    for (int r = 0; r < 16; ++r) pmax = fmaxf(pmax, p1[r]);
    { auto rr = __builtin_amdgcn_permlane32_swap(__float_as_uint(pmax), __float_as_uint(pmax), false, false);
      pmax = fmaxf(__uint_as_float(rr[0]), __uint_as_float(rr[1])); }
    constexpr float C2 = 1.4426950408889634f * SCALE;
    if (__builtin_expect(__all((pmax - m_reg) * SCALE <= THR), 1)) { mn = m_reg; alpha = 1.f; }
    else { mn = fmaxf(m_reg, pmax); alpha = __builtin_amdgcn_exp2f((m_reg - mn) * C2); m_reg = mn; }
    const float mnL = -mn * C2;
#pragma unroll
    for (int r = 0; r < 16; ++r) p0[r] = fmaf(p0[r], C2, mnL);
#pragma unroll
    for (int r = 0; r < 16; ++r) p1[r] = fmaf(p1[r], C2, mnL);
#pragma unroll
    for (int r = 0; r < 16; ++r) p0[r] = __builtin_amdgcn_exp2f(p0[r]);
    if (SEL) {
#pragma unroll
        for (int r = 0; r < 16; ++r) p0[r] = __uint_as_float(__float_as_uint(p0[r]) & (unsigned)__builtin_amdgcn_sbfe((int)selw, r, 1));
    }
}
template <bool SEL>
__device__ __forceinline__ void finishSM(f32x16& p0, f32x16& p1, float alpha, float& l_reg, bf16x8& pa0, bf16x8& pa1, bf16x8& pa2, bf16x8& pa3, unsigned selw) {
#pragma unroll
    for (int r = 0; r < 16; ++r) p1[r] = __builtin_amdgcn_exp2f(p1[r]);
    if (SEL) {
#pragma unroll
        for (int r = 0; r < 16; ++r) p1[r] = __uint_as_float(__float_as_uint(p1[r]) & (unsigned)__builtin_amdgcn_sbfe((int)selw, 16 + r, 1));
    }
    float ps = 0;
#pragma unroll
    for (int r = 0; r < 16; ++r) ps += p0[r];
#pragma unroll
    for (int r = 0; r < 16; ++r) ps += p1[r];
    { auto rr = __builtin_amdgcn_permlane32_swap(__float_as_uint(ps), __float_as_uint(ps), false, false);
      ps = __uint_as_float(rr[0]) + __uint_as_float(rr[1]); }
    l_reg = l_reg * alpha + ps;
#define PK4(P, B_, OUT) do { unsigned a0 = cvt_pk_bf16(P[B_+0], P[B_+1]), a1 = cvt_pk_bf16(P[B_+2], P[B_+3]);                          \
        unsigned b0 = cvt_pk_bf16(P[B_+4], P[B_+5]), b1 = cvt_pk_bf16(P[B_+6], P[B_+7]);                                             \
        auto r0 = __builtin_amdgcn_permlane32_swap(a0, b0, false, false); auto r1 = __builtin_amdgcn_permlane32_swap(a1, b1, false, false); \
        u32x4 w = {r0[0], r1[0], r0[1], r1[1]}; OUT = *reinterpret_cast<bf16x8*>(&w); } while (0)
    PK4(p0, 0, pa0); PK4(p0, 8, pa1); PK4(p1, 0, pa2); PK4(p1, 8, pa3);
#undef PK4
}
template <int KB, int QREG>
__device__ __forceinline__ void qkt(f32x16& p0, f32x16& p1, const char* K_lds, int r32, int hi, const bf16x8* qr, const char* qlds) {
    p0 = f32x16{}; p1 = f32x16{};
    const char* kb[4];
#pragma unroll
    for (int dd = 0; dd < 4; ++dd) kb[dd] = K_lds + KB * SHM_K + KSWZ(r32, (dd * 16 + hi * 8) * 2);
#pragma unroll
    for (int d0 = 0; d0 < 8; ++d0) { const char* a = kb[d0 & 3] + (d0 >> 2) * 128;
        bf16x8 b0 = *reinterpret_cast<const bf16x8*>(a);
        bf16x8 b1 = *reinterpret_cast<const bf16x8*>(a + 32 * 256);
        const bf16x8 qf = (d0 < QREG) ? qr[d0 < QREG ? d0 : 0] : *reinterpret_cast<const bf16x8*>(qlds + (d0 - QREG) * 1024);
        p0 = __builtin_amdgcn_mfma_f32_32x32x16_bf16(b0, qf, p0, 0, 0, 0);
        p1 = __builtin_amdgcn_mfma_f32_32x32x16_bf16(b1, qf, p1, 0, 0, 0); }
}
template <int VB>
__device__ __forceinline__ void pv_tile(f32x16* o, int vb0, bf16x8 pa0, bf16x8 pa1, bf16x8 pa2, bf16x8 pa3) {
#define TRRD(dst, off) asm volatile("ds_read_b64_tr_b16 %0, %1 offset:%2" : "=&v"(dst) : "v"(vb0), "i"(off) : "memory")
#define PV_D0(d0) do { s16x4 l0, l1, l2, l3, h0, h1, h2, h3; constexpr int b_ = VB * SHM_V + v_rd_off(d0, 0, 0); \
        TRRD(l0, b_); TRRD(h0, b_ + 2048); TRRD(l1, b_ + 4096); TRRD(h1, b_ + 6144); TRRD(l2, b_ + 8192); TRRD(h2, b_ + 10240); TRRD(l3, b_ + 12288); TRRD(h3, b_ + 14336); \
        asm volatile("s_waitcnt lgkmcnt(0)" ::: "memory"); SBAR(); \
        o[d0] = __builtin_amdgcn_mfma_f32_32x32x16_bf16(pa0, (bf16x8){l0[0], l0[1], l0[2], l0[3], h0[0], h0[1], h0[2], h0[3]}, o[d0], 0, 0, 0);   \
        o[d0] = __builtin_amdgcn_mfma_f32_32x32x16_bf16(pa1, (bf16x8){l1[0], l1[1], l1[2], l1[3], h1[0], h1[1], h1[2], h1[3]}, o[d0], 0, 0, 0);   \
        o[d0] = __builtin_amdgcn_mfma_f32_32x32x16_bf16(pa2, (bf16x8){l2[0], l2[1], l2[2], l2[3], h2[0], h2[1], h2[2], h2[3]}, o[d0], 0, 0, 0);   \
        o[d0] = __builtin_amdgcn_mfma_f32_32x32x16_bf16(pa3, (bf16x8){l3[0], l3[1], l3[2], l3[3], h3[0], h3[1], h3[2], h3[3]}, o[d0], 0, 0, 0); } while (0)
    PV_D0(0); PV_D0(1); PV_D0(2); PV_D0(3);
#undef PV_D0
#undef TRRD
}
struct BlockRef { const bf16_t* Q; const bf16_t* K; const bf16_t* V; bf16_t* O; const unsigned* M; int P0; };
struct MergeArgs { unsigned char* ws; const float* cw; };
struct Seam { bf16x8 qr[8]; bf16x8 st_v0, st_v1, st_k0, st_k1; };
__device__ __forceinline__ int swa_jlo(int P0, int W) { const int lowk = P0 - W + 1; return lowk > 0 ? lowk / KVBLK : 0; }
#define ROW(p, k0, rr) ((p) + (size_t)((k0) + (rr)) * KS + sc)
#define VMW() asm volatile("s_waitcnt vmcnt(0)" ::: "memory")
#define VMWN(n) asm volatile("s_waitcnt vmcnt(%0)" :: "i"(n) : "memory")
#define SLOAD_H(Kp, Vp, k0) do { S.st_v0 = load8(ROW(Vp, k0, sr)); S.st_v1 = load8(ROW(Vp, k0, 32 + sr));              \
                         S.st_k0 = load8(ROW(Kp, k0, sr)); S.st_k1 = load8(ROW(Kp, k0, 32 + sr)); } while (0)
#define SWRITE_HK(bf) do { *(bf16x8*)(K_lds + (bf) * SHM_K + kws) = S.st_k0; *(bf16x8*)(K_lds + (bf) * SHM_K + kws + 32 * 256) = S.st_k1; } while (0)
#define SWRITE_HV(bf) do { *(bf16x8*)(V_lds + (bf) * SHM_V + vst0) = S.st_v0; *(bf16x8*)(V_lds + (bf) * SHM_V + vst1) = S.st_v1; } while (0)
#define SWRITE_H(bf) do { SWRITE_HV(bf); SWRITE_HK(bf); } while (0)
template <int QS, int KS>
__device__ __forceinline__ void attn_prime(const BlockRef& cur, int W, char* lds, Seam& S, const int wid) {
    const int lane = lane_id(), tid = wid * 64 + lane, r32 = lane & 31, hi = lane >> 5;
    const int sr = tid >> 4, sc = (tid & 15) * 8, kws = KSWZ(sr, sc * 2); char* K_lds = lds + 2 * SHM_V;
    const int kb0 = swa_jlo(cur.P0, W) * KVBLK;
#pragma unroll
    for (int d0 = 0; d0 < 8; ++d0) S.qr[d0] = load8(cur.Q + (size_t)(wid * QBLK + r32) * QS + d0 * 16 + hi * 8);
    SLOAD_H(cur.K, cur.V, kb0); VMW(); SWRITE_HK(0);
    __syncthreads();
}
template <int QS, int KS, int OS, bool SEL, int QREG, bool MERGE>
__device__ __forceinline__ void attn_block(const BlockRef& cur, const BlockRef& nxt, int skv, int W, char* lds, Seam& S, const MergeArgs& MG, const int wid) {
    const int lane = lane_id(), tid = wid * 64 + lane, r32 = lane & 31, hi = lane >> 5;
    const int j_lo = swa_jlo(cur.P0, W);
    int j_hi = (cur.P0 + QB - 1) / KVBLK + 1; if (j_hi > skv / KVBLK) j_hi = skv / KVBLK;
    const int NT = j_hi - j_lo;
    const int kbn = swa_jlo(nxt.P0, W) * KVBLK;
    const int qlo = cur.P0 + wid * QBLK, qm = qlo + r32 - 4 * hi;
    char* V_lds = lds; char* K_lds = lds + 2 * SHM_V;
    float* ws = (float*)(lds + 2 * SHM_V + 2 * SHM_K) + wid * 64; float* li_l = ws, * al_l = ws + 32;
    float m_reg = -1e30f, l_reg = 0; f32x16 o[4] = {};
    const int sr = tid >> 4, sc = (tid & 15) * 8, vst0 = v_st(sr, sc), vst1 = v_st(32 + sr, sc), kws = KSWZ(sr, sc * 2);
    const int vb0 = (int)(uintptr_t)V_lds + v_rd_base(lane);
    const bf16_t* Kh = cur.K; const bf16_t* Vh = cur.V;
    const unsigned moff = (unsigned)((wid * QBLK + r32) * 128 + hi);
#define RESC(a) do { if (__any((a) < 1.f)) { if (hi == 0) al_l[r32] = (a); asm volatile("s_waitcnt lgkmcnt(0)" ::: "memory");              \
                     for (int d_ = 0; d_ < 4; ++d_) for (int r = 0; r < 16; ++r) o[d_][r] *= al_l[crow(r, hi)]; } } while (0)
#define KBASE(t) ((j_lo + (t)) * KVBLK)
#define MLOAD(t) (SEL ? cur.M[moff + 2u * (unsigned)(j_lo + (t))] : 0u)
#define MASKT(P0_, P1_, t) do { } while (0)
    constexpr int NQL = 8;
#define SEAM_K0() do { VMWN(NQL); SWRITE_HK(0); SBAR(); } while (0)
    f32x16 pA0, pA1, pB0, pB1; float mnA, mnB, alA, alB; bf16x8 pa0, pa1, pa2, pa3; unsigned mwA = 0u, mwB = 0u;
    const char* qlds = lds + LDS_QOFF + wid * 8192 + lane * 16;
    if (QREG < 8) {
#pragma unroll
        for (int d0 = QREG; d0 < 8; ++d0) *(bf16x8*)(lds + LDS_QOFF + wid * 8192 + lane * 16 + (d0 - QREG) * 1024) = S.qr[d0];
    }
    SWRITE_HV(0); SBAR();
    mwA = MLOAD(0);
    if (NT > 1) { SLOAD_H(Kh, Vh, KBASE(1)); }
    SBAR(); qkt<0, QREG>(pA0, pA1, K_lds, r32, hi, S.qr, qlds);
    MASKT(pA0, pA1, 0); partialSM<SEL>(pA0, pA1, m_reg, mnA, alA, mwA);
    if (NT > 1) { VMW(); SWRITE_H(1); }
    __syncthreads();
#define HALF_STEP(PX0, PX1, mnX, alX, mwX, PY0, PY1, alY, mwY, t, KB, VB, SB) do {                                            \
        SBAR(); qkt<KB, QREG>(PX0, PX1, K_lds, r32, hi, S.qr, qlds);                                                                     \
        finishSM<SEL>(PY0, PY1, alY, l_reg, pa0, pa1, pa2, pa3, mwY); SBAR();                                                 \
        mwX = MLOAD(t);                                                                                                       \
        if ((t) + 1 < NT) { SLOAD_H(Kh, Vh, KBASE((t) + 1)); SBAR(); }                                                        \
        pv_tile<VB>(o, vb0, pa0, pa1, pa2, pa3); MASKT(PX0, PX1, (t)); partialSM<SEL>(PX0, PX1, m_reg, mnX, alX, mwX);        \
        __syncthreads();                                                                                                      \
        if ((t) + 1 < NT) { VMW(); SWRITE_H(SB); }                                                                            \
        RESC(alX); __syncthreads(); } while (0)
    for (int t = 1; t + 1 < NT; t += 2) {
        HALF_STEP(pB0, pB1, mnB, alB, mwB, pA0, pA1, alA, mwA, t, 1, 0, 0);
        HALF_STEP(pA0, pA1, mnA, alA, mwA, pB0, pB1, alB, mwB, t + 1, 0, 1, 1);
    }
    const bool even = (NT & 1) == 0;
    if (even) { SBAR(); mwB = MLOAD(NT - 1); qkt<1, QREG>(pB0, pB1, K_lds, r32, hi, S.qr, qlds); SBAR(); }
    SLOAD_H(nxt.K, nxt.V, kbn); SBAR();
#pragma unroll
    for (int d0 = 0; d0 < 8; ++d0) S.qr[d0] = load8(nxt.Q + (size_t)(wid * QBLK + r32) * QS + d0 * 16 + hi * 8);
    SBAR();
    finishSM<SEL>(pA0, pA1, alA, l_reg, pa0, pa1, pa2, pa3, mwA); SBAR();
    pv_tile<0>(o, vb0, pa0, pa1, pa2, pa3);
    if (even) { MASKT(pB0, pB1, NT - 1); partialSM<SEL>(pB0, pB1, m_reg, mnB, alB, mwB); __syncthreads(); RESC(alB);
        finishSM<SEL>(pB0, pB1, alB, l_reg, pa0, pa1, pa2, pa3, mwB); SBAR(); pv_tile<1>(o, vb0, pa0, pa1, pa2, pa3); }
    SBAR(); SEAM_K0();
    if (hi == 0) li_l[r32] = l_reg; asm volatile("s_waitcnt lgkmcnt(0)" ::: "memory");
    float rli[16];
#pragma unroll
    for (int r = 0; r < 16; ++r) rli[r] = __builtin_amdgcn_rcpf(li_l[crow(r, hi)]);
    {
        char* stg = lds + LDS_QOFF + wid * 8192;
#pragma unroll
        for (int r = 0; r < 16; ++r) { const int orow = crow(r, hi);
#pragma unroll
            for (int d0 = 0; d0 < 4; ++d0) { const float v = o[d0][r] * rli[r];
                const float vn = __shfl_xor(v, 1);
                if ((r32 & 1) == 0) *(unsigned*)(stg + orow * 256 + (d0 * 32 + r32) * 2) = cvt_pk_bf16(v, vn); } }
        asm volatile("s_waitcnt lgkmcnt(0)" ::: "memory");
        const int ch = lane & 15, rq = lane >> 4;
        if (!MERGE) {
            bf16_t* Ow = cur.O + (size_t)(wid * QBLK) * OS + ch * 8;
#pragma unroll
            for (int p = 0; p < 8; ++p) { const int row = 4 * p + rq; *(u32x4*)(Ow + (size_t)row * OS) = *(const u32x4*)(stg + row * 256 + ch * 16); }
        } else {
            const bf16_t* Obase = (const bf16_t*)(MG.ws + WS_YATT); const bf16_t* MA = (const bf16_t*)(MG.ws + WS_ABUF); const bf16_t* MP = (const bf16_t*)(MG.ws + WS_PBUF);
            const bf16_t* MGA = (const bf16_t*)(MG.ws + WS_GABUF); bf16_t* MOUT = (bf16_t*)(MG.ws + WS_MERGED);
            const size_t eoff = (size_t)(cur.O - Obase) + (size_t)(wid * QBLK) * OS + ch * 8;
            const int colg = (int)((cur.O - Obase) % OS) + ch * 8;
            float w0[8], w1[8], w2[8];
#pragma unroll
            for (int j = 0; j < 8; ++j) { w0[j] = MG.cw[colg + j]; w1[j] = MG.cw[OS + colg + j]; w2[j] = MG.cw[2 * OS + colg + j]; }
            u32x4 ca, cga, cp2, cp1, cp0, na, nga, np2, np1, np0;
#define MG_LOAD(p_, A_, GA_, P2_, P1_, P0_) do { const int row_ = 4 * (p_) + rq, spos_ = cur.P0 + wid * QBLK + row_; const size_t e_ = eoff + (size_t)row_ * OS; \
                A_ = *(const u32x4*)(MA + e_); GA_ = *(const u32x4*)(MGA + e_); P2_ = *(const u32x4*)(MP + e_); \
                P1_ = (u32x4){0u, 0u, 0u, 0u}; P0_ = (u32x4){0u, 0u, 0u, 0u}; \
                if (spos_ >= 1) P1_ = *(const u32x4*)(MP + e_ - OS); if (spos_ >= 2) P0_ = *(const u32x4*)(MP + e_ - 2 * OS); } while (0)
            MG_LOAD(0, ca, cga, cp2, cp1, cp0);
#pragma unroll 1
            for (int p = 0; p < 8; ++p) {
                const int row = 4 * p + rq;
                const size_t e = eoff + (size_t)row * OS;
                const u32x4 y = *(const u32x4*)(stg + row * 256 + ch * 16);
                if (p < 7) MG_LOAD(p + 1, na, nga, np2, np1, np0);
                float ov[8];
#pragma unroll
                for (int j = 0; j < 4; ++j) {
                    ov[2 * j] = bf_lo(ca[j]) * (w0[2 * j] * bf_lo(cp0[j]) + w1[2 * j] * bf_lo(cp1[j]) + w2[2 * j] * bf_lo(cp2[j])) + bf_lo(cga[j]) * bf_lo(y[j]);
                    ov[2 * j + 1] = bf_hi(ca[j]) * (w0[2 * j + 1] * bf_hi(cp0[j]) + w1[2 * j + 1] * bf_hi(cp1[j]) + w2[2 * j + 1] * bf_hi(cp2[j])) + bf_hi(cga[j]) * bf_hi(y[j]);
                }
                u32x4 wv_; wv_.x = cvt_pk_bf16(ov[0], ov[1]); wv_.y = cvt_pk_bf16(ov[2], ov[3]); wv_.z = cvt_pk_bf16(ov[4], ov[5]); wv_.w = cvt_pk_bf16(ov[6], ov[7]);
                *(u32x4*)(MOUT + e) = wv_;
                ca = na; cga = nga; cp2 = np2; cp1 = np1; cp0 = np0;
            }
#undef MG_LOAD
        }
    }
    __syncthreads();
#undef RESC
#undef KBASE
#undef MLOAD
#undef MASKT
#undef SEAM_K0
#undef HALF_STEP
}
#undef ROW
#undef VMW
#undef VMWN
#undef SLOAD_H
#undef SWRITE_HK
#undef SWRITE_HV
#undef SWRITE_H

enum { ORDER_NATURAL = 0, ORDER_PAIRED = 2, ORDER_XCD = 4, ORDER_LPT = 8 };
struct AttnItem { int bh, qb0, qb1; };
__device__ __forceinline__ AttnItem attn_decode(int L, int nb, int nh, int nhkv, int nqb, int nx, int order) {
    const int G = nh / nhkv; AttnItem it; int x;
    if ((order & ORDER_XCD) && (nb * nhkv) % 8 == 0) { const int xcd = L & 7, k = L >> 3, per = G * nx, gi = k / per, r = k - gi * per;
        it.bh = (gi * 8 + xcd) * G + r / nx; x = r % nx; }
    else { it.bh = L / nx; x = L - it.bh * nx; }
    if (order & ORDER_PAIRED) { it.qb0 = x; it.qb1 = nqb - 1 - x; }
    else { it.qb0 = it.qb1 = x; }
    return it;
}
struct AttnTensors { const bf16_t* Q; const bf16_t* K; const bf16_t* V; bf16_t* O; const unsigned* M; };
template <int QS, int KS, int OS>
__device__ __forceinline__ BlockRef attn_ref(const AttnItem& it, int pass, const AttnTensors& X, int nh, int nhkv, int sq, int skv, int p0base) {
    const int qb = pass ? it.qb1 : it.qb0, b = it.bh / nh, h = it.bh - b * nh, kvh = h / (nh / nhkv);
    BlockRef r; const size_t t0 = (size_t)b * sq + (size_t)qb * QB;
    r.Q = X.Q + t0 * QS + h * D; r.O = X.O + t0 * OS + h * D;
    r.K = X.K + (size_t)b * skv * KS + kvh * D; r.V = X.V + (size_t)b * skv * KS + kvh * D;
    r.M = X.M ? X.M + t0 * 128 : nullptr; r.P0 = p0base + qb * QB;
    return r;
}
__device__ __forceinline__ int attn_kmax(int stride, int order, int nb, int nh, int nhkv, int nqb, int nx) {
    if (order & ORDER_LPT) { const int G = nh / nhkv, rg = (G * nqb + stride - 1) / stride; return rg * (nb * nhkv / 8); }
    return (nx * nb * nh + stride - 1) / stride;
}
__device__ __forceinline__ bool attn_item_at(int k, int first, int stride, int order, int nb, int nh, int nhkv, int nqb, int nx, AttnItem& it) {
    if (order & ORDER_LPT) {
        const int x = first & 7, slot = first >> 3, G = nh / nhkv, nblk = G * nqb, rg = (nblk + stride - 1) / stride;
        const int gi = k / rg, kk = k - gi * rg, sl = (gi & 1) ? stride - 1 - slot : slot;
        const int pos = (kk & 1) ? stride - 1 - sl : sl, s = kk * stride + pos;
        if (s >= nblk) return false;
        it.bh = (gi * 8 + x) * G + (s % G); it.qb0 = it.qb1 = nqb - 1 - s / G; return true;
    }
    const int L = first + k * stride; if (L >= nx * nb * nh) return false;
    it = attn_decode(L, nb, nh, nhkv, nqb, nx, order); return true;
}
template <int QS, int KS, int OS, bool SEL, int QREG, bool MERGE>
__device__ __forceinline__ void attn_phase(char* lds, const AttnTensors& X, const MergeArgs& MG, int nb, int nh, int nhkv, int sq, int skv, int p0base, int order, int stride, int first, const int wid) {
    const int W = 1 << 30;
    const int nqb = sq / QB, nx = (order & ORDER_PAIRED) ? nqb / 2 : nqb;
    AttnItem it; int k = 0, pass = 0; const int kmax = attn_kmax(stride, order, nb, nh, nhkv, nqb, nx);
    while (k < kmax && !attn_item_at(k, first, stride, order, nb, nh, nhkv, nqb, nx, it)) ++k;
    if (k >= kmax) return;
    BlockRef cur = attn_ref<QS, KS, OS>(it, 0, X, nh, nhkv, sq, skv, p0base);
    Seam S;
    attn_prime<QS, KS>(cur, W, lds, S, wid);
    for (;;) {
        const bool more_pass = pass == 0 && it.qb1 != it.qb0;
        AttnItem itn = it; int passn = pass + 1, kn = k; bool last = false;
        if (!more_pass) { passn = 0; kn = k + 1; while (kn < kmax && !attn_item_at(kn, first, stride, order, nb, nh, nhkv, nqb, nx, itn)) ++kn; if (kn >= kmax) { last = true; itn = it; kn = k; } }
        const BlockRef nxt = last ? cur : attn_ref<QS, KS, OS>(itn, passn, X, nh, nhkv, sq, skv, p0base);
        attn_block<QS, KS, OS, SEL, QREG, MERGE>(cur, nxt, skv, W, lds, S, MG, wid);
        if (last) break;
        cur = nxt; it = itn; pass = passn; k = kn;
    }
    asm volatile("s_waitcnt vmcnt(0)" ::: "memory");
    __syncthreads();
}
}


namespace ix {
constexpr int KCH = 256;
constexpr int BUFB = KCH * 128;
template <int CTRL> __device__ __forceinline__ int dpp_mov(int v) { return __builtin_amdgcn_update_dpp(0, v, CTRL, 0xF, 0xF, true); }
__device__ __forceinline__ int half_sum(int v) {
    v += dpp_mov<0xB1>(v); v += dpp_mov<0x4E>(v); v += dpp_mov<0x141>(v); v += dpp_mov<0x140>(v);
    return v + __shfl_xor(v, 16);
}
__device__ __forceinline__ float half_min(float v) {
    v = fminf(v, __int_as_float(dpp_mov<0xB1>(__float_as_int(v)))); v = fminf(v, __int_as_float(dpp_mov<0x4E>(__float_as_int(v))));
    v = fminf(v, __int_as_float(dpp_mov<0x141>(__float_as_int(v)))); v = fminf(v, __int_as_float(dpp_mov<0x140>(__float_as_int(v))));
    return fminf(v, __shfl_xor(v, 16));
}
__device__ __forceinline__ float half_max(float v) {
    v = fmaxf(v, __int_as_float(dpp_mov<0xB1>(__float_as_int(v)))); v = fmaxf(v, __int_as_float(dpp_mov<0x4E>(__float_as_int(v))));
    v = fmaxf(v, __int_as_float(dpp_mov<0x141>(__float_as_int(v)))); v = fmaxf(v, __int_as_float(dpp_mov<0x140>(__float_as_int(v))));
    return fmaxf(v, __shfl_xor(v, 16));
}
__device__ __forceinline__ int excl_scan64(int v, int lane, int& total) {
    int s = v;
#pragma unroll
    for (int o = 1; o <= 32; o <<= 1) { const int t = __shfl_up(s, o); s += (lane >= o) ? t : 0; }
    total = __shfl(s, 63);
    return s - v;
}
__device__ __forceinline__ void tie_fix(unsigned& ge0, unsigned& ge1, unsigned gt0, unsigned gt1, int need, int lane) {
    unsigned eq0 = ge0 & ~gt0, eq1 = ge1 & ~gt1;
    const int c0 = __popc(eq0), c1 = __popc(eq1);
    int tot0, tot1; const int pre0 = excl_scan64(c0, lane, tot0); const int pre1 = tot0 + excl_scan64(c1, lane, tot1);
    int t0 = need - pre0; t0 = t0 < 0 ? 0 : (t0 > c0 ? c0 : t0);
    int t1 = need - pre1; t1 = t1 < 0 ? 0 : (t1 > c1 ? c1 : t1);
    while (__popc(eq0) > t0) eq0 &= ~(0x80000000u >> __clz(eq0));
    while (__popc(eq1) > t1) eq1 &= ~(0x80000000u >> __clz(eq1));
    ge0 = gt0 | eq0; ge1 = gt1 | eq1;
}
__device__ __forceinline__ unsigned nib16(unsigned w, int hi) {
    unsigned x = (w >> (4 * hi)) & 0x0F0F0F0Fu; x = (x | (x >> 4)) & 0x00FF00FFu; x = (x | (x >> 8)) & 0xFFFFu; return x;
}
__device__ __forceinline__ void store_row(unsigned* row, unsigned g0, unsigned g1, int lane) {
    const int hi = lane & 1, e = lane & ~1;
    const unsigned a0 = __shfl(g0, e), b0 = __shfl(g0, e + 1), a1 = __shfl(g1, e), b1 = __shfl(g1, e + 1);
    row[lane] = nib16(a0, hi) | (nib16(b0, hi) << 16);
    row[64 + lane] = nib16(a1, hi) | (nib16(b1, hi) << 16);
}
constexpr int LDS_SIDE = 65536;
__device__ __forceinline__ void indexer_phase(const Frame& F, const bf16_t* QI, const bf16_t* KI, const float* WI, unsigned* MASK, const pg8::SideConv& SD) {
    const int tid = F.tid_(), lane = F.lane_(), w = F.wave, r = lane & 31, hi = lane >> 5;
    LAS unsigned char* lds = F.lds;
    const float NEG = -__builtin_inff();
    int sq = 0, spar = 0; bool pend0 = false, pend1 = false; size_t pd0 = 0, pd1 = 0;
    for (int rnd = 0; rnd < 4; ++rnd) {
        const int p = (rnd & 1) ? (F.G - 1 - F.bid) : F.bid; const int sidx = rnd * F.G + p;
        if (sidx >= NB * (SEQ / 16)) continue;
        const int qg = (SEQ / 16 - 1) - (sidx >> 2), b = sidx & 3;
        const int q0 = qg * 16, nkeys = q0 + 16, nkt = (nkeys + 31) >> 5, nch = (nkeys + KCH - 1) / KCH;
        const size_t tb = (size_t)b * SEQ;
        const int tq = q0 + 2 * w + hi;
        bf16x8 afr[4];
        { const int qsel = (r >> 2) & 1, head = (r & 3) + 4 * (r >> 3);
          const bf16_t* qp = QI + (tb + q0 + 2 * w + qsel) * 1024 + head * 64 + 8 * hi;
#pragma unroll
          for (int s = 0; s < 4; ++s) afr[s] = *(const bf16x8*)(qp + 16 * s); }
        f32x4 wv[4];
#pragma unroll
        for (int i = 0; i < 4; ++i) wv[i] = *(const f32x4*)(WI + (tb + tq) * 16 + 4 * i);
        float sc[128];
#pragma unroll
        for (int i = 0; i < 128; ++i) sc[i] = NEG;
        const int skey = 8 * w + (lane >> 3), ssl = lane & 7;
        const bf16_t* ksrc = KI + (tb + skey) * 64 + ((ssl ^ ((skey >> 1) & 7)) * 8);
#define IX_STAGE(chunk, buf) do { _Pragma("unroll") for (int i = 0; i < 4; ++i) \
            __builtin_amdgcn_global_load_lds((const unsigned*)(ksrc + ((size_t)(chunk) * KCH + 64 * i) * 64), (LAS unsigned*)(lds + (buf) * BUFB + (64 * i + 8 * w) * 128), 16, 0, 0); } while (0)
        for (int rep22 = 0; rep22 < (REP_PHASE == 22 ? 2 : 1); ++rep22) {
        IX_STAGE(0, 0);
        asm volatile("s_waitcnt vmcnt(0)" ::: "memory");
        __syncthreads();
        int boff[4];
#pragma unroll
        for (int s = 0; s < 4; ++s) boff[s] = r * 128 + (((2 * s + hi) ^ ((r >> 1) & 7)) * 16);
        for (int c = 0; c < nch; ++c) {
            const bool more = (c + 1 < nch);
            if (more) IX_STAGE(c + 1, (c + 1) & 1);
            {   LAS unsigned char* told = lds + LDS_SIDE + (spar ^ 1) * 2 * 16640; LAS unsigned char* tnew = lds + LDS_SIDE + spar * 2 * 16640;
                if (pend0) SD.consume(told, pd0, w, lane);
                if (pend1) SD.consume(told + 16640, pd1, w, lane);
                const int ja = SD.j0 + sq * SD.G + SD.c, jb = ja + SD.G;
                pend0 = ja < SD.jn; pend1 = jb < SD.jn;
                if (pend0) { pd0 = SD.issue(ja, tnew, w, lane); ++sq; }
                if (pend1) { pd1 = SD.issue(jb, tnew + 16640, w, lane); ++sq; }
                spar ^= 1; }
            LAS unsigned char* kb = lds + (c & 1) * BUFB;
#pragma unroll
            for (int g = 0; g < 2; ++g) {
                float s4[4];
#pragma unroll
                for (int k4 = 0; k4 < 4; ++k4) {
                    const int k = g * 4 + k4, kt = c * 8 + k;
                    s4[k4] = NEG;
                    if (kt < nkt) {
                        f32x16 acc = {};
#pragma unroll
                        for (int s = 0; s < 4; ++s) { const bf16x8 bfr = *(const LAS bf16x8*)(kb + k * 4096 + boff[s]);
                            acc = __builtin_amdgcn_mfma_f32_32x32x16_bf16(afr[s], bfr, acc, 0, 0, 0); }
                        float s0 = 0.f;
#pragma unroll
                        for (int h = 0; h < 16; ++h) s0 = fmaf(wv[h >> 2][h & 3], fmaxf(acc[h], 0.f), s0);
                        s4[k4] = (kt * 32 + r <= tq) ? s0 : NEG;
                    }
                }
#define IX_INS(cc) case cc: _Pragma("unroll") for (int k = 0; k < 4; ++k) sc[(cc) * 4 + k] = s4[k]; break;
                switch (c * 2 + g) { IX_INS(0) IX_INS(1) IX_INS(2) IX_INS(3) IX_INS(4) IX_INS(5) IX_INS(6) IX_INS(7) IX_INS(8) IX_INS(9) IX_INS(10) IX_INS(11) IX_INS(12) IX_INS(13) IX_INS(14) IX_INS(15)
                                     IX_INS(16) IX_INS(17) IX_INS(18) IX_INS(19) IX_INS(20) IX_INS(21) IX_INS(22) IX_INS(23) IX_INS(24) IX_INS(25) IX_INS(26) IX_INS(27) IX_INS(28) IX_INS(29) IX_INS(30) IX_INS(31) default: break; }
#undef IX_INS
            }
            asm volatile("s_waitcnt vmcnt(0)" ::: "memory");
            __syncthreads();
        }
        }
#undef IX_STAGE
        float tau = -3.0e38f; int tiemode = 0, need = 0;
        for (int rep20 = 0; rep20 < (REP_PHASE == 20 ? 2 : 1); ++rep20) {
            tiemode = 0; need = 0;
            float lo = 0.f, hiv = 0.f; int done = (tq + 1 <= TOPK) ? 1 : 0;
            if (!done) {
                float mn = __builtin_inff(), mx = NEG;
#pragma unroll
                for (int c = 0; c < 16; ++c) if (c < nch) {
#pragma unroll
                    for (int k = 0; k < 8; ++k) { const float v = sc[c * 8 + k]; mx = fmaxf(mx, v); mn = fminf(mn, (v == NEG) ? __builtin_inff() : v); } }
                lo = half_min(mn); mx = half_max(mx);
                hiv = mx + fabsf(mx) * 1e-6f + 1e-30f;
            }
            for (int it = 0; it < 64 && __any(!done); ++it) {
                const unsigned ul = __float_as_uint(lo), uh = __float_as_uint(hiv);
                const unsigned kl = (ul & 0x80000000u) ? ~ul : (ul | 0x80000000u), kh = (uh & 0x80000000u) ? ~uh : (uh | 0x80000000u);
                const bool adj = (kh - kl) <= 1u;
                const unsigned km = kl + ((kh - kl) >> 1);
                const float kmid = __uint_as_float((km & 0x80000000u) ? (km ^ 0x80000000u) : ~km);
                const float fmid = 0.5f * (lo + hiv);
                const float mid = (it < 24 && fmid > lo && fmid < hiv) ? fmid : kmid;
                const float piv = adj ? hiv : mid;
                int cnt = 0;
#pragma unroll
                for (int c = 0; c < 16; ++c) if (c < nch) {
#pragma unroll
                    for (int k = 0; k < 8; ++k) cnt += (sc[c * 8 + k] >= piv) ? 1 : 0; }
                cnt = half_sum(cnt);
                if (!done) {
                    if (adj) { tau = lo; tiemode = 1; need = TOPK - cnt; done = 1; }
                    else if (cnt == TOPK) { tau = mid; done = 1; }
                    else if (cnt > TOPK) lo = mid; else hiv = mid;
                }
            }
        }
        unsigned wA0 = 0u, wA1 = 0u, wB0 = 0u, wB1 = 0u;
#define IX_BAL(RA, RB, KT, LN, OP) { const unsigned long long bl_ = __ballot(sc[KT] OP tau); \
            asm volatile("s_nop 1\n\tv_writelane_b32 %0, %2, %4\n\tv_writelane_b32 %1, %3, %4" : "+v"(RA), "+v"(RB) : "s"((unsigned)bl_), "s"((unsigned)(bl_ >> 32)), "n"(LN)); }
#define IX_REP8(M, RA, RB, b, o, OP) M(RA, RB, (b) + 0, (b) - (o) + 0, OP) M(RA, RB, (b) + 1, (b) - (o) + 1, OP) M(RA, RB, (b) + 2, (b) - (o) + 2, OP) M(RA, RB, (b) + 3, (b) - (o) + 3, OP) \
                                     M(RA, RB, (b) + 4, (b) - (o) + 4, OP) M(RA, RB, (b) + 5, (b) - (o) + 5, OP) M(RA, RB, (b) + 6, (b) - (o) + 6, OP) M(RA, RB, (b) + 7, (b) - (o) + 7, OP)
#define IX_REP64(M, RA, RB, b, OP) IX_REP8(M, RA, RB, (b) + 0, b, OP) IX_REP8(M, RA, RB, (b) + 8, b, OP) IX_REP8(M, RA, RB, (b) + 16, b, OP) IX_REP8(M, RA, RB, (b) + 24, b, OP) \
                                   IX_REP8(M, RA, RB, (b) + 32, b, OP) IX_REP8(M, RA, RB, (b) + 40, b, OP) IX_REP8(M, RA, RB, (b) + 48, b, OP) IX_REP8(M, RA, RB, (b) + 56, b, OP)
        IX_REP64(IX_BAL, wA0, wB0, 0, >=)
        IX_REP64(IX_BAL, wA1, wB1, 64, >=)
        if (__any(tiemode)) {
            unsigned gA0 = 0u, gA1 = 0u, gB0 = 0u, gB1 = 0u;
            IX_REP64(IX_BAL, gA0, gB0, 0, >)
            IX_REP64(IX_BAL, gA1, gB1, 64, >)
            const int tieA = __builtin_amdgcn_readlane(tiemode, 0), tieB = __builtin_amdgcn_readlane(tiemode, 32);
            const int needA = __builtin_amdgcn_readlane(need, 0), needB = __builtin_amdgcn_readlane(need, 32);
            if (tieA) tie_fix(wA0, wA1, gA0, gA1, needA, lane);
            if (tieB) tie_fix(wB0, wB1, gB0, gB1, needB, lane);
        }
        unsigned* ra = MASK + (tb + q0 + 2 * w) * 128;
        store_row(ra, wA0, wA1, lane);
        store_row(ra + 128, wB0, wB1, lane);
#undef IX_BAL
#undef IX_REP8
#undef IX_REP64
        __syncthreads();
    }
    {   LAS unsigned char* told = lds + LDS_SIDE + (spar ^ 1) * 2 * 16640;
        if (pend0) SD.consume(told, pd0, w, lane);
        if (pend1) SD.consume(told + 16640, pd1, w, lane); }
    SD.leftover(sq, w, lane);
}
}


#ifdef PROBE_MASK
__device__ __forceinline__ void probe_mask_check(const Frame& F) {
    const unsigned* MASK = F.W<unsigned>(WS_MASK); unsigned* flag = F.W<unsigned>(WS_CTL + CTL_CNT + 1024);
    for (int t = F.bid * 8 + F.wave; t < T; t += F.G * 8) {
        const int s = t & (SEQ - 1);
        int cnt = 0, bad = 0;
#pragma unroll
        for (int i = 0; i < 2; ++i) {
            const int o = i * 64 + F.lane_(); const unsigned w = MASK[(size_t)t * 128 + o];
            cnt += __popc(w);
            const int tile = o >> 1, hi = o & 1;
#pragma unroll
            for (int b = 0; b < 32; ++b) if ((w >> b) & 1u) { const int r = b & 15; const int key = tile * 64 + (b >> 4) * 32 + (r & 3) + 8 * (r >> 2) + 4 * hi; if (key > s) bad = 1; }
        }
        cnt = (int)wave_sum((float)cnt);
        const int want = (s + 1 < TOPK) ? s + 1 : TOPK;
        if (cnt != want) bad = 1;
        if (__any(bad) && F.lane_() == 0) atomicAdd(flag, 1u);
    }
}
#endif
__device__ __forceinline__ void p4_merge(const Frame& F) {
    const bf16_t* A = F.W<bf16_t>(WS_ABUF); const bf16_t* P = F.W<bf16_t>(WS_PBUF); const bf16_t* GA = F.W<bf16_t>(WS_GABUF); const bf16_t* Y = F.W<bf16_t>(WS_YATT);
    bf16_t* M = F.W<bf16_t>(WS_MERGED); const float* cw = F.I<float>(IN_CONV_W);
    for (int r = F.bid * 2 + (F.tid_() >> 8); r < T; r += F.G * 2) {
        const int c = (F.tid_() & 255) * 8, s = r & (SEQ - 1);
        const u32x4 a = *(const u32x4*)(A + (size_t)r * DM + c), p2 = *(const u32x4*)(P + (size_t)r * DM + c);
        u32x4 p1 = (u32x4){0u, 0u, 0u, 0u}, p0 = (u32x4){0u, 0u, 0u, 0u};
        if (s >= 1) p1 = *(const u32x4*)(P + (size_t)(r - 1) * DM + c);
        if (s >= 2) p0 = *(const u32x4*)(P + (size_t)(r - 2) * DM + c);
#if MILESTONE >= 4
        const u32x4 ga = *(const u32x4*)(GA + (size_t)r * DM + c), y = *(const u32x4*)(Y + (size_t)r * DM + c);
#else
        const u32x4 ga = (u32x4){0u, 0u, 0u, 0u}, y = (u32x4){0u, 0u, 0u, 0u}; (void)GA; (void)Y;
#endif
        float o[8];
#pragma unroll
        for (int j = 0; j < 4; ++j) {
            const float w0l = cw[c + 2 * j], w1l = cw[DM + c + 2 * j], w2l = cw[2 * DM + c + 2 * j];
            const float w0h = cw[c + 2 * j + 1], w1h = cw[DM + c + 2 * j + 1], w2h = cw[2 * DM + c + 2 * j + 1];
            o[2 * j] = bf_lo(a[j]) * (w0l * bf_lo(p0[j]) + w1l * bf_lo(p1[j]) + w2l * bf_lo(p2[j])) + bf_lo(ga[j]) * bf_lo(y[j]);
            o[2 * j + 1] = bf_hi(a[j]) * (w0h * bf_hi(p0[j]) + w1h * bf_hi(p1[j]) + w2h * bf_hi(p2[j])) + bf_hi(ga[j]) * bf_hi(y[j]);
        }
        u32x4 w; w.x = cvt_pk_bf16(o[0], o[1]); w.y = cvt_pk_bf16(o[2], o[3]); w.z = cvt_pk_bf16(o[4], o[5]); w.w = cvt_pk_bf16(o[6], o[7]);
        *(u32x4*)(M + (size_t)r * DM + c) = w;
    }
}


__device__ __forceinline__ void p9_route(const Frame& F, const bf16_t* h) {
    const float* wrt = F.W<float>(WS_WRT); const float* br = F.I<float>(IN_B_ROUTER);
    unsigned* cnt = F.W<unsigned>(WS_CTL + CTL_CNT);
    int* slot_e = F.W<int>(WS_SLOTE); int* slot_r = F.W<int>(WS_SLOTR); float* slot_g = F.W<float>(WS_SLOTG); float* rs2o = F.W<float>(WS_RS2);
    LAS float* part = (LAS float*)F.lds;
    LAS float* ssp = (LAS float*)(F.lds + 16384);
    const int lane = F.lane_(), w = F.wave, tg = w & 3, kh = w >> 2, tok = lane & 15, kq = lane >> 4;
    for (int u = F.bid; u < T / 64; u += F.G) {
        const int t0 = u * 64 + tg * 16;
        const bf16_t* hp = h + (size_t)(t0 + tok) * DM + kh * 1024 + 4 * kq;
        const float* w0 = wrt + (size_t)tok * DM + kh * 1024 + 4 * kq;
        const float* w1 = w0 + (size_t)16 * DM;
        f32x4 acc0 = (f32x4){0.f, 0.f, 0.f, 0.f}, acc1 = (f32x4){0.f, 0.f, 0.f, 0.f}; float ss = 0.f;
#pragma unroll 4
        for (int s = 0; s < 64; ++s) {
            const u32x2 ab = *(const u32x2*)(hp + 16 * s); const f32x4 a = (f32x4){bf_lo(ab.x), bf_hi(ab.x), bf_lo(ab.y), bf_hi(ab.y)};
            const f32x4 b0 = *(const f32x4*)(w0 + 16 * s), b1 = *(const f32x4*)(w1 + 16 * s);
            ss += a[0] * a[0] + a[1] * a[1] + a[2] * a[2] + a[3] * a[3];
#pragma unroll
            for (int j = 0; j < 4; ++j) { acc0 = __builtin_amdgcn_mfma_f32_16x16x4f32(a[j], b0[j], acc0, 0, 0, 0); acc1 = __builtin_amdgcn_mfma_f32_16x16x4f32(a[j], b1[j], acc1, 0, 0, 0); }
        }
        ss += __shfl_xor(ss, 16); ss += __shfl_xor(ss, 32);
        if (kq == 0) ssp[kh * 64 + tg * 16 + tok] = ss;
#pragma unroll
        for (int i = 0; i < 4; ++i) { part[(kh * 64 + tg * 16 + 4 * kq + i) * 32 + tok] = acc0[i]; part[(kh * 64 + tg * 16 + 4 * kq + i) * 32 + 16 + tok] = acc1[i]; }
        __syncthreads();
        if (F.tid_() < 64) {
            const int t = u * 64 + F.tid_();
            const float rs = __builtin_amdgcn_rsqf((ssp[F.tid_()] + ssp[64 + F.tid_()]) * (1.0f / DM) + NORM_EPS);
            float lg[32];
#pragma unroll
            for (int e = 0; e < 32; ++e) lg[e] = (part[F.tid_() * 32 + e] + part[(64 + F.tid_()) * 32 + e]) * rs + br[e];
            unsigned chosen = 0u; float tv[4]; int ti[4];
#pragma unroll
            for (int p = 0; p < 4; ++p) {
                float best = -__builtin_inff(); int bi = 0;
#pragma unroll
                for (int e = 0; e < 32; ++e) { const bool ok = !((chosen >> e) & 1u) && (lg[e] > best); best = ok ? lg[e] : best; bi = ok ? e : bi; }
                chosen |= 1u << bi; tv[p] = best; ti[p] = bi;
            }
            const float e1 = __expf(tv[1] - tv[0]), e2 = __expf(tv[2] - tv[0]), e3 = __expf(tv[3] - tv[0]);
            const float inv = 1.0f / (1.0f + e1 + e2 + e3);
            const float gt[4] = {inv, e1 * inv, e2 * inv, e3 * inv};
            rs2o[t] = rs;
#pragma unroll
            for (int p = 0; p < 4; ++p) {
                const unsigned rk = atomicAdd(cnt + ti[p], 1u);
                slot_e[t * 4 + p] = ti[p]; slot_r[t * 4 + p] = (int)rk; slot_g[t * 4 + p] = gt[p];
            }
        }
        __syncthreads();
    }
}

__device__ __forceinline__ void p10_gather(const Frame& F, const bf16_t* hb) {
    LAS int* off = (LAS int*)F.lds;
    const unsigned* cnt = F.W<unsigned>(WS_CTL + CTL_CNT);
    int* tile_e = F.W<int>(WS_TILEE);
    if (F.tid_() == 0) { int o = 0; for (int e = 0; e < NEXP; ++e) { off[e] = o; o += ((int)cnt[e] + 255) & ~255; } off[NEXP] = o; }
    __syncthreads();
    if (F.bid == 0) {
        const int nmt = off[NEXP] >> 8;
        for (int m = F.tid_(); m < nmt; m += 512) { int e = 0; for (int q = 1; q < NEXP; ++q) e = (off[q] <= m * 256) ? q : e; tile_e[m] = e; }
        if (F.tid_() == 0) tile_e[511] = nmt;
    }
    const int* slot_e = F.W<int>(WS_SLOTE); const int* slot_r = F.W<int>(WS_SLOTR); const float* slot_g = F.W<float>(WS_SLOTG); const float* rs2 = F.W<float>(WS_RS2);
    int* pos = F.W<int>(WS_POS); float* rss = F.W<float>(WS_RSS); float* gws = F.W<float>(WS_GWS); unsigned char* as = F.W<unsigned char>(WS_ASORT); const float* gffn = F.I<float>(IN_NORM_FFN);
    for (int t = F.bid * 8 + F.wave; t < T; t += F.G * 8) {
        u32x2 v[4];
#pragma unroll
        for (int i = 0; i < 4; ++i) { const int c = (i * 64 + F.lane_()) * 8;
            const u32x4 hv = *(const u32x4*)(hb + (size_t)t * DM + c); const f32x4 g0 = *(const f32x4*)(gffn + c), g1 = *(const f32x4*)(gffn + c + 4);
            v[i] = pack_fp8x8(bf_lo(hv.x) * g0[0], bf_hi(hv.x) * g0[1], bf_lo(hv.y) * g0[2], bf_hi(hv.y) * g0[3], bf_lo(hv.z) * g1[0], bf_hi(hv.z) * g1[1], bf_lo(hv.w) * g1[2], bf_hi(hv.w) * g1[3]); }
        const float rs = rs2[t];
        const u32x4 se = *(const u32x4*)(slot_e + t * 4), sr = *(const u32x4*)(slot_r + t * 4); const f32x4 sg = *(const f32x4*)(slot_g + t * 4);
        int pp[4];
#pragma unroll
        for (int k = 0; k < 4; ++k) pp[k] = off[se[k]] + (int)sr[k];
#pragma unroll
        for (int k = 0; k < 4; ++k) {
            const int p = pp[k];
#pragma unroll
            for (int i = 0; i < 4; ++i) *(u32x2*)(as + (size_t)p * DM + (i * 64 + F.lane_()) * 8) = v[i];
            if (F.lane_() == 0) { rss[p] = rs; gws[p] = sg[k]; }
        }
        if (F.lane_() == 0) *(u32x4*)(pos + t * 4) = (u32x4){(unsigned)pp[0], (unsigned)pp[1], (unsigned)pp[2], (unsigned)pp[3]};
    }
}

struct SchedMoE { int G, c, nM, nN; const char* A; const char* Bt; const LAS int* tile_e; size_t tstep, estep;
    __device__ __forceinline__ bool next(int i, Unit& u) const {
        const int L = i * G + c; if (L >= nM * nN) return false;
        int pm, pn; pg8::tile_of(L, nM, nN, pm, pn); const int e = tile_e[pm];
        u.pm = pm; u.pn = pn; u.a = A + (size_t)pm * tstep; u.b = Bt + (size_t)e * estep + (size_t)pn * tstep; u.kind = 0; u.aux = e; return true; }
};
struct EpiSwiglu { const float* rss; const float* bgu; unsigned char* hdn;
    struct Pre { };
    __device__ __forceinline__ Pre pre(const Unit&, int, int, int, int) const { return Pre{}; }
    __device__ __forceinline__ void operator()(const f32x4 (&acc)[2][2][4][2], const Unit& u, int wr, int wc, int fr, int fq, const Pre&) const {
        const int cw = 128 * u.pn + 32 * wc + 8 * fq; const float* bg = bgu + (size_t)u.aux * 4096 + cw;
        const f32x4 bg0 = *(const f32x4*)bg, bg1 = *(const f32x4*)(bg + 4), bu0 = *(const f32x4*)(bg + 2048), bu1 = *(const f32x4*)(bg + 2052);
        float rsv[8];
#pragma unroll
        for (int q = 0; q < 8; ++q) rsv[q] = rss[u.pm * 256 + (q >> 2) * 128 + wr * 64 + (q & 3) * 16 + fr];
#pragma unroll
        for (int ai = 0; ai < 2; ++ai)
#pragma unroll
            for (int m = 0; m < 4; ++m) {
                const int row = u.pm * 256 + ai * 128 + wr * 64 + m * 16 + fr; const float rs = rsv[ai * 4 + m] * (1.0f / W8_SCALE);
                f32x4 o[2];
#pragma unroll
                for (int n = 0; n < 2; ++n)
#pragma unroll
                    for (int j = 0; j < 4; ++j) {
                        float g = acc[ai][0][m][n][j] * rs + (n ? bg1[j] : bg0[j]); float up = acc[ai][1][m][n][j] * rs + (n ? bu1[j] : bu0[j]);
                        g = fminf(g, 7.0f); up = fminf(fmaxf(up, -7.0f), 7.0f);
                        o[n][j] = (up + 1.0f) * g * __builtin_amdgcn_rcpf(1.0f + __expf(-1.702f * g));
                    }
                *(u32x2*)(hdn + (size_t)row * DFF + cw) = pack_fp8x8(o[0][0], o[0][1], o[0][2], o[0][3], o[1][0], o[1][1], o[1][2], o[1][3]);
            }
    }
};
constexpr float YS_SCALE = 16.0f;
struct EpiDown { const float* gws; const float* bdn; unsigned char* ys;
    struct Pre { float gwv[8]; };
    __device__ __forceinline__ Pre pre(const Unit& u, int wr, int wc, int fr, int fq) const {
        Pre p;
#pragma unroll
        for (int q = 0; q < 8; ++q) p.gwv[q] = gws[u.pm * 256 + (q >> 2) * 128 + wr * 64 + (q & 3) * 16 + fr];
        return p;
    }
    __device__ __forceinline__ void operator()(const f32x4 (&acc)[2][2][4][2], const Unit& u, int wr, int wc, int fr, int fq, const Pre& pr) const {
        const int c0 = 256 * u.pn + 32 * wc + 8 * fq; const float* bp = bdn + (size_t)u.aux * DM + c0;
        const f32x4 b00 = *(const f32x4*)bp, b01 = *(const f32x4*)(bp + 4), b10 = *(const f32x4*)(bp + 128), b11 = *(const f32x4*)(bp + 132); const float (&gwv)[8] = pr.gwv;
#pragma unroll
        for (int ai = 0; ai < 2; ++ai)
#pragma unroll
            for (int m = 0; m < 4; ++m) {
                const int row = u.pm * 256 + ai * 128 + wr * 64 + m * 16 + fr; const float gw = gwv[ai * 4 + m] * YS_SCALE;
                constexpr float iw = 1.0f / W8_SCALE;
                const f32x4 o0 = (acc[ai][0][m][0] * iw + b00) * gw, o1 = (acc[ai][0][m][1] * iw + b01) * gw, o2 = (acc[ai][1][m][0] * iw + b10) * gw, o3 = (acc[ai][1][m][1] * iw + b11) * gw;
                *(u32x2*)(ys + (size_t)row * DM + c0) = pack_fp8x8(o0[0], o0[1], o0[2], o0[3], o1[0], o1[1], o1[2], o1[3]);
                *(u32x2*)(ys + (size_t)row * DM + c0 + 128) = pack_fp8x8(o2[0], o2[1], o2[2], o2[3], o3[0], o3[1], o3[2], o3[3]);
            }
    }
};

__device__ __forceinline__ void p_final(const Frame& F, const bf16_t* h) {
    const float* g = F.I<float>(IN_NORM_FINAL); const unsigned char* ys = F.W<unsigned char>(WS_YS); const int* pos = F.W<int>(WS_POS);
    const int ln = F.lane_();
    u32x4 pnext = (u32x4){0u, 0u, 0u, 0u};
    { const int r0 = F.bid * 8 + F.wave; if (r0 < T) pnext = *(const u32x4*)(pos + r0 * 4); }
    for (int r = F.bid * 8 + F.wave; r < T; r += F.G * 8) {
        f32x4 v[8]; float ss = 0.f;
        const int ps0 = (int)pnext.x, ps1 = (int)pnext.y, ps2 = (int)pnext.z, ps3 = (int)pnext.w;
        { const int rn = r + F.G * 8; if (rn < T) pnext = *(const u32x4*)(pos + rn * 4); }
#pragma unroll
        for (int i = 0; i < 4; ++i) {
            const int c = (i * 64 + ln) * 8;
            const u32x4 hh = *(const u32x4*)(h + (size_t)r * DM + c);
            const u32x2 y0 = *(const u32x2*)(ys + (size_t)ps0 * DM + c), y1 = *(const u32x2*)(ys + (size_t)ps1 * DM + c), y2 = *(const u32x2*)(ys + (size_t)ps2 * DM + c), y3 = *(const u32x2*)(ys + (size_t)ps3 * DM + c);
            f32x4 a, b;
            constexpr float iy = 1.0f / YS_SCALE;
#define FIN_Y(W, HI) ((__builtin_amdgcn_cvt_pk_f32_fp8((int)y0.W, HI) + __builtin_amdgcn_cvt_pk_f32_fp8((int)y1.W, HI)) + (__builtin_amdgcn_cvt_pk_f32_fp8((int)y2.W, HI) + __builtin_amdgcn_cvt_pk_f32_fp8((int)y3.W, HI)))
            { const f32x2 s0 = FIN_Y(x, false), s1 = FIN_Y(x, true), s2 = FIN_Y(y, false), s3 = FIN_Y(y, true);
              a[0] = bf_lo(hh.x) + s0[0] * iy; a[1] = bf_hi(hh.x) + s0[1] * iy; a[2] = bf_lo(hh.y) + s1[0] * iy; a[3] = bf_hi(hh.y) + s1[1] * iy;
              b[0] = bf_lo(hh.z) + s2[0] * iy; b[1] = bf_hi(hh.z) + s2[1] * iy; b[2] = bf_lo(hh.w) + s3[0] * iy; b[3] = bf_hi(hh.w) + s3[1] * iy; }
#undef FIN_Y
            v[2 * i] = a; v[2 * i + 1] = b;
            ss += a[0] * a[0] + a[1] * a[1] + a[2] * a[2] + a[3] * a[3] + b[0] * b[0] + b[1] * b[1] + b[2] * b[2] + b[3] * b[3];
        }
        ss = wave_sum(ss);
        float rs = __builtin_amdgcn_rsqf(ss * (1.0f / DM) + NORM_EPS);
#ifdef PROBE_MASK
        if (F.W<unsigned>(WS_CTL + CTL_CNT + 1024)[0] != 0u) rs = __builtin_nanf("");
#endif
#pragma unroll
        for (int i = 0; i < 4; ++i) {
            const int c = (i * 64 + ln) * 8;
            const f32x4 g0 = *(const f32x4*)(g + c), g1 = *(const f32x4*)(g + c + 4);
            *(f32x4*)(F.a->out + (size_t)r * DM + c) = v[2 * i] * rs * g0; *(f32x4*)(F.a->out + (size_t)r * DM + c + 4) = v[2 * i + 1] * rs * g1;
        }
    }
}

constexpr int N_PHASES = 14;
__global__ void __launch_bounds__(512, 2) fwd_kernel(Args args) {
    extern __shared__ __attribute__((aligned(16))) unsigned char lds_raw[];
    Frame F; F.a = &args; F.ws = args.ws; F.lds = (LAS unsigned char*)lds_raw;
    F.wave = __builtin_amdgcn_readfirstlane(threadIdx.x >> 6); F.G = gridDim.x; F.bid = blockIdx.x;
    volatile LAS unsigned* misc = (volatile LAS unsigned*)(F.lds + LDS_MISC);
    if (F.tid_() < 64) misc[F.tid_()] = 0u;
    __syncthreads();
    XcdBarrier bar; bar.bar = F.W<unsigned>(WS_CTL + CTL_BAR); bar.x = 0; bar.st = misc; bar.wv = F.wave;
#if !N_LAUNCH_PER_PHASE
    bar = xcd_barrier_post(F.W<unsigned>(WS_CTL + CTL_BAR), misc, F.wave);
#define GRID_BAR() xcd_barrier(bar)
#else
#define GRID_BAR() do { } while (0)
#endif
    const int lo = args.ph_lo, hi = args.ph_hi;
#ifndef ONLY_PHASE
#define ONLY_PHASE -1
#endif
#define IN(k) ((ONLY_PHASE < 0 || ONLY_PHASE == (k)) && lo <= (k) && (k) < hi)
#define BOTH(k) (IN(k) && IN((k) + 1))

    if (IN(0)) { p0_prologue(F); if (BOTH(0)) GRID_BAR(); }
#if REP_PHASE == 0
    if (IN(0)) { p0_prologue(F); if (BOTH(0)) GRID_BAR(); }
#endif
    if (IN(1)) {
        SchedG1F S8{F.G, F.bid, F.W<char>(WS_XB8), F.W<char>(WS_WINT)};
        SchedG1 S{F.G, F.G - 1 - F.bid, F.W<char>(WS_XB), F.W<char>(WS_WINT), F.W<char>(WS_MEMB), F.W<char>(WS_WKVT)};
        EpiG1 E{F.W<float>(WS_RS0), F.W<float>(WS_RSMEM), F.W<float>(WS_ROPEQK), F.W<float>(WS_ROPEI), F.W<bf16_t>(WS_ABUF), F.W<bf16_t>(WS_PBUF), F.W<bf16_t>(WS_GABUF),
                F.W<bf16_t>(WS_QB), F.W<bf16_t>(WS_KB), F.W<bf16_t>(WS_VB), F.W<bf16_t>(WS_QIB), F.W<bf16_t>(WS_KIB), F.W<float>(WS_WIB), F.W<bf16_t>(WS_KX), F.W<bf16_t>(WS_VX), 1.0f / W8_SCALE};
        pg8::SideConv SD{F.I<float>(IN_W_GU), F.W<unsigned char>(WS_WGUT), 1, 0, SJ_GU_P1, F.G, F.bid};
        const int sdone8 = pg8::gemm_phase<EpiG1, SchedG1F, pg8::SideConv, true>(F.lds, DM, S8, E, F.wave, SD);
        E.sc = 1.0f; SD.j0 += sdone8 * F.G;
        const int sdone = pg8::gemm_phase(F.lds, DM * 2, S, E, F.wave, SD);
        SD.leftover(sdone, F.wave, F.lane_());
        if (BOTH(1)) GRID_BAR();
    }
#if REP_PHASE == 1
    if (IN(1)) {
        SchedG1F S8{F.G, F.bid, F.W<char>(WS_XB8), F.W<char>(WS_WINT)};
        SchedG1 S{F.G, F.G - 1 - F.bid, F.W<char>(WS_XB), F.W<char>(WS_WINT), F.W<char>(WS_MEMB), F.W<char>(WS_WKVT)};
        EpiG1 E{F.W<float>(WS_RS0), F.W<float>(WS_RSMEM), F.W<float>(WS_ROPEQK), F.W<float>(WS_ROPEI), F.W<bf16_t>(WS_ABUF), F.W<bf16_t>(WS_PBUF), F.W<bf16_t>(WS_GABUF),
                F.W<bf16_t>(WS_QB), F.W<bf16_t>(WS_KB), F.W<bf16_t>(WS_VB), F.W<bf16_t>(WS_QIB), F.W<bf16_t>(WS_KIB), F.W<float>(WS_WIB), F.W<bf16_t>(WS_KX), F.W<bf16_t>(WS_VX), 1.0f / W8_SCALE};
        pg8::SideConv SD{F.I<float>(IN_W_GU), F.W<unsigned char>(WS_WGUT), 1, 0, SJ_GU_P1, F.G, F.bid};
        const int sdone8 = pg8::gemm_phase<EpiG1, SchedG1F, pg8::SideConv, true>(F.lds, DM, S8, E, F.wave, SD);
        E.sc = 1.0f; SD.j0 += sdone8 * F.G;
        const int sdone = pg8::gemm_phase(F.lds, DM * 2, S, E, F.wave, SD);
        SD.leftover(sdone, F.wave, F.lane_());
        if (BOTH(1)) GRID_BAR();
    }
#endif
#if MILESTONE >= 4
    if (IN(2)) { pg8::SideConv SD{F.I<float>(IN_W_GU), F.W<unsigned char>(WS_WGUT), 1, SJ_GU_P1, SJ_GU_P2, F.G, F.bid};
                 ix::indexer_phase(F, F.W<bf16_t>(WS_QIB), F.W<bf16_t>(WS_KIB), F.W<float>(WS_WIB), F.W<unsigned>(WS_MASK), SD); if (BOTH(2)) GRID_BAR(); }
#if REP_PHASE == 2
    if (IN(2)) { pg8::SideConv SD{F.I<float>(IN_W_GU), F.W<unsigned char>(WS_WGUT), 1, SJ_GU_P1, SJ_GU_P2, F.G, F.bid};
                 ix::indexer_phase(F, F.W<bf16_t>(WS_QIB), F.W<bf16_t>(WS_KIB), F.W<float>(WS_WIB), F.W<unsigned>(WS_MASK), SD); if (BOTH(2)) GRID_BAR(); }
#endif
    if (IN(3)) {
        att::AttnTensors X{F.W<bf16_t>(WS_QB), F.W<bf16_t>(WS_KB), F.W<bf16_t>(WS_VB), F.W<bf16_t>(WS_YATT), F.W<unsigned>(WS_MASK)};
        att::MergeArgs MG{F.ws, F.I<float>(IN_CONV_W)};
        att::attn_phase<DM, 512, DM, true, 6, true>((char*)lds_raw, X, MG, NB, NHEAD, NKVH, SEQ, SEQ, 0, att::ORDER_PAIRED | att::ORDER_XCD, F.G, F.bid, F.wave);
        if (BOTH(3)) GRID_BAR();
    }
#if REP_PHASE == 3
    if (IN(3)) {
        att::AttnTensors X{F.W<bf16_t>(WS_QB), F.W<bf16_t>(WS_KB), F.W<bf16_t>(WS_VB), F.W<bf16_t>(WS_YATT), F.W<unsigned>(WS_MASK)};
        att::MergeArgs MG{F.ws, F.I<float>(IN_CONV_W)};
        att::attn_phase<DM, 512, DM, true, 6, true>((char*)lds_raw, X, MG, NB, NHEAD, NKVH, SEQ, SEQ, 0, att::ORDER_PAIRED | att::ORDER_XCD, F.G, F.bid, F.wave);
        if (BOTH(3)) GRID_BAR();
    }
#endif
#endif
#ifdef PROBE_MASK
    if (IN(4)) { probe_mask_check(F); GRID_BAR(); }
#endif
    if (IN(5)) {
        SchedDense S{F.G, F.bid, 64, 8, F.W<char>(WS_MERGED), F.W<char>(WS_WOUTT), (size_t)256 * DM * 2};
        EpiResid<true> E{F.I<float>(IN_X), F.W<bf16_t>(WS_H1B), F.W<float>(WS_CTL + CTL_SS1)};
        pg8::SideConv SD{F.I<float>(IN_W_GU), F.W<unsigned char>(WS_WGUT), 1, SJ_GU_P2, SJ_GU, F.G, F.bid};
        const int sdone = pg8::gemm_phase(F.lds, DM * 2, S, E, F.wave, SD);
        SD.leftover(sdone, F.wave, F.lane_());
        if (BOTH(5)) GRID_BAR();
    }
#if REP_PHASE == 5
    if (IN(5)) {
        SchedDense S{F.G, F.bid, 64, 8, F.W<char>(WS_MERGED), F.W<char>(WS_WOUTT), (size_t)256 * DM * 2};
        EpiResid<true> E{F.I<float>(IN_X), F.W<bf16_t>(WS_H1B), nullptr};
        pg8::gemm_phase(F.lds, DM * 2, S, E, F.wave);
        if (BOTH(5)) GRID_BAR();
    }
#endif
#if MILESTONE >= 3
    if (IN(6)) {
        SchedDense S{F.G, F.bid, 64, 2, F.W<char>(WS_H1B), F.W<char>(WS_WQT), (size_t)256 * DM * 2};
        EpiScaleBf16 E{F.W<float>(WS_CTL + CTL_SS1), F.W<bf16_t>(WS_QX), 512};
        pg8::gemm_phase(F.lds, DM * 2, S, E, F.wave);
        if (F.G == 256 && F.bid >= 128) {
            pg8::SideConv SD{F.I<float>(IN_W_DN), F.W<unsigned char>(WS_WDNT), 0, SJ_DN - SJ_DN_P6, SJ_DN, 128, F.bid - 128};
            SD.leftover(0, F.wave, F.lane_()); }
        if (BOTH(6)) GRID_BAR();
    }
#if REP_PHASE == 6
    if (IN(6)) {
        SchedDense S{F.G, F.bid, 64, 2, F.W<char>(WS_H1B), F.W<char>(WS_WQT), (size_t)256 * DM * 2};
        EpiScaleBf16 E{F.W<float>(WS_CTL + CTL_SS1), F.W<bf16_t>(WS_QX), 512};
        pg8::gemm_phase(F.lds, DM * 2, S, E, F.wave);
        if (F.G == 256 && F.bid >= 128) {
            pg8::SideConv SD{F.I<float>(IN_W_DN), F.W<unsigned char>(WS_WDNT), 0, SJ_DN - SJ_DN_P6, SJ_DN, 128, F.bid - 128};
            SD.leftover(0, F.wave, F.lane_()); }
        if (BOTH(6)) GRID_BAR();
    }
#endif
    if (IN(7)) {
        att::AttnTensors X{F.W<bf16_t>(WS_QX), F.W<bf16_t>(WS_KX), F.W<bf16_t>(WS_VX), F.W<bf16_t>(WS_OX), nullptr};
        att::attn_phase<512, 512, 512, false, 6, false>((char*)lds_raw, X, att::MergeArgs{}, NB, XHEAD, XHEAD, SEQ, MEML, 1 << 20, att::ORDER_NATURAL, F.G, F.bid, F.wave);
        if (BOTH(7)) GRID_BAR();
    }
#if REP_PHASE == 7
    if (IN(7)) {
        att::AttnTensors X{F.W<bf16_t>(WS_QX), F.W<bf16_t>(WS_KX), F.W<bf16_t>(WS_VX), F.W<bf16_t>(WS_OX), nullptr};
        att::attn_phase<512, 512, 512, false, 6, false>((char*)lds_raw, X, att::MergeArgs{}, NB, XHEAD, XHEAD, SEQ, MEML, 1 << 20, att::ORDER_NATURAL, F.G, F.bid, F.wave);
        if (BOTH(7)) GRID_BAR();
    }
#endif
    if (IN(8)) {
        SchedDense S{F.G, F.bid, 64, 8, F.W<char>(WS_OX), F.W<char>(WS_WOXT), (size_t)256 * 512 * 2};
        EpiResid<false> E{F.W<bf16_t>(WS_H1B), F.W<bf16_t>(WS_H2B), nullptr};
        pg8::gemm_phase(F.lds, 512 * 2, S, E, F.wave);
        if (BOTH(8)) GRID_BAR();
    }
#if REP_PHASE == 8
    if (IN(8)) {
        SchedDense S{F.G, F.bid, 64, 8, F.W<char>(WS_OX), F.W<char>(WS_WOXT), (size_t)256 * 512 * 2};
        EpiResid<false> E{F.W<bf16_t>(WS_H1B), F.W<bf16_t>(WS_H2B), nullptr};
        pg8::gemm_phase(F.lds, 512 * 2, S, E, F.wave);
        if (BOTH(8)) GRID_BAR();
    }
#endif
#endif
    const bf16_t* h2b = F.W<bf16_t>(WS_H2B);
#if MILESTONE >= 2
    if (IN(9)) { p9_route(F, h2b); if (BOTH(9)) GRID_BAR(); }
    if (IN(10)) { p10_gather(F, h2b); if (BOTH(10)) GRID_BAR(); }
#if REP_PHASE == 10
    if (IN(10)) { p10_gather(F, h2b); if (BOTH(10)) GRID_BAR(); }
#endif
    if (IN(11)) {
        const int* te = F.W<int>(WS_TILEE); LAS int* tel = (LAS int*)(F.lds + LDS_MISC + 1024);
        tel[F.tid_()] = te[F.tid_()]; __syncthreads();
        SchedMoE S{F.G, F.bid, tel[511], 16, F.W<char>(WS_ASORT), F.W<char>(WS_WGUT), tel, (size_t)256 * DM, (size_t)4096 * DM};
        EpiSwiglu E{F.W<float>(WS_RSS), F.I<float>(IN_B_GU), F.W<unsigned char>(WS_HDN)};
        pg8::SideConv SD{F.I<float>(IN_W_DN), F.W<unsigned char>(WS_WDNT), 0, 0, F.G == 256 ? SJ_DN - SJ_DN_P6 : SJ_DN, F.G, F.bid};
        const int sdone = pg8::gemm_phase<EpiSwiglu, SchedMoE, pg8::SideConv, true>(F.lds, DM, S, E, F.wave, SD);
        SD.leftover(sdone, F.wave, F.lane_());
        if (BOTH(11)) GRID_BAR();
    }
#if REP_PHASE == 11
    if (IN(11)) {
        const int* te = F.W<int>(WS_TILEE); LAS int* tel = (LAS int*)(F.lds + LDS_MISC + 1024);
        tel[F.tid_()] = te[F.tid_()]; __syncthreads();
        SchedMoE S{F.G, F.bid, tel[511], 16, F.W<char>(WS_ASORT), F.W<char>(WS_WGUT), tel, (size_t)256 * DM, (size_t)4096 * DM};
        EpiSwiglu E{F.W<float>(WS_RSS), F.I<float>(IN_B_GU), F.W<unsigned char>(WS_HDN)};
        pg8::SideConv SD{F.I<float>(IN_W_DN), F.W<unsigned char>(WS_WDNT), 0, 0, F.G == 256 ? SJ_DN - SJ_DN_P6 : SJ_DN, F.G, F.bid};
        const int sdone = pg8::gemm_phase<EpiSwiglu, SchedMoE, pg8::SideConv, true>(F.lds, DM, S, E, F.wave, SD);
        SD.leftover(sdone, F.wave, F.lane_());
        if (BOTH(11)) GRID_BAR();
    }
#endif
    if (IN(12)) {
        const int* te = F.W<int>(WS_TILEE); LAS int* tel = (LAS int*)(F.lds + LDS_MISC + 1024);
        tel[F.tid_()] = te[F.tid_()]; __syncthreads();
        SchedMoE S{F.G, F.bid, tel[511], 8, F.W<char>(WS_HDN), F.W<char>(WS_WDNT), tel, (size_t)256 * DFF, (size_t)DM * DFF};
        EpiDown E{F.W<float>(WS_GWS), F.I<float>(IN_B_DN), F.W<unsigned char>(WS_YS)};
        pg8::gemm_phase<EpiDown, SchedMoE, pg8::SideNone, true>(F.lds, DFF, S, E, F.wave);
        if (BOTH(12)) GRID_BAR();
    }
#if REP_PHASE == 12
    if (IN(12)) {
        const int* te = F.W<int>(WS_TILEE); LAS int* tel = (LAS int*)(F.lds + LDS_MISC + 1024);
        tel[F.tid_()] = te[F.tid_()]; __syncthreads();
        SchedMoE S{F.G, F.bid, tel[511], 8, F.W<char>(WS_HDN), F.W<char>(WS_WDNT), tel, (size_t)256 * DFF, (size_t)DM * DFF};
        EpiDown E{F.W<float>(WS_GWS), F.I<float>(IN_B_DN), F.W<unsigned char>(WS_YS)};
        pg8::gemm_phase<EpiDown, SchedMoE, pg8::SideNone, true>(F.lds, DFF, S, E, F.wave);
        if (BOTH(12)) GRID_BAR();
    }
#endif
    if (IN(13)) { p_final(F, h2b); }
#if REP_PHASE == 13
    if (IN(13)) { p_final(F, h2b); }
#endif
#endif
#undef IN
#undef BOTH
}

extern "C" void kernel_launch(void* const* d_in, const int* in_sizes, int n_in, void* d_out, int out_size, void* d_ws, size_t ws_size, hipStream_t stream) {
    static int grid = 0;
    if (grid == 0) {
        if (n_in != 21 || out_size != T * DM || ws_size < WS_END) { fprintf(stderr, "kernel_launch: unexpected shapes (n_in %d, out %d, ws %zu < %zu)\n", n_in, out_size, ws_size, (size_t)WS_END); grid = -1; return; }
        int dev = 0, cus = 0, per_cu = 0;
        if (hipGetDevice(&dev) != hipSuccess || hipDeviceGetAttribute(&cus, hipDeviceAttributeMultiprocessorCount, dev) != hipSuccess) { grid = -1; return; }
        if (hipFuncSetAttribute((const void*)fwd_kernel, hipFuncAttributeMaxDynamicSharedMemorySize, LDS_BYTES) != hipSuccess) { fprintf(stderr, "kernel_launch: hipFuncSetAttribute failed\n"); grid = -1; return; }
        if (hipOccupancyMaxActiveBlocksPerMultiprocessor(&per_cu, (const void*)fwd_kernel, 512, LDS_BYTES) != hipSuccess || per_cu < 1) { fprintf(stderr, "kernel_launch: occupancy query says %d\n", per_cu); (void)hipGetLastError(); per_cu = 1; }
        grid = cus;
    }
    if (grid < 0) return;
    (void)hipMemsetAsync((char*)d_ws + WS_CTL, 0, CTL_BYTES, stream);
    Args a{};
    for (int i = 0; i < 21; ++i) a.in[i] = d_in[i];
    a.out = (float*)d_out; a.ws = (unsigned char*)d_ws;
#if N_LAUNCH_PER_PHASE
    for (int p = 0; p < N_PHASES; ++p) {
#if MILESTONE == 1
        if (!(p == 0 || p == 1 || p == 4 || p == 5 || p == 13)) continue;
#endif
#if MILESTONE == 2
        if (!(p == 0 || p == 1 || p == 4 || p == 5 || p >= 9)) continue;
#endif
#if MILESTONE == 3
        if (!(p == 0 || p == 1 || p >= 4)) continue;
#endif
        a.ph_lo = p; a.ph_hi = p + 1;
        hipLaunchKernelGGL(fwd_kernel, dim3(grid), dim3(512), LDS_BYTES, stream, a);
    }
#else
    a.ph_lo = 0; a.ph_hi = N_PHASES;
    hipLaunchKernelGGL(fwd_kernel, dim3(grid), dim3(512), LDS_BYTES, stream, a);
#endif
}
```

```cpp
#include <hip/hip_runtime.h>
#include <stdio.h>
#include <stdint.h>

#ifndef N_LAUNCH_PER_PHASE
#define N_LAUNCH_PER_PHASE 0
#endif
#ifndef REP_PHASE
#define REP_PHASE -1
#endif
#ifndef MILESTONE
#define MILESTONE 4
#endif

#define LAS __attribute__((address_space(3)))
typedef unsigned short bf16_t;
typedef short bf16x8 __attribute__((ext_vector_type(8)));
typedef float f32x2 __attribute__((ext_vector_type(2)));
typedef float f32x4 __attribute__((ext_vector_type(4)));
typedef float f32x16 __attribute__((ext_vector_type(16)));
typedef unsigned u32x4 __attribute__((ext_vector_type(4)));
typedef unsigned u32x2 __attribute__((ext_vector_type(2)));

constexpr int NB = 4, SEQ = 4096, T = NB * SEQ, DM = 2048, DIN = 14416;
constexpr int NHEAD = 16, HD = 128, NKVH = 4, IHEAD = 16, IDIM = 64, TOPK = 256;
constexpr int MEML = 256, XHEAD = 4;
constexpr int NEXP = 32, DFF = 2048, TOPE = 4;
constexpr float NORM_EPS = 1e-6f;
constexpr int C_CB = 0, C_CC = 2048, C_CX = 4096, C_Q = 6144, C_K = 8192, C_V = 8704, C_QI = 9216, C_KI = 10240, C_WI = 10304, C_GC = 10320, C_GA = 12368;
constexpr int TL_A = 0, TL_P = 16, TL_G = 32, TL_Q = 40, TL_K = 48, TL_V = 50, TL_QI = 52, TL_KI = 56, N1_TILES = 57, N1P = N1_TILES * 256;
constexpr int CAP_ROWS = T * TOPE + NEXP * 256;
constexpr int MAX_MT = CAP_ROWS / 256;

constexpr size_t al256(size_t x) { return (x + 255) & ~(size_t)255; }
constexpr size_t WS_CTL = 0;
constexpr size_t CTL_BAR = 0;
constexpr size_t CTL_CNT = 16384;
constexpr size_t CTL_SS1 = 32768;
constexpr size_t CTL_BYTES = CTL_SS1 + (size_t)T * 4;
constexpr size_t WS_XB = al256(CTL_BYTES);
constexpr size_t WS_RS0 = WS_XB + (size_t)T * DM * 2;
constexpr size_t WS_RSMEM = WS_RS0 + (size_t)T * 4;
constexpr size_t WS_ROPEQK = WS_RSMEM + 4096;
constexpr size_t WS_ROPEI = WS_ROPEQK + (size_t)T * 32 * 4;
constexpr size_t WS_MEMB = WS_ROPEI + (size_t)T * 16 * 4;
constexpr size_t WS_WINT = WS_MEMB + (size_t)NB * MEML * DM * 2;
constexpr size_t WS_WOUTT = WS_WINT + (size_t)N1P * DM * 2;
constexpr size_t WS_WQT = WS_WOUTT + (size_t)DM * DM * 2;
constexpr size_t WS_WKVT = WS_WQT + (size_t)512 * DM * 2;
constexpr size_t WS_WOXT = WS_WKVT + (size_t)1024 * DM * 2;
constexpr size_t WS_WGUT = WS_WOXT + (size_t)DM * 512 * 2;
constexpr size_t WS_WDNT = WS_WGUT + (size_t)NEXP * 4096 * DM * 2;
constexpr size_t WS_WRT = WS_WDNT + (size_t)NEXP * DM * DFF * 2;
constexpr size_t WS_ABUF = WS_WRT + (size_t)NEXP * DM * 4;
constexpr size_t WS_PBUF = WS_ABUF + (size_t)T * DM * 2;
constexpr size_t WS_GABUF = WS_PBUF + (size_t)T * DM * 2;
constexpr size_t WS_QB = WS_GABUF + (size_t)T * DM * 2;
constexpr size_t WS_KB = WS_QB + (size_t)T * DM * 2;
constexpr size_t WS_VB = WS_KB + (size_t)T * 512 * 2;
constexpr size_t WS_QIB = WS_VB + (size_t)T * 512 * 2;
constexpr size_t WS_KIB = WS_QIB + (size_t)T * 1024 * 2;
constexpr size_t WS_WIB = WS_KIB + (size_t)T * 64 * 2;
constexpr size_t WS_MASK = WS_WIB + (size_t)T * 16 * 4;
constexpr size_t WS_YATT = WS_MASK + (size_t)T * 128 * 4;
constexpr size_t WS_MERGED = WS_YATT + (size_t)T * DM * 2;
constexpr size_t WS_H1 = WS_MERGED + (size_t)T * DM * 2;
constexpr size_t WS_H1B = WS_H1 + (size_t)T * DM * 4;
constexpr size_t WS_QX = WS_H1B + (size_t)T * DM * 2;
constexpr size_t WS_KX = WS_QX + (size_t)T * 512 * 2;
constexpr size_t WS_VX = WS_KX + (size_t)NB * MEML * 512 * 2;
constexpr size_t WS_OX = WS_VX + (size_t)NB * MEML * 512 * 2;
constexpr size_t WS_H2 = WS_OX + (size_t)T * 512 * 2;
constexpr size_t WS_H2B = WS_H2 + (size_t)T * DM * 4;
constexpr size_t WS_SLOTE = WS_H2B + (size_t)T * DM * 2;
constexpr size_t WS_SLOTR = WS_SLOTE + (size_t)T * 4 * 4;
constexpr size_t WS_SLOTG = WS_SLOTR + (size_t)T * 4 * 4;
constexpr size_t WS_RS2 = WS_SLOTG + (size_t)T * 4 * 4;
constexpr size_t WS_POS = WS_RS2 + (size_t)T * 4;
constexpr size_t WS_RSS = WS_POS + (size_t)T * 4 * 4;
constexpr size_t WS_GWS = WS_RSS + (size_t)CAP_ROWS * 4;
constexpr size_t WS_TILEE = WS_GWS + (size_t)CAP_ROWS * 4;
constexpr size_t WS_ASORT = WS_TILEE + 2048;
constexpr size_t WS_HDN = WS_ASORT + (size_t)CAP_ROWS * DM * 2;
constexpr size_t WS_YS = WS_HDN + (size_t)CAP_ROWS * DFF * 2;
constexpr size_t WS_TIE = WS_YS + (size_t)CAP_ROWS * DM * 2;
constexpr size_t WS_XB8 = WS_TIE;
constexpr size_t WS_END = WS_TIE + (size_t)256 * 8 * 128 * 64 * 4;

__device__ __forceinline__ unsigned cvt_pk_bf16(float lo, float hi) { unsigned r; asm volatile("v_cvt_pk_bf16_f32 %0, %1, %2" : "=v"(r) : "v"(lo), "v"(hi)); return r; }
__device__ __forceinline__ u32x2 pack_fp8x8(float a0, float a1, float a2, float a3, float a4, float a5, float a6, float a7) {
    int lo = 0, hi = 0;
    lo = __builtin_amdgcn_cvt_pk_fp8_f32(a0, a1, lo, false); lo = __builtin_amdgcn_cvt_pk_fp8_f32(a2, a3, lo, true);
    hi = __builtin_amdgcn_cvt_pk_fp8_f32(a4, a5, hi, false); hi = __builtin_amdgcn_cvt_pk_fp8_f32(a6, a7, hi, true);
    return (u32x2){(unsigned)lo, (unsigned)hi};
}
constexpr float W8_SCALE = 64.0f;
__device__ __forceinline__ float bf2f(unsigned short b) { return __uint_as_float(((unsigned)b) << 16); }
__device__ __forceinline__ float bf_lo(unsigned w) { return __uint_as_float(w << 16); }
__device__ __forceinline__ float bf_hi(unsigned w) { return __uint_as_float(w & 0xffff0000u); }
__device__ __forceinline__ float sigmoidf_(float x) { return __builtin_amdgcn_rcpf(1.0f + __expf(-x)); }
__device__ __forceinline__ int lane_id() { int x; asm volatile("v_mbcnt_lo_u32_b32 %0, -1, 0\n\tv_mbcnt_hi_u32_b32 %0, -1, %0" : "=v"(x)); return x; }
__device__ __forceinline__ float wave_sum(float v) {
#pragma unroll
    for (int o = 32; o >= 1; o >>= 1) v += __shfl_xor(v, o);
    return v;
}

#define XB_TMO      128
#define XB_XCNT(j)  (256  + 64 * (j))
#define XB_XSUB(j)  (1280 + 64 * (j))
#define XB_XGEN(j)  (2304 + 64 * (j))
#define XB_TOP      3328
#define XB_TOPGEN   3392
#define XCD_BAR_WORDS 3456
#define XB_SPIN_CAP (1u << 18)

__device__ __forceinline__ unsigned xb_ld(unsigned* p)              { return __hip_atomic_load(p, __ATOMIC_RELAXED, __HIP_MEMORY_SCOPE_AGENT); }
__device__ __forceinline__ unsigned xb_add(unsigned* p, unsigned v) { return __hip_atomic_fetch_add(p, v, __ATOMIC_RELAXED, __HIP_MEMORY_SCOPE_AGENT); }
__device__ __forceinline__ unsigned xb_xcc_id() { return (unsigned)__builtin_amdgcn_s_getreg((3 << 11) | 20) & 0xFu; }
#define XB_SPIN(cond, bar) do { unsigned _sp = 0; while (cond) { __builtin_amdgcn_s_sleep(1); \
    if ((++_sp & 255u) == 0u) { if (xb_ld(&(bar)[XB_TMO])) break; if (_sp > XB_SPIN_CAP) { atomicAdd(&(bar)[XB_TMO], 1u); break; } } } } while (0)

struct XcdBarrier { unsigned* bar; unsigned x; volatile LAS unsigned* st; int wv; };

__device__ __forceinline__ XcdBarrier xcd_barrier_post(unsigned* bar, volatile LAS unsigned* st, int wv) {
    XcdBarrier b; b.bar = bar; b.x = xb_xcc_id(); b.st = st; b.wv = wv;
    if (wv == 0 && lane_id() == 0) (void)xb_add(&bar[XB_XCNT(b.x)], 1u);
    return b;
}
__device__ __forceinline__ void xcd_barrier_complete(unsigned* bar, unsigned x, unsigned& nloc, unsigned& nx) {
    const unsigned G = gridDim.x * gridDim.y * gridDim.z;
    unsigned sum, cnt, mine, sp = 0u;
    for (;;) {
        sum = 0u; cnt = 0u; mine = 0u;
#pragma unroll
        for (unsigned j = 0; j < 16; ++j) { const unsigned c = xb_ld(&bar[XB_XCNT(j)]); sum += c; cnt += (c > 0u) ? 1u : 0u; mine = (j == x) ? c : mine; }
        if (sum == G) break;
        __builtin_amdgcn_s_sleep(1);
        if ((++sp & 255u) == 0u) { if (xb_ld(&bar[XB_TMO])) break; if (sp > XB_SPIN_CAP) { atomicAdd(&bar[XB_TMO], 1u); break; } }
    }
    nloc = mine > 0u ? mine : 1u; nx = cnt > 0u ? cnt : 1u;
}
__device__ __forceinline__ void xcd_barrier(const XcdBarrier& b) {
    asm volatile("s_waitcnt vmcnt(0)" ::: "memory");
    __syncthreads();
    if (b.wv == 0 && lane_id() == 0) {
        unsigned* bar = b.bar;
        __builtin_amdgcn_s_waitcnt(0);
        unsigned nloc = b.st[0], nx = b.st[1];
        if (nloc == 0u) { xcd_barrier_complete(bar, b.x, nloc, nx); b.st[0] = nloc; b.st[1] = nx; }
        const unsigned old = xb_add(&bar[XB_XSUB(b.x)], 1u);
        const unsigned gen = old / nloc;
        if (old + 1u == (gen + 1u) * nloc) {
            __builtin_amdgcn_fence(__ATOMIC_RELEASE, "agent");
            asm volatile("s_waitcnt vmcnt(0)" ::: "memory");
            const unsigned og = xb_add(&bar[XB_TOP], 1u);
            const unsigned tg = og / nx;
            if (og + 1u == (tg + 1u) * nx) xb_add(&bar[XB_TOPGEN], 1u);
            else XB_SPIN(xb_ld(&bar[XB_TOPGEN]) == tg, bar);
            __builtin_amdgcn_fence(__ATOMIC_ACQUIRE, "agent");
            xb_add(&bar[XB_XGEN(b.x)], 1u);
            asm volatile("s_waitcnt vmcnt(0)" ::: "memory");
        } else {
            XB_SPIN(xb_ld(&bar[XB_XGEN(b.x)]) == gen, bar);
            __builtin_amdgcn_fence(__ATOMIC_ACQUIRE, "agent");
            asm volatile("s_waitcnt vmcnt(0)" ::: "memory");
        }
    }
    __syncthreads();
}

constexpr int LDS_CT = 131072;
namespace pg8 {
constexpr int BM = 256, BK = 64, HALF = 128, HTB = HALF * BK * 2, STAGE_BYTES = 8 * HTB, NXCD = 8, WGM = 8;
__device__ __forceinline__ int lds_byte(int r, int c) { const int st = (r >> 4) * 2 + (c >> 5), rr = r & 15, cc = c & 31, ob = rr * 64 + cc * 2; return st * 1024 + (ob ^ (((ob >> 9) & 1) << 5)); }
__device__ __forceinline__ void stage_rc(int b, int& R, int& C) { const int st = b / 1024, sb = b % 1024, swz = sb ^ (((sb >> 9) & 1) << 5); R = (st >> 1) * 16 + swz / 64; C = (st & 1) * 32 + (swz % 64) / 2; }
__device__ __forceinline__ int perm32(int rho) { const int n = rho >> 4, i = rho & 15; return 8 * (i >> 2) + 4 * n + (i & 3); }

struct Unit { const char* a; const char* b; int pm, pn, kind, aux; };

__device__ __forceinline__ void tile_of(int L, int nM, int nN, int& pm, int& pn) {
    const int nwg = nM * nN; int wgid = L;
    { const int q = nwg / NXCD, r = nwg % NXCD, xcd = wgid % NXCD, off = wgid / NXCD; wgid = (xcd < r ? xcd * (q + 1) : r * (q + 1) + (xcd - r) * q) + off; }
    const int nig = WGM * nN, gid = wgid / nig, fm = gid * WGM, gsz = (nM - fm) < WGM ? (nM - fm) : WGM;
    pm = fm + ((wgid % nig) % gsz); pn = (wgid % nig) / gsz;
}


struct SideNone { static constexpr bool ON = false; };
struct SideConv {
    static constexpr bool ON = true;
    const float* src; unsigned char* dst; int gu; int j0, jn; int G, c;
    __device__ __forceinline__ void decode(int j, size_t& soff, int& sld, size_t& doff) const {
        if (gu) { const int e = j >> 11, r = j & 2047, nt = r >> 4, kt = r & 15, n0 = nt * 32, w = n0 & 255, tile = n0 >> 8;
            const int sc = (w < 128) ? 128 * tile + w : 2048 + 128 * tile + (w - 128);
            sld = 4096; soff = (size_t)e * 2048 * 4096 + (size_t)(kt * 128) * 4096 + sc; doff = (size_t)e * 4096 * 2048 + (size_t)n0 * 2048 + kt * 128; }
        else { const int e = j >> 10, r = j & 1023, nt = r >> 4, kt = r & 15, n0 = nt * 32;
            sld = 2048; soff = (size_t)e * 2048 * 2048 + (size_t)(kt * 128) * 2048 + n0; doff = (size_t)e * 2048 * 2048 + (size_t)n0 * 2048 + kt * 128; }
    }
    __device__ __forceinline__ size_t issue(int j, LAS unsigned char* tile, int wid, int lane) const {
        size_t soff, doff; int sld; decode(j, soff, sld, doff);
        const float* sp = src + soff + (size_t)(16 * wid + (lane >> 3)) * sld + (lane & 7) * 4;
        __builtin_amdgcn_global_load_lds((const unsigned*)sp, (LAS unsigned*)(tile + (2 * wid) * 1040), 16, 0, 2);
        __builtin_amdgcn_global_load_lds((const unsigned*)(sp + (size_t)8 * sld), (LAS unsigned*)(tile + (2 * wid + 1) * 1040), 16, 0, 2);
        return doff;
    }
    __device__ __forceinline__ void consume(const LAS unsigned char* tile, size_t doff, int wid, int lane) const {
        float sv[8];
#pragma unroll
        for (int j = 0; j < 8; ++j) sv[j] = *(const LAS float*)(tile + (lane & 15) * 1040 + j * 128 + (4 * wid + (lane >> 4)) * 4);
        __builtin_nontemporal_store(pack_fp8x8(sv[0] * W8_SCALE, sv[1] * W8_SCALE, sv[2] * W8_SCALE, sv[3] * W8_SCALE, sv[4] * W8_SCALE, sv[5] * W8_SCALE, sv[6] * W8_SCALE, sv[7] * W8_SCALE),
                                    (u32x2*)(dst + doff + (size_t)(4 * wid + (lane >> 4)) * 2048 + 8 * (lane & 15)));
    }
    __device__ __forceinline__ void leftover(int done, int wid, int lane) const {
        for (int q = done; j0 + q * G + c < jn; q += 4) {
            float v[4][8]; size_t doff[4]; bool ok[4];
#pragma unroll
            for (int u = 0; u < 4; ++u) {
                const int j = j0 + (q + u) * G + c; ok[u] = j < jn;
                size_t soff; int sld; decode(ok[u] ? j : j0 + q * G + c, soff, sld, doff[u]);
                const float* sp = src + soff + (size_t)(16 * wid + 8 * (lane >> 5)) * sld + (lane & 31);
#pragma unroll
                for (int r = 0; r < 8; ++r) v[u][r] = __builtin_nontemporal_load(sp + (size_t)r * sld);
            }
#pragma unroll
            for (int u = 0; u < 4; ++u)
                if (ok[u]) *(u32x2*)(dst + doff[u] + (size_t)(lane & 31) * 2048 + 16 * wid + 8 * (lane >> 5)) = pack_fp8x8(v[u][0] * W8_SCALE, v[u][1] * W8_SCALE, v[u][2] * W8_SCALE, v[u][3] * W8_SCALE, v[u][4] * W8_SCALE, v[u][5] * W8_SCALE, v[u][6] * W8_SCALE, v[u][7] * W8_SCALE);
        }
    }
};

typedef int i32x4_ __attribute__((ext_vector_type(4)));
typedef int i32x8_ __attribute__((ext_vector_type(8)));
template <class Epi, class Sched, class Side = SideNone, bool FP8 = false>
__device__ __forceinline__ int gemm_phase(LAS unsigned char* lds, const int RB, const Sched& S, const Epi& E, const int wid, const Side& SD = Side{}) {
    const int lane = lane_id(), tid = wid * 64 + lane, wr = wid >> 2, wc = wid & 3, fr = lane & 15, fq = lane >> 4;
    const int nt = RB / 128;
    unsigned voffA[2], voffB[2];
#pragma unroll
    for (int i = 0; i < 2; ++i) { int R, C; stage_rc(tid * 16 + i * 8192, R, C); const int Rb = (R & ~31) + perm32(R & 31);
        voffA[i] = (unsigned)(R * RB + C * 2); voffB[i] = (unsigned)(Rb * RB + C * 2); }
    const size_t kstep = (size_t)(BK * 2);
    const size_t hstep = (size_t)HALF * RB;
    const unsigned ldsw = (unsigned)wid * 1024u;
    const int aoff = lds_byte(wr * 64 + fr, fq * 8), boff = lds_byte(wc * 32 + fr, fq * 8);
#define PG8_SA(b, h) (((b) * 2 + (h)) * HTB)
#define PG8_SB(b, h) ((4 + (b) * 2 + (h)) * HTB)
#define PG8_STAGE(bufoff, gbase, voff) do { _Pragma("unroll") for (int _i = 0; _i < 2; ++_i) \
        __builtin_amdgcn_global_load_lds((const unsigned*)((const char*)(gbase) + (voff)[_i]), (LAS unsigned*)(lds + (bufoff) + ldsw + _i * 8192), 16, 0, 0); } while (0)
#define PG8_LDA(dst, b, h) do { if constexpr (FP8) { _Pragma("unroll") for (int m = 0; m < 4; ++m) dst##8[m] = __builtin_shufflevector(*(const LAS i32x4_*)(lds + PG8_SA(b, h) + aoff + m * 2048), *(const LAS i32x4_*)(lds + PG8_SA(b, h) + aoff + m * 2048 + 1024), 0, 1, 2, 3, 4, 5, 6, 7); } \
        else { _Pragma("unroll") for (int m = 0; m < 4; ++m) _Pragma("unroll") for (int k = 0; k < 2; ++k) dst[m][k] = *(const LAS bf16x8*)(lds + PG8_SA(b, h) + aoff + m * 2048 + k * 1024); } } while (0)
#define PG8_LDB(dst, b, h) do { if constexpr (FP8) { _Pragma("unroll") for (int n = 0; n < 2; ++n) dst##8[n] = __builtin_shufflevector(*(const LAS i32x4_*)(lds + PG8_SB(b, h) + boff + n * 2048), *(const LAS i32x4_*)(lds + PG8_SB(b, h) + boff + n * 2048 + 1024), 0, 1, 2, 3, 4, 5, 6, 7); } \
        else { _Pragma("unroll") for (int n = 0; n < 2; ++n) _Pragma("unroll") for (int k = 0; k < 2; ++k) dst[n][k] = *(const LAS bf16x8*)(lds + PG8_SB(b, h) + boff + n * 2048 + k * 1024); } } while (0)
#define PG8_CAT(X) X
#define PG8_MMA(ai, bj, At, Bt) do { if constexpr (FP8) __builtin_amdgcn_sched_barrier(0); __builtin_amdgcn_s_setprio(1); _Pragma("unroll") for (int m = 0; m < 4; ++m) _Pragma("unroll") for (int n = 0; n < 2; ++n) { \
        if constexpr (FP8) asm volatile("v_mfma_scale_f32_16x16x128_f8f6f4 %0, %1, %2, %0, %3, %3 op_sel_hi:[0,0,0]" : "+v"(acc[ai][bj][m][n]) : "v"(Bt##8[n]), "v"(At##8[m]), "v"(mx_one));   \
        else { _Pragma("unroll") for (int k = 0; k < 2; ++k) acc[ai][bj][m][n] = __builtin_amdgcn_mfma_f32_16x16x32_bf16(Bt[n][k], At[m][k], acc[ai][bj][m][n], 0, 0, 0); } } \
        __builtin_amdgcn_s_setprio(0); if constexpr (FP8) __builtin_amdgcn_sched_barrier(0); } while (0)
#define PG8_WAIT_V(n) asm volatile("s_waitcnt vmcnt(" #n ")" ::: "memory")
#define PG8_WAIT_L(n) asm volatile("s_waitcnt lgkmcnt(" #n ")" ::: "memory")
#define PG8_BAR __builtin_amdgcn_s_barrier()
#define PG8_SCHED __builtin_amdgcn_sched_barrier(0)
    Unit cur, nxt; int ui = 0;
    int sq = 0; bool s_have = false; size_t s_doff = 0;
    if (!S.next(0, cur)) return 0;
    f32x4 acc[2][2][4][2];
#pragma unroll
    for (int a = 0; a < 2; ++a)
#pragma unroll
        for (int b = 0; b < 2; ++b)
#pragma unroll
            for (int m = 0; m < 4; ++m)
#pragma unroll
                for (int n = 0; n < 2; ++n) acc[a][b][m][n] = (f32x4){0.f, 0.f, 0.f, 0.f};
    bf16x8 At[4][2], B0[2][2], B1[2][2];
    const int mx_one = 0x7F7F7F7F;
    i32x8_ At8[4], B08[2], B18[2];
    const char* cA = cur.a; const char* cB = cur.b;
    PG8_STAGE(PG8_SB(0, 0), cB, voffB); PG8_STAGE(PG8_SA(0, 0), cA, voffA); PG8_STAGE(PG8_SB(0, 1), cB + hstep, voffB); PG8_STAGE(PG8_SA(0, 1), cA + hstep, voffA);
    if (wr == 1) PG8_BAR;
    PG8_WAIT_V(4); PG8_BAR;
    PG8_STAGE(PG8_SB(1, 0), cB + kstep, voffB); PG8_STAGE(PG8_SA(1, 0), cA + kstep, voffA); PG8_STAGE(PG8_SB(1, 1), cB + hstep + kstep, voffB);
    PG8_WAIT_V(6); PG8_BAR;
    for (;;) {
        const bool has_next = S.next(ui + 1, nxt);
        const char* nA = has_next ? nxt.a : cA; const char* nB = has_next ? nxt.b : cB;
        const int lzp = lane_id(); const typename Epi::Pre pre = E.pre(cur, wr, wc, lzp & 15, lzp >> 4);
        for (int t = 0; t < nt; t += 2) {
            const bool last = (t == nt - 2);
            const char* a1 = cA + (size_t)(t + 1) * kstep;
            const char* a2 = last ? nA : cA + (size_t)(t + 2) * kstep; const char* b2 = last ? nB : cB + (size_t)(t + 2) * kstep;
            const char* a3 = a2 + kstep; const char* b3 = b2 + kstep;
            PG8_LDB(B0, 0, 0); PG8_SCHED; PG8_LDA(At, 0, 0); PG8_STAGE(PG8_SA(1, 1), a1 + hstep, voffA);
            PG8_WAIT_L(8); PG8_BAR; PG8_WAIT_L(0); PG8_MMA(0, 0, At, B0); PG8_BAR; PG8_SCHED;
            PG8_LDB(B1, 0, 1);
            float sv[8]; const bool s_st = Side::ON && s_have;
            if constexpr (Side::ON) { if (s_st) {
#pragma unroll
                for (int j = 0; j < 8; ++j) sv[j] = *(const LAS float*)(lds + LDS_CT + (lane & 15) * 1040 + j * 128 + (4 * wid + (lane >> 4)) * 4); } }
            PG8_STAGE(PG8_SB(0, 0), b2, voffB);
            PG8_BAR; PG8_WAIT_L(0);
            u32x2 sw; if constexpr (Side::ON) { if (s_st) sw = pack_fp8x8(sv[0] * W8_SCALE, sv[1] * W8_SCALE, sv[2] * W8_SCALE, sv[3] * W8_SCALE, sv[4] * W8_SCALE, sv[5] * W8_SCALE, sv[6] * W8_SCALE, sv[7] * W8_SCALE); }
            PG8_MMA(0, 1, At, B1); PG8_BAR;
            PG8_LDA(At, 0, 1);
            if constexpr (Side::ON) { if (s_st) *(u32x2*)(SD.dst + s_doff + (size_t)(4 * wid + (lane >> 4)) * 2048 + 8 * (lane & 15)) = sw; }
            PG8_STAGE(PG8_SA(0, 0), a2, voffA);
            PG8_BAR; PG8_WAIT_L(0); PG8_MMA(1, 0, At, B0); PG8_BAR; PG8_SCHED;
            PG8_STAGE(PG8_SB(0, 1), b2 + hstep, voffB);
            if (Side::ON && s_st) { PG8_WAIT_V(7); } else { PG8_WAIT_V(6); }
            PG8_BAR; PG8_MMA(1, 1, At, B1); PG8_BAR;
            PG8_LDB(B0, 1, 0); PG8_SCHED; PG8_LDA(At, 1, 0);
            if constexpr (Side::ON) {
                s_have = false;
                if (SD.j0 + sq * SD.G + SD.c < SD.jn) { size_t soff; int sld; SD.decode(SD.j0 + sq * SD.G + SD.c, soff, sld, s_doff);
                    const float* sp = SD.src + soff + (size_t)(16 * wid + (lane >> 3)) * sld + (lane & 7) * 4;
                    __builtin_amdgcn_global_load_lds((const unsigned*)sp, (LAS unsigned*)(lds + LDS_CT + (2 * wid) * 1040), 16, 0, 2);
                    __builtin_amdgcn_global_load_lds((const unsigned*)(sp + (size_t)8 * sld), (LAS unsigned*)(lds + LDS_CT + (2 * wid + 1) * 1040), 16, 0, 2);
                    s_have = true; ++sq; }
            }
            PG8_STAGE(PG8_SA(0, 1), a2 + hstep, voffA);
            PG8_WAIT_L(8); PG8_BAR; PG8_WAIT_L(0); PG8_MMA(0, 0, At, B0); PG8_BAR; PG8_SCHED;
            PG8_LDB(B1, 1, 1); PG8_STAGE(PG8_SB(1, 0), b3, voffB);
            PG8_BAR; PG8_WAIT_L(0); PG8_MMA(0, 1, At, B1); PG8_BAR;
            PG8_LDA(At, 1, 1); PG8_STAGE(PG8_SA(1, 0), a3, voffA);
            PG8_BAR; PG8_WAIT_L(0); PG8_MMA(1, 0, At, B0); PG8_BAR; PG8_SCHED;
            PG8_STAGE(PG8_SB(1, 1), b3 + hstep, voffB);
            PG8_WAIT_V(6); PG8_BAR; PG8_MMA(1, 1, At, B1); PG8_BAR;
        }
        if constexpr (FP8) asm volatile("s_nop 15\n s_nop 7" ::: "memory");
        { const int lz = lane_id(); E(acc, cur, wr, wc, lz & 15, lz >> 4, pre); }
        if (!has_next) break;
#pragma unroll
        for (int a = 0; a < 2; ++a)
#pragma unroll
            for (int b = 0; b < 2; ++b)
#pragma unroll
                for (int m = 0; m < 4; ++m)
#pragma unroll
                    for (int n = 0; n < 2; ++n) acc[a][b][m][n] = (f32x4){0.f, 0.f, 0.f, 0.f};
        cur = nxt; cA = nA; cB = nB; ++ui;
    }
    PG8_WAIT_V(0);
    if (wr == 0) PG8_BAR;
    PG8_BAR;
    if constexpr (Side::ON) { if (s_have) {
        float sv[8];
#pragma unroll
        for (int j = 0; j < 8; ++j) sv[j] = *(const LAS float*)(lds + LDS_CT + (lane & 15) * 1040 + j * 128 + (4 * wid + (lane >> 4)) * 4);
        *(u32x2*)(SD.dst + s_doff + (size_t)(4 * wid + (lane >> 4)) * 2048 + 8 * (lane & 15)) =
            pack_fp8x8(sv[0] * W8_SCALE, sv[1] * W8_SCALE, sv[2] * W8_SCALE, sv[3] * W8_SCALE, sv[4] * W8_SCALE, sv[5] * W8_SCALE, sv[6] * W8_SCALE, sv[7] * W8_SCALE); } }
#undef PG8_SA
#undef PG8_SB
#undef PG8_STAGE
#undef PG8_LDA
#undef PG8_LDB
#undef PG8_MMA
#undef PG8_WAIT_V
#undef PG8_WAIT_L
#undef PG8_BAR
#undef PG8_SCHED
#undef PG8_CAT
    return sq;
}
}
using pg8::Unit;

struct Args { const void* in[21]; float* out; unsigned char* ws; int ph_lo, ph_hi; };
enum { IN_X = 0, IN_MEM, IN_POS, IN_NORM_MIX, IN_W_IN, IN_CONV_W, IN_W_OUT, IN_NORM_XATTN, IN_NORM_MEM, IN_WQ_X, IN_WK_X, IN_WV_X, IN_WO_X, IN_NORM_FFN,
       IN_W_ROUTER, IN_B_ROUTER, IN_W_GU, IN_B_GU, IN_W_DN, IN_B_DN, IN_NORM_FINAL };
constexpr int LDS_BYTES = 163840;
constexpr int LDS_MISC = 155648;

struct Frame {
    const Args* a; unsigned char* ws; LAS unsigned char* lds; int wave, G, bid;
    __device__ __forceinline__ int lane_() const { return lane_id(); }
    __device__ __forceinline__ int tid_() const { return wave * 64 + lane_id(); }
    template <class Tp> __device__ __forceinline__ Tp* W(size_t off) const { return (Tp*)(ws + off); }
    template <class Tp> __device__ __forceinline__ const Tp* I(int k) const { return (const Tp*)a->in[k]; }
};

__constant__ float c_invfreq[16] = {1.000000000e+00f, 4.403665960e-01f, 1.939227432e-01f, 8.539710194e-02f, 3.760603070e-02f, 1.656044088e-02f, 7.292664610e-03f, 3.211446106e-03f,
                                    1.414213562e-03f, 6.227724371e-04f, 2.742481884e-04f, 1.207697351e-04f, 5.318295734e-05f, 2.341999971e-05f, 1.031338525e-05f, 4.541670478e-06f};

__device__ __forceinline__ int win_src_col(int c) {
    const int tile = c >> 8, w = c & 255;
    if (tile < TL_P) { const int i = tile - TL_A; return w < 128 ? C_CB + 128 * i + w : C_GC + 128 * i + (w - 128); }
    if (tile < TL_G) { const int i = tile - TL_P; return w < 128 ? C_CC + 128 * i + w : C_CX + 128 * i + (w - 128); }
    if (tile < TL_Q) return C_GA + 256 * (tile - TL_G) + w;
    if (tile < TL_V) {
        const int col = (tile < TL_K) ? 256 * (tile - TL_Q) + w : 256 * (tile - TL_K) + w; const int base = (tile < TL_K) ? C_Q : C_K;
        const int d = col & 127; int pd = d;
        if (d < 32) { const int f = d >> 3, r = d & 7; pd = (r < 4) ? 4 * f + r : 16 + 4 * f + (r - 4); }
        return base + (col & ~127) + pd;
    }
    if (tile < TL_QI) return C_V + 256 * (tile - TL_V) + w;
    if (tile < TL_KI) { const int col = 256 * (tile - TL_QI) + w; const int d = col & 63; int pd = d;
        if (d < 16) { const int f = d >> 3, r = d & 7; pd = (r < 4) ? 4 * f + r : 8 + 4 * f + (r - 4); }
        return C_QI + (col & ~63) + pd; }
    if (w < 64) { int pd = w; if (w < 16) { const int f = w >> 3, r = w & 7; pd = (r < 4) ? 4 * f + r : 8 + 4 * f + (r - 4); } return C_KI + pd; }
    if (w < 80) return C_WI + (w - 64);
    return -1;
}

enum { MAP_ID = 0, MAP_WIN = 1, MAP_KV = 2, MAP_GU = 3 };
struct TJob { const float* src; const float* src2; const float* scale; bf16_t* dst; int src_ld, K, n0, k0, map, f8; };
__device__ __forceinline__ void tjob_load(const TJob& J, int wave, int lane, f32x4 (&R)[8]) {
    const int n = J.n0 + 32 * wave + (lane & 7) * 4;
    const float* sp = J.src; int sc = n;
    if (J.map == MAP_WIN) sc = win_src_col(n);
    else if (J.map == MAP_KV) { if (n >= 512) { sp = J.src2; sc = n - 512; } }
    else if (J.map == MAP_GU) { const int tile = n >> 8, w = n & 255; sc = (w < 128) ? 128 * tile + w : 2048 + 128 * tile + (w - 128); }
    const float* p = sp + (size_t)(J.k0 + 8 * (lane >> 3)) * J.src_ld + (sc >= 0 ? sc : 0);
#pragma unroll
    for (int j = 0; j < 8; ++j) { R[j] = (sc >= 0) ? __builtin_nontemporal_load((const f32x4*)(p + (size_t)j * J.src_ld)) : (f32x4){0.f, 0.f, 0.f, 0.f}; }
}
__device__ __forceinline__ void tjob_store(const TJob& J, int wave, int lane, const f32x4 (&R)[8]) {
    const int n = J.n0 + 32 * wave + (lane & 7) * 4, k = J.k0 + 8 * (lane >> 3);
    f32x4 s0 = (f32x4){1.f, 1.f, 1.f, 1.f}, s1 = s0;
    if (J.scale) { s0 = *(const f32x4*)(J.scale + k); s1 = *(const f32x4*)(J.scale + k + 4); }
    if (J.f8) {
        s0 *= W8_SCALE; s1 *= W8_SCALE;
#pragma unroll
        for (int c = 0; c < 4; ++c)
            __builtin_nontemporal_store(pack_fp8x8(R[0][c] * s0[0], R[1][c] * s0[1], R[2][c] * s0[2], R[3][c] * s0[3], R[4][c] * s1[0], R[5][c] * s1[1], R[6][c] * s1[2], R[7][c] * s1[3]),
                                        (u32x2*)((unsigned char*)J.dst + (size_t)(n + c) * J.K + k));
        return;
    }
#pragma unroll
    for (int c = 0; c < 4; ++c) {
        u32x4 w;
        w.x = cvt_pk_bf16(R[0][c] * s0[0], R[1][c] * s0[1]); w.y = cvt_pk_bf16(R[2][c] * s0[2], R[3][c] * s0[3]);
        w.z = cvt_pk_bf16(R[4][c] * s1[0], R[5][c] * s1[1]); w.w = cvt_pk_bf16(R[6][c] * s1[2], R[7][c] * s1[3]);
        __builtin_nontemporal_store(w, (u32x4*)(J.dst + (size_t)(n + c) * J.K + k));
    }
}

__device__ __forceinline__ void row_cvt(const float* src, bf16_t* dst, float* rs, int lane, unsigned char* dst8 = nullptr) {
    float ss = 0.f;
#pragma unroll
    for (int i = 0; i < 4; ++i) {
        const int c = (i * 64 + lane) * 8;
        const f32x4 a = *(const f32x4*)(src + c), b = *(const f32x4*)(src + c + 4);
        ss += a[0] * a[0] + a[1] * a[1] + a[2] * a[2] + a[3] * a[3] + b[0] * b[0] + b[1] * b[1] + b[2] * b[2] + b[3] * b[3];
        u32x4 w; w.x = cvt_pk_bf16(a[0], a[1]); w.y = cvt_pk_bf16(a[2], a[3]); w.z = cvt_pk_bf16(b[0], b[1]); w.w = cvt_pk_bf16(b[2], b[3]);
        *(u32x4*)(dst + c) = w;
        if (dst8) *(u32x2*)(dst8 + c) = pack_fp8x8(a[0], a[1], a[2], a[3], b[0], b[1], b[2], b[3]);
    }
    ss = wave_sum(ss);
    if (lane == 0) *rs = __builtin_amdgcn_rsqf(ss * (1.0f / DM) + NORM_EPS);
}

constexpr int SJ_GU = NEXP * 32 * 64, SJ_GU_P1 = 256 * 160, SJ_GU_P2 = SJ_GU_P1 + 256 * 64, SJ_DN = NEXP * 32 * 32;
constexpr int J_WIN = N1_TILES * 32, J_WOUT = 8 * 32, J_WQ = 2 * 32, J_WKV = 4 * 32, J_WOX = 8 * 8, J_GU = 16 * 32, J_DN = 8 * 32;
constexpr int TJ0 = J_WIN, TJ1 = TJ0 + J_WOUT, TJ2 = TJ1 + J_WQ, TJ3 = TJ2 + J_WKV, TJ_EARLY = TJ3 + J_WOX, TJ5 = TJ_EARLY + NEXP * J_GU, TJ_ALL = TJ5 + NEXP * J_DN;
__device__ __forceinline__ TJob tjob_decode(const Frame& F, int j) {
    TJob J; J.src2 = nullptr; J.scale = nullptr; J.src_ld = DM; J.K = DM; J.map = MAP_ID; J.f8 = 0;
    if (j < TJ0) { const int nt = j >> 5, kt = j & 31; J.src = F.I<float>(IN_W_IN); J.src_ld = DIN; J.scale = F.I<float>(IN_NORM_MIX); J.dst = F.W<bf16_t>(WS_WINT); J.map = MAP_WIN; J.n0 = nt * 256; J.k0 = kt * 64; J.f8 = nt < TL_P || (nt >= TL_G && nt < TL_QI); if (J.f8) J.dst += (size_t)nt * 128 * DM; }
    else if (j < TJ1) { const int q = j - TJ0, nt = q >> 5, kt = q & 31; J.src = F.I<float>(IN_W_OUT); J.dst = F.W<bf16_t>(WS_WOUTT); J.n0 = nt * 256; J.k0 = kt * 64; }
    else if (j < TJ2) { const int q = j - TJ1, nt = q >> 5, kt = q & 31; J.src = F.I<float>(IN_WQ_X); J.src_ld = 512; J.scale = F.I<float>(IN_NORM_XATTN); J.dst = F.W<bf16_t>(WS_WQT); J.n0 = nt * 256; J.k0 = kt * 64; }
    else if (j < TJ3) { const int q = j - TJ2, nt = q >> 5, kt = q & 31; J.src = F.I<float>(IN_WK_X); J.src2 = F.I<float>(IN_WV_X); J.src_ld = 512; J.scale = F.I<float>(IN_NORM_MEM); J.dst = F.W<bf16_t>(WS_WKVT); J.map = MAP_KV; J.n0 = nt * 256; J.k0 = kt * 64; }
    else if (j < TJ_EARLY) { const int q = j - TJ3, nt = q >> 3, kt = q & 7; J.src = F.I<float>(IN_WO_X); J.dst = F.W<bf16_t>(WS_WOXT); J.K = 512; J.n0 = nt * 256; J.k0 = kt * 64; }
    else if (j < TJ5) { const int q = j - TJ_EARLY, e = q / J_GU, r = q % J_GU, nt = r >> 5, kt = r & 31;
        J.src = F.I<float>(IN_W_GU) + (size_t)e * DM * 4096; J.src_ld = 4096; J.scale = F.I<float>(IN_NORM_FFN); J.dst = F.W<bf16_t>(WS_WGUT) + (size_t)e * 4096 * DM; J.map = MAP_GU; J.n0 = nt * 256; J.k0 = kt * 64; }
    else { const int q = j - TJ5, e = q / J_DN, r = q % J_DN, nt = r >> 5, kt = r & 31;
        J.src = F.I<float>(IN_W_DN) + (size_t)e * DFF * DM; J.dst = F.W<bf16_t>(WS_WDNT) + (size_t)e * DM * DFF; J.K = DFF; J.n0 = nt * 256; J.k0 = kt * 64; }
    return J;
}
template <int NS>
__device__ __forceinline__ void convert_weights(const Frame& F, int jlo, int jhi, int first, int step) {
    f32x4 R[NS][8]; TJob J[NS]; int jj[NS];
    const int wv = F.wave, ln = F.lane_();
    int j = jlo + first;
#pragma unroll
    for (int s = 0; s < NS - 1; ++s) { jj[s] = j; if (j < jhi) { J[s] = tjob_decode(F, j); tjob_load(J[s], wv, ln, R[s]); } j += step; }
    for (;;) {
        bool done = false;
#pragma unroll
        for (int s = 0; s < NS; ++s) {
            if (!done) {
                constexpr int dummy = 0; (void)dummy;
                const int sl = (s + NS - 1) % NS;
                jj[sl] = j; if (j < jhi) { J[sl] = tjob_decode(F, j); tjob_load(J[sl], wv, ln, R[sl]); } j += step;
                if (jj[s] >= jhi) done = true; else tjob_store(J[s], wv, ln, R[s]);
            }
        }
        if (done) break;
    }
}

__device__ __forceinline__ void p0_prologue(const Frame& F) {
    const int G = F.G, bid = F.bid;
    convert_weights<3>(F, 0, TJ_EARLY, bid, G);
    for (int r = bid * 8 + F.wave; r < T + NB * MEML; r += G * 8) {
        if (r < T) row_cvt(F.I<float>(IN_X) + (size_t)r * DM, F.W<bf16_t>(WS_XB) + (size_t)r * DM, F.W<float>(WS_RS0) + r, F.lane_(), F.W<unsigned char>(WS_XB8) + (size_t)r * DM);
        else { const int m = r - T; row_cvt(F.I<float>(IN_MEM) + (size_t)m * DM, F.W<bf16_t>(WS_MEMB) + (size_t)m * DM, F.W<float>(WS_RSMEM) + m, F.lane_()); }
    }
    for (int i = bid * 512 + F.tid_(); i < T * 24; i += G * 512) {
        const int t = i / 24, f = i % 24;
        const float inv = f < 16 ? c_invfreq[f] : c_invfreq[2 * (f - 16)];
        const float ang = (float)F.I<int>(IN_POS)[t] * inv;
        double rev = (double)ang * 0.15915494309189533577; rev -= __builtin_rint(rev);
        const float rv = (float)rev;
        const float sn = __builtin_amdgcn_sinf(rv), cs = __builtin_amdgcn_cosf(rv);
        if (f < 16) { F.W<float>(WS_ROPEQK)[t * 32 + f] = cs; F.W<float>(WS_ROPEQK)[t * 32 + 16 + f] = sn; }
        else { F.W<float>(WS_ROPEI)[t * 16 + (f - 16)] = cs; F.W<float>(WS_ROPEI)[t * 16 + 8 + (f - 16)] = sn; }
    }
    for (int i = bid * 512 + F.tid_(); i < NEXP * DM; i += G * 512) {
        const int e = i / DM, k = i % DM;
        F.W<float>(WS_WRT)[i] = F.I<float>(IN_NORM_FFN)[k] * F.I<float>(IN_W_ROUTER)[k * NEXP + e];
    }
}

enum { KD_A = 0, KD_P, KD_G, KD_Q, KD_K, KD_V, KD_QI, KD_KI, KD_KVX };
struct SchedG1F {
    int G, c; const char* xb8; const char* wint;
    static constexpr int NT8 = TL_P + (TL_QI - TL_G);
    __device__ __forceinline__ bool next(int i, Unit& u) const {
        int L = i * G + c;
        if (G == 256) {
            if (i == 8) { if (c >= 176) return false; L = 2048 + c; }
            else if (i == 9) { if (c >= 80) return false; L = 2224 + c; }
            else if (i > 9) return false;
        }
        if (L >= 64 * NT8) return false;
        int pm, pn; pg8::tile_of(L, 64, NT8, pm, pn); if (pn >= TL_P) pn += TL_G - TL_P; u.pm = pm; u.pn = pn; u.a = xb8 + (size_t)pm * 256 * DM; u.b = wint + (size_t)pn * 256 * DM * 2;
        u.kind = pn < TL_P ? KD_A : pn < TL_Q ? KD_G : pn < TL_K ? KD_Q : pn < TL_V ? KD_K : KD_V; u.aux = 0; return true;
    }
};
struct SchedG1 {
    int G, c; const char* xb; const char* wint; const char* memb; const char* wkvt;
    __device__ __forceinline__ bool next(int i, Unit& u) const {
        constexpr int NT = N1_TILES - SchedG1F::NT8;
        const int L = i * G + c; constexpr int NW1 = 64 * NT;
        if (L < NW1) { int pm, pn; pg8::tile_of(L, 64, NT, pm, pn); pn = pn < TL_G - TL_P ? TL_P + pn : TL_QI + (pn - (TL_G - TL_P)); u.pm = pm; u.pn = pn; u.a = xb + (size_t)pm * 256 * DM * 2; u.b = wint + (size_t)pn * 256 * DM * 2;
            u.kind = pn < TL_P ? KD_A : pn < TL_G ? KD_P : pn < TL_Q ? KD_G : pn < TL_K ? KD_Q : pn < TL_V ? KD_K : pn < TL_QI ? KD_V : pn < TL_KI ? KD_QI : KD_KI; u.aux = 0; return true; }
        const int q = L - NW1; if (q >= 16) return false;
        u.pm = q & 3; u.pn = q >> 2; u.a = memb + (size_t)u.pm * 256 * DM * 2; u.b = wkvt + (size_t)u.pn * 256 * DM * 2; u.kind = KD_KVX; u.aux = 0; return true;
    }
};
__device__ __forceinline__ void st_bf16x8(bf16_t* p, const f32x4& a, const f32x4& b) {
    u32x4 w; w.x = cvt_pk_bf16(a[0], a[1]); w.y = cvt_pk_bf16(a[2], a[3]); w.z = cvt_pk_bf16(b[0], b[1]); w.w = cvt_pk_bf16(b[2], b[3]);
    *(u32x4*)p = w;
}
struct EpiG1 {
    const float* rs0; const float* rsmem; const float* ropeqk; const float* ropei;
    bf16_t* abuf; bf16_t* pbuf; bf16_t* gabuf; bf16_t* qb; bf16_t* kb; bf16_t* vb; bf16_t* qib; bf16_t* kib; float* wib; bf16_t* kx; bf16_t* vx; float sc;
    struct Pre { };
    __device__ __forceinline__ Pre pre(const Unit&, int, int, int, int) const { return Pre{}; }
    __device__ __forceinline__ void operator()(const f32x4 (&acc)[2][2][4][2], const Unit& u, int wr, int wc, int fr, int fq, const Pre&) const {
        const int kind = u.kind, pn = u.pn;
        const int cw = 32 * wc + 8 * fq;
        const int rowb = u.pm * 256 + wr * 64 + fr;
        float rsv[8];
        { const float* rsp = (kind == KD_KVX) ? rsmem : rs0;
#pragma unroll
          for (int q = 0; q < 8; ++q) rsv[q] = rsp[rowb + (q >> 2) * 128 + (q & 3) * 16] * sc; }
        const bool rotqk = (kind == KD_Q || kind == KD_K) && (wc == 0);
        const bool roti = (kind == KD_QI && ((wc & 1) == 0) && fq < 2) || (kind == KD_KI && wc == 0 && fq < 2);
#pragma unroll
        for (int ai = 0; ai < 2; ++ai) {
            f32x4 cs[4], sn[4];
#pragma unroll
            for (int q = 0; q < 4; ++q) { cs[q] = (f32x4){1.f, 1.f, 1.f, 1.f}; sn[q] = (f32x4){0.f, 0.f, 0.f, 0.f}; }
            if (rotqk) {
#pragma unroll
                for (int q = 0; q < 4; ++q) { const float* tp = ropeqk + (size_t)(rowb + ai * 128 + q * 16) * 32 + 4 * fq; cs[q] = *(const f32x4*)tp; sn[q] = *(const f32x4*)(tp + 16); }
            } else if (roti) {
#pragma unroll
                for (int q = 0; q < 4; ++q) { const float* tp = ropei + (size_t)(rowb + ai * 128 + q * 16) * 16 + 4 * fq; cs[q] = *(const f32x4*)tp; sn[q] = *(const f32x4*)(tp + 8); }
            }
#pragma unroll
            for (int m = 0; m < 4; ++m) {
                const int row = rowb + ai * 128 + m * 16, q = m;
                const float rs = rsv[ai * 4 + m];
                if (kind == KD_KVX) {
                    bf16_t* o = (pn < 2 ? kx : vx) + (size_t)row * 512 + 256 * (pn & 1) + cw;
#pragma unroll
                    for (int bj = 0; bj < 2; ++bj) st_bf16x8(o + 128 * bj, acc[ai][bj][m][0] * rs, acc[ai][bj][m][1] * rs);
                } else if (kind == KD_A) {
                    f32x4 o0, o1;
#pragma unroll
                    for (int j = 0; j < 4; ++j) { o0[j] = acc[ai][0][m][0][j] * rs * sigmoidf_(acc[ai][1][m][0][j] * rs); o1[j] = acc[ai][0][m][1][j] * rs * sigmoidf_(acc[ai][1][m][1][j] * rs); }
                    st_bf16x8(abuf + (size_t)row * DM + 128 * (pn - TL_A) + cw, o0, o1);
                } else if (kind == KD_P) {
                    const float r2 = rs * rs;
                    st_bf16x8(pbuf + (size_t)row * DM + 128 * (pn - TL_P) + cw, acc[ai][0][m][0] * acc[ai][1][m][0] * r2, acc[ai][0][m][1] * acc[ai][1][m][1] * r2);
                } else if (kind == KD_G) {
#pragma unroll
                    for (int bj = 0; bj < 2; ++bj) { f32x4 o0, o1;
#pragma unroll
                        for (int j = 0; j < 4; ++j) { o0[j] = sigmoidf_(acc[ai][bj][m][0][j] * rs); o1[j] = sigmoidf_(acc[ai][bj][m][1][j] * rs); }
                        st_bf16x8(gabuf + (size_t)row * DM + 256 * (pn - TL_G) + 128 * bj + cw, o0, o1); }
                } else if (kind == KD_Q || kind == KD_K) {
                    bf16_t* o = (kind == KD_Q) ? qb + (size_t)row * DM + 256 * (pn - TL_Q) + cw : kb + (size_t)row * 512 + 256 * (pn - TL_K) + cw;
#pragma unroll
                    for (int bj = 0; bj < 2; ++bj) {
                        const f32x4 x1 = acc[ai][bj][m][0] * rs, x2 = acc[ai][bj][m][1] * rs;
                        if (rotqk) st_bf16x8(o + 128 * bj, x1 * cs[q] - x2 * sn[q], x2 * cs[q] + x1 * sn[q]);
                        else st_bf16x8(o + 128 * bj, x1, x2);
                    }
                } else if (kind == KD_V) {
#pragma unroll
                    for (int bj = 0; bj < 2; ++bj) st_bf16x8(vb + (size_t)row * 512 + 256 * (pn - TL_V) + 128 * bj + cw, acc[ai][bj][m][0] * rs, acc[ai][bj][m][1] * rs);
                } else if (kind == KD_QI) {
#pragma unroll
                    for (int bj = 0; bj < 2; ++bj) {
                        const f32x4 x1 = acc[ai][bj][m][0] * rs, x2 = acc[ai][bj][m][1] * rs;
                        bf16_t* o = qib + (size_t)row * 1024 + 256 * (pn - TL_QI) + 128 * bj + cw;
                        if (roti) st_bf16x8(o, x1 * cs[q] - x2 * sn[q], x2 * cs[q] + x1 * sn[q]); else st_bf16x8(o, x1, x2);
                    }
                } else {
                    const f32x4 x1 = acc[ai][0][m][0] * rs, x2 = acc[ai][0][m][1] * rs;
                    if (wc < 2) {
                        if (roti) st_bf16x8(kib + (size_t)row * 64 + cw, x1 * cs[q] - x2 * sn[q], x2 * cs[q] + x1 * sn[q]);
                        else st_bf16x8(kib + (size_t)row * 64 + cw, x1, x2);
                    } else if (wc == 2 && fq < 2) {
                        *(f32x4*)(wib + (size_t)row * 16 + 8 * fq) = x1 * 0.03125f; *(f32x4*)(wib + (size_t)row * 16 + 8 * fq + 4) = x2 * 0.03125f;
                    }
                }
            }
        }
    }
};

struct SchedDense { int G, c, nM, nN; const char* A; const char* Bt; size_t tstep;
    __device__ __forceinline__ bool next(int i, Unit& u) const {
        const int L = i * G + c; if (L >= nM * nN) return false;
        int pm, pn; pg8::tile_of(L, nM, nN, pm, pn); u.pm = pm; u.pn = pn; u.a = A + (size_t)pm * tstep; u.b = Bt + (size_t)pn * tstep; u.kind = 0; u.aux = 0; return true; }
};
template <bool RF32>
struct EpiResid { const void* resid; bf16_t* hb; float* ss;
    struct Pre { };
    __device__ __forceinline__ Pre pre(const Unit&, int, int, int, int) const { return Pre{}; }
    __device__ __forceinline__ void operator()(const f32x4 (&acc)[2][2][4][2], const Unit& u, int wr, int wc, int fr, int fq, const Pre&) const {
        const size_t off0 = (size_t)(u.pm * 256 + wr * 64 + fr) * DM + u.pn * 256 + 32 * wc + 8 * fq;
#pragma unroll
        for (int ai = 0; ai < 2; ++ai) {
            f32x4 r0[4][2], r1[4][2];
#pragma unroll
            for (int m = 0; m < 4; ++m)
#pragma unroll
                for (int bj = 0; bj < 2; ++bj) {
                    const size_t off = off0 + (size_t)(ai * 128 + m * 16) * DM + 128 * bj;
                    if (RF32) { r0[m][bj] = *(const f32x4*)((const float*)resid + off); r1[m][bj] = *(const f32x4*)((const float*)resid + off + 4); }
                    else { const u32x4 rb = *(const u32x4*)((const bf16_t*)resid + off);
                        r0[m][bj] = (f32x4){bf_lo(rb.x), bf_hi(rb.x), bf_lo(rb.y), bf_hi(rb.y)}; r1[m][bj] = (f32x4){bf_lo(rb.z), bf_hi(rb.z), bf_lo(rb.w), bf_hi(rb.w)}; }
                }
#pragma unroll
            for (int m = 0; m < 4; ++m) {
                const int row = u.pm * 256 + ai * 128 + wr * 64 + m * 16 + fr; float sq = 0.f;
#pragma unroll
                for (int bj = 0; bj < 2; ++bj) {
                    const size_t off = off0 + (size_t)(ai * 128 + m * 16) * DM + 128 * bj;
                    const f32x4 v0 = acc[ai][bj][m][0] + r0[m][bj], v1 = acc[ai][bj][m][1] + r1[m][bj];
                    st_bf16x8(hb + off, v0, v1);
                    sq += v0[0] * v0[0] + v0[1] * v0[1] + v0[2] * v0[2] + v0[3] * v0[3] + v1[0] * v1[0] + v1[1] * v1[1] + v1[2] * v1[2] + v1[3] * v1[3];
                }
                if (ss) { sq += __shfl_xor(sq, 16); sq += __shfl_xor(sq, 32); if (fq == 0) atomicAdd(ss + row, sq); }
            }
        }
    }
};

struct EpiScaleBf16 { const float* ss; bf16_t* out; int ldo;
    struct Pre { float rsv[8]; };
    __device__ __forceinline__ Pre pre(const Unit& u, int wr, int wc, int fr, int fq) const {
        Pre p;
#pragma unroll
        for (int q = 0; q < 8; ++q) p.rsv[q] = ss[u.pm * 256 + (q >> 2) * 128 + wr * 64 + (q & 3) * 16 + fr];
        return p;
    }
    __device__ __forceinline__ void operator()(const f32x4 (&acc)[2][2][4][2], const Unit& u, int wr, int wc, int fr, int fq, const Pre& pr) const {
        const float (&rsv)[8] = pr.rsv;
#pragma unroll
        for (int ai = 0; ai < 2; ++ai)
#pragma unroll
            for (int m = 0; m < 4; ++m) {
                const int row = u.pm * 256 + ai * 128 + wr * 64 + m * 16 + fr; const float rs = __builtin_amdgcn_rsqf(rsv[ai * 4 + m] * (1.0f / DM) + NORM_EPS);
#pragma unroll
                for (int bj = 0; bj < 2; ++bj) st_bf16x8(out + (size_t)row * ldo + u.pn * 256 + 128 * bj + 32 * wc + 8 * fq, acc[ai][bj][m][0] * rs, acc[ai][bj][m][1] * rs);
            }
    }
};

namespace att {
constexpr int D = 128, NW = 8, QBLK = 32, KVBLK = 64, QB = NW * QBLK;
constexpr int SHM_V = KVBLK * D * 2, SHM_K = KVBLK * D * 2;
constexpr int LDS_QOFF = 2 * SHM_V + 2 * SHM_K + NW * 64 * 4;
constexpr int LDS_BYTES_ATT = LDS_QOFF + NW * 8192;
static_assert(LDS_BYTES_ATT <= 135168, "attention LDS map");
constexpr float SCALE = 0.08838834764831845f;
constexpr float THR = 8.f;
typedef short s16x4 __attribute__((ext_vector_type(4)));
#define KSWZ(row, colB) ((row) * 256 + ((colB) ^ (((row) & 7) << 4)))
#define SBAR() __builtin_amdgcn_sched_barrier(0)
__device__ __forceinline__ int v_st(int k, int c) { const int kk = (k & ~0xC) | ((k & 4) << 1) | ((k & 8) >> 1); return ((kk >> 3) * 4 + (c >> 5)) * 512 + ((kk & 7) * 32 + (c & 31)) * 2; }
__device__ __forceinline__ int v_rd_base(int lane) { return ((lane & 3) << 3) | (((lane >> 2) & 3) << 6) | (((lane >> 4) & 1) << 5) | (((lane >> 5) & 1) << 8); }
constexpr int v_rd_off(int d0, int ks, int half) { return d0 * 512 + ks * 4096 + half * 2048; }
__device__ __forceinline__ int crow(int r, int hi) { return (r & 3) + 8 * (r >> 2) + 4 * hi; }
__device__ __forceinline__ bf16x8 load8(const bf16_t* p) { return *reinterpret_cast<const bf16x8*>(p); }
__device__ __forceinline__ void mask_tile(f32x16& p0, f32x16& p1, int dq, unsigned W) {
    const float NEG = -__builtin_inff();
#pragma unroll
    for (int r = 0; r < 16; ++r) {
        const int c = (r & 3) + 8 * (r >> 2);
        if ((unsigned)(dq - c) >= W) p0[r] = NEG;
        if ((unsigned)(dq - c - 32) >= W) p1[r] = NEG;
    }
}
template <bool SEL>
__device__ __forceinline__ void partialSM(f32x16& p0, f32x16& p1, float& m_reg, float& mn, float& alpha, unsigned selw) {
    float pmax = p0[0];
#pragma unroll
    for (int r = 1; r < 16; ++r) pmax = fmaxf(pmax, p0[r]);
#pragma unroll
    for (int r = 0; r < 16; ++r) pmax = fmaxf(pmax, p1[r]);
    { auto rr = __builtin_amdgcn_permlane32_swap(__float_as_uint(pmax), __float_as_uint(pmax), false, false);
      pmax = fmaxf(__uint_as_float(rr[0]), __uint_as_float(rr[1])); }
    constexpr float C2 = 1.4426950408889634f * SCALE;
    if (__builtin_expect(__all((pmax - m_reg) * SCALE <= THR), 1)) { mn = m_reg; alpha = 1.f; }
    else { mn = fmaxf(m_reg, pmax); alpha = __builtin_amdgcn_exp2f((m_reg - mn) * C2); m_reg = mn; }
    const float mnL = -mn * C2;
#pragma unroll
    for (int r = 0; r < 16; ++r) p0[r] = fmaf(p0[r], C2, mnL);
#pragma unroll
    for (int r = 0; r < 16; ++r) p1[r] = fmaf(p1[r], C2, mnL);
#pragma unroll
    for (int r = 0; r < 16; ++r) p0[r] = __builtin_amdgcn_exp2f(p0[r]);
    if (SEL) {
#pragma unroll
        for (int r = 0; r < 16; ++r) p0[r] = __uint_as_float(__float_as_uint(p0[r]) & (unsigned)__builtin_amdgcn_sbfe((int)selw, r, 1));
    }
}
template <bool SEL>
__device__ __forceinline__ void finishSM(f32x16& p0, f32x16& p1, float alpha, float& l_reg, bf16x8& pa0, bf16x8& pa1, bf16x8& pa2, bf16x8& pa3, unsigned selw) {
#pragma unroll
    for (int r = 0; r < 16; ++r) p1[r] = __builtin_amdgcn_exp2f(p1[r]);
    if (SEL) {
#pragma unroll
        for (int r = 0; r < 16; ++r) p1[r] = __uint_as_float(__float_as_uint(p1[r]) & (unsigned)__builtin_amdgcn_sbfe((int)selw, 16 + r, 1));
    }
    float ps = 0;
#pragma unroll
    for (int r = 0; r < 16; ++r) ps += p0[r];
#pragma unroll
    for (int r = 0; r < 16; ++r) ps += p1[r];
    { auto rr = __builtin_amdgcn_permlane32_swap(__float_as_uint(ps), __float_as_uint(ps), false, false);
      ps = __uint_as_float(rr[0]) + __uint_as_float(rr[1]); }
    l_reg = l_reg * alpha + ps;
#define PK4(P, B_, OUT) do { unsigned a0 = cvt_pk_bf16(P[B_+0], P[B_+1]), a1 = cvt_pk_bf16(P[B_+2], P[B_+3]);                          \
        unsigned b0 = cvt_pk_bf16(P[B_+4], P[B_+5]), b1 = cvt_pk_bf16(P[B_+6], P[B_+7]);                                             \
        auto r0 = __builtin_amdgcn_permlane32_swap(a0, b0, false, false); auto r1 = __builtin_amdgcn_permlane32_swap(a1, b1, false, false); \
        u32x4 w = {r0[0], r1[0], r0[1], r1[1]}; OUT = *reinterpret_cast<bf16x8*>(&w); } while (0)
    PK4(p0, 0, pa0); PK4(p0, 8, pa1); PK4(p1, 0, pa2); PK4(p1, 8, pa3);
#undef PK4
}
template <int KB, int QREG>
__device__ __forceinline__ void qkt(f32x16& p0, f32x16& p1, const char* K_lds, int r32, int hi, const bf16x8* qr, const char* qlds) {
    p0 = f32x16{}; p1 = f32x16{};
    const char* kb[4];
#pragma unroll
    for (int dd = 0; dd < 4; ++dd) kb[dd] = K_lds + KB * SHM_K + KSWZ(r32, (dd * 16 + hi * 8) * 2);
#pragma unroll
    for (int d0 = 0; d0 < 8; ++d0) { const char* a = kb[d0 & 3] + (d0 >> 2) * 128;
        bf16x8 b0 = *reinterpret_cast<const bf16x8*>(a);
        bf16x8 b1 = *reinterpret_cast<const bf16x8*>(a + 32 * 256);
        const bf16x8 qf = (d0 < QREG) ? qr[d0 < QREG ? d0 : 0] : *reinterpret_cast<const bf16x8*>(qlds + (d0 - QREG) * 1024);
        p0 = __builtin_amdgcn_mfma_f32_32x32x16_bf16(b0, qf, p0, 0, 0, 0);
        p1 = __builtin_amdgcn_mfma_f32_32x32x16_bf16(b1, qf, p1, 0, 0, 0); }
}
template <int VB>
__device__ __forceinline__ void pv_tile(f32x16* o, int vb0, bf16x8 pa0, bf16x8 pa1, bf16x8 pa2, bf16x8 pa3) {
#define TRRD(dst, off) asm volatile("ds_read_b64_tr_b16 %0, %1 offset:%2" : "=&v"(dst) : "v"(vb0), "i"(off) : "memory")
#define PV_D0(d0) do { s16x4 l0, l1, l2, l3, h0, h1, h2, h3; constexpr int b_ = VB * SHM_V + v_rd_off(d0, 0, 0); \
        TRRD(l0, b_); TRRD(h0, b_ + 2048); TRRD(l1, b_ + 4096); TRRD(h1, b_ + 6144); TRRD(l2, b_ + 8192); TRRD(h2, b_ + 10240); TRRD(l3, b_ + 12288); TRRD(h3, b_ + 14336); \
        asm volatile("s_waitcnt lgkmcnt(0)" ::: "memory"); SBAR(); \
        o[d0] = __builtin_amdgcn_mfma_f32_32x32x16_bf16(pa0, (bf16x8){l0[0], l0[1], l0[2], l0[3], h0[0], h0[1], h0[2], h0[3]}, o[d0], 0, 0, 0);   \
        o[d0] = __builtin_amdgcn_mfma_f32_32x32x16_bf16(pa1, (bf16x8){l1[0], l1[1], l1[2], l1[3], h1[0], h1[1], h1[2], h1[3]}, o[d0], 0, 0, 0);   \
        o[d0] = __builtin_amdgcn_mfma_f32_32x32x16_bf16(pa2, (bf16x8){l2[0], l2[1], l2[2], l2[3], h2[0], h2[1], h2[2], h2[3]}, o[d0], 0, 0, 0);   \
        o[d0] = __builtin_amdgcn_mfma_f32_32x32x16_bf16(pa3, (bf16x8){l3[0], l3[1], l3[2], l3[3], h3[0], h3[1], h3[2], h3[3]}, o[d0], 0, 0, 0); } while (0)
    PV_D0(0); PV_D0(1); PV_D0(2); PV_D0(3);
#undef PV_D0
#undef TRRD
}
struct BlockRef { const bf16_t* Q; const bf16_t* K; const bf16_t* V; bf16_t* O; const unsigned* M; int P0; };
struct MergeArgs { unsigned char* ws; const float* cw; };
struct Seam { bf16x8 qr[8]; bf16x8 st_v0, st_v1, st_k0, st_k1; };
__device__ __forceinline__ int swa_jlo(int P0, int W) { const int lowk = P0 - W + 1; return lowk > 0 ? lowk / KVBLK : 0; }
#define ROW(p, k0, rr) ((p) + (size_t)((k0) + (rr)) * KS + sc)
#define VMW() asm volatile("s_waitcnt vmcnt(0)" ::: "memory")
#define VMWN(n) asm volatile("s_waitcnt vmcnt(%0)" :: "i"(n) : "memory")
#define SLOAD_H(Kp, Vp, k0) do { S.st_v0 = load8(ROW(Vp, k0, sr)); S.st_v1 = load8(ROW(Vp, k0, 32 + sr));              \
                         S.st_k0 = load8(ROW(Kp, k0, sr)); S.st_k1 = load8(ROW(Kp, k0, 32 + sr)); } while (0)
#define SWRITE_HK(bf) do { *(bf16x8*)(K_lds + (bf) * SHM_K + kws) = S.st_k0; *(bf16x8*)(K_lds + (bf) * SHM_K + kws + 32 * 256) = S.st_k1; } while (0)
#define SWRITE_HV(bf) do { *(bf16x8*)(V_lds + (bf) * SHM_V + vst0) = S.st_v0; *(bf16x8*)(V_lds + (bf) * SHM_V + vst1) = S.st_v1; } while (0)
#define SWRITE_H(bf) do { SWRITE_HV(bf); SWRITE_HK(bf); } while (0)
template <int QS, int KS>
__device__ __forceinline__ void attn_prime(const BlockRef& cur, int W, char* lds, Seam& S, const int wid) {
    const int lane = lane_id(), tid = wid * 64 + lane, r32 = lane & 31, hi = lane >> 5;
    const int sr = tid >> 4, sc = (tid & 15) * 8, kws = KSWZ(sr, sc * 2); char* K_lds = lds + 2 * SHM_V;
    const int kb0 = swa_jlo(cur.P0, W) * KVBLK;
#pragma unroll
    for (int d0 = 0; d0 < 8; ++d0) S.qr[d0] = load8(cur.Q + (size_t)(wid * QBLK + r32) * QS + d0 * 16 + hi * 8);
    SLOAD_H(cur.K, cur.V, kb0); VMW(); SWRITE_HK(0);
    __syncthreads();
}
template <int QS, int KS, int OS, bool SEL, int QREG, bool MERGE>
__device__ __forceinline__ void attn_block(const BlockRef& cur, const BlockRef& nxt, int skv, int W, char* lds, Seam& S, const MergeArgs& MG, const int wid) {
    const int lane = lane_id(), tid = wid * 64 + lane, r32 = lane & 31, hi = lane >> 5;
    const int j_lo = swa_jlo(cur.P0, W);
    int j_hi = (cur.P0 + QB - 1) / KVBLK + 1; if (j_hi > skv / KVBLK) j_hi = skv / KVBLK;
    const int NT = j_hi - j_lo;
    const int kbn = swa_jlo(nxt.P0, W) * KVBLK;
    const int qlo = cur.P0 + wid * QBLK, qm = qlo + r32 - 4 * hi;
    char* V_lds = lds; char* K_lds = lds + 2 * SHM_V;
    float* ws = (float*)(lds + 2 * SHM_V + 2 * SHM_K) + wid * 64; float* li_l = ws, * al_l = ws + 32;
    float m_reg = -1e30f, l_reg = 0; f32x16 o[4] = {};
    const int sr = tid >> 4, sc = (tid & 15) * 8, vst0 = v_st(sr, sc), vst1 = v_st(32 + sr, sc), kws = KSWZ(sr, sc * 2);
    const int vb0 = (int)(uintptr_t)V_lds + v_rd_base(lane);
    const bf16_t* Kh = cur.K; const bf16_t* Vh = cur.V;
    const unsigned moff = (unsigned)((wid * QBLK + r32) * 128 + hi);
#define RESC(a) do { if (__any((a) < 1.f)) { if (hi == 0) al_l[r32] = (a); asm volatile("s_waitcnt lgkmcnt(0)" ::: "memory");              \
                     for (int d_ = 0; d_ < 4; ++d_) for (int r = 0; r < 16; ++r) o[d_][r] *= al_l[crow(r, hi)]; } } while (0)
#define KBASE(t) ((j_lo + (t)) * KVBLK)
#define MLOAD(t) (SEL ? cur.M[moff + 2u * (unsigned)(j_lo + (t))] : 0u)
#define MASKT(P0_, P1_, t) do { } while (0)
    constexpr int NQL = 8;
#define SEAM_K0() do { VMWN(NQL); SWRITE_HK(0); SBAR(); } while (0)
    f32x16 pA0, pA1, pB0, pB1; float mnA, mnB, alA, alB; bf16x8 pa0, pa1, pa2, pa3; unsigned mwA = 0u, mwB = 0u;
    const char* qlds = lds + LDS_QOFF + wid * 8192 + lane * 16;
    if (QREG < 8) {
#pragma unroll
        for (int d0 = QREG; d0 < 8; ++d0) *(bf16x8*)(lds + LDS_QOFF + wid * 8192 + lane * 16 + (d0 - QREG) * 1024) = S.qr[d0];
    }
    SWRITE_HV(0); SBAR();
    mwA = MLOAD(0);
    if (NT > 1) { SLOAD_H(Kh, Vh, KBASE(1)); }
    SBAR(); qkt<0, QREG>(pA0, pA1, K_lds, r32, hi, S.qr, qlds);
    MASKT(pA0, pA1, 0); partialSM<SEL>(pA0, pA1, m_reg, mnA, alA, mwA);
    if (NT > 1) { VMW(); SWRITE_H(1); }
    __syncthreads();
#define HALF_STEP(PX0, PX1, mnX, alX, mwX, PY0, PY1, alY, mwY, t, KB, VB, SB) do {                                            \
        SBAR(); qkt<KB, QREG>(PX0, PX1, K_lds, r32, hi, S.qr, qlds);                                                                     \
        finishSM<SEL>(PY0, PY1, alY, l_reg, pa0, pa1, pa2, pa3, mwY); SBAR();                                                 \
        mwX = MLOAD(t);                                                                                                       \
        if ((t) + 1 < NT) { SLOAD_H(Kh, Vh, KBASE((t) + 1)); SBAR(); }                                                        \
        pv_tile<VB>(o, vb0, pa0, pa1, pa2, pa3); MASKT(PX0, PX1, (t)); partialSM<SEL>(PX0, PX1, m_reg, mnX, alX, mwX);        \
        __syncthreads();                                                                                                      \
        if ((t) + 1 < NT) { VMW(); SWRITE_H(SB); }                                                                            \
        RESC(alX); __syncthreads(); } while (0)
    for (int t = 1; t + 1 < NT; t += 2) {
        HALF_STEP(pB0, pB1, mnB, alB, mwB, pA0, pA1, alA, mwA, t, 1, 0, 0);
        HALF_STEP(pA0, pA1, mnA, alA, mwA, pB0, pB1, alB, mwB, t + 1, 0, 1, 1);
    }
    const bool even = (NT & 1) == 0;
    if (even) { SBAR(); mwB = MLOAD(NT - 1); qkt<1, QREG>(pB0, pB1, K_lds, r32, hi, S.qr, qlds); SBAR(); }
    SLOAD_H(nxt.K, nxt.V, kbn); SBAR();
#pragma unroll
    for (int d0 = 0; d0 < 8; ++d0) S.qr[d0] = load8(nxt.Q + (size_t)(wid * QBLK + r32) * QS + d0 * 16 + hi * 8);
    SBAR();
    finishSM<SEL>(pA0, pA1, alA, l_reg, pa0, pa1, pa2, pa3, mwA); SBAR();
    pv_tile<0>(o, vb0, pa0, pa1, pa2, pa3);
    if (even) { MASKT(pB0, pB1, NT - 1); partialSM<SEL>(pB0, pB1, m_reg, mnB, alB, mwB); __syncthreads(); RESC(alB);
        finishSM<SEL>(pB0, pB1, alB, l_reg, pa0, pa1, pa2, pa3, mwB); SBAR(); pv_tile<1>(o, vb0, pa0, pa1, pa2, pa3); }
    SBAR(); SEAM_K0();
    if (hi == 0) li_l[r32] = l_reg; asm volatile("s_waitcnt lgkmcnt(0)" ::: "memory");
    float rli[16];
#pragma unroll
    for (int r = 0; r < 16; ++r) rli[r] = __builtin_amdgcn_rcpf(li_l[crow(r, hi)]);
    {
        char* stg = lds + LDS_QOFF + wid * 8192;
#pragma unroll
        for (int r = 0; r < 16; ++r) { const int orow = crow(r, hi);
#pragma unroll
            for (int d0 = 0; d0 < 4; ++d0) { const float v = o[d0][r] * rli[r];
                const float vn = __shfl_xor(v, 1);
                if ((r32 & 1) == 0) *(unsigned*)(stg + orow * 256 + (d0 * 32 + r32) * 2) = cvt_pk_bf16(v, vn); } }
        asm volatile("s_waitcnt lgkmcnt(0)" ::: "memory");
        const int ch = lane & 15, rq = lane >> 4;
        if (!MERGE) {
            bf16_t* Ow = cur.O + (size_t)(wid * QBLK) * OS + ch * 8;
#pragma unroll
            for (int p = 0; p < 8; ++p) { const int row = 4 * p + rq; *(u32x4*)(Ow + (size_t)row * OS) = *(const u32x4*)(stg + row * 256 + ch * 16); }
        } else {
            const bf16_t* Obase = (const bf16_t*)(MG.ws + WS_YATT); const bf16_t* MA = (const bf16_t*)(MG.ws + WS_ABUF); const bf16_t* MP = (const bf16_t*)(MG.ws + WS_PBUF);
            const bf16_t* MGA = (const bf16_t*)(MG.ws + WS_GABUF); bf16_t* MOUT = (bf16_t*)(MG.ws + WS_MERGED);
            const size_t eoff = (size_t)(cur.O - Obase) + (size_t)(wid * QBLK) * OS + ch * 8;
            const int colg = (int)((cur.O - Obase) % OS) + ch * 8;
            float w0[8], w1[8], w2[8];
#pragma unroll
            for (int j = 0; j < 8; ++j) { w0[j] = MG.cw[colg + j]; w1[j] = MG.cw[OS + colg + j]; w2[j] = MG.cw[2 * OS + colg + j]; }
            u32x4 ca, cga, cp2, cp1, cp0, na, nga, np2, np1, np0;
#define MG_LOAD(p_, A_, GA_, P2_, P1_, P0_) do { const int row_ = 4 * (p_) + rq, spos_ = cur.P0 + wid * QBLK + row_; const size_t e_ = eoff + (size_t)row_ * OS; \
                A_ = *(const u32x4*)(MA + e_); GA_ = *(const u32x4*)(MGA + e_); P2_ = *(const u32x4*)(MP + e_); \
                P1_ = (u32x4){0u, 0u, 0u, 0u}; P0_ = (u32x4){0u, 0u, 0u, 0u}; \
                if (spos_ >= 1) P1_ = *(const u32x4*)(MP + e_ - OS); if (spos_ >= 2) P0_ = *(const u32x4*)(MP + e_ - 2 * OS); } while (0)
            MG_LOAD(0, ca, cga, cp2, cp1, cp0);
#pragma unroll 1
            for (int p = 0; p < 8; ++p) {
                const int row = 4 * p + rq;
                const size_t e = eoff + (size_t)row * OS;
                const u32x4 y = *(const u32x4*)(stg + row * 256 + ch * 16);
                if (p < 7) MG_LOAD(p + 1, na, nga, np2, np1, np0);
                float ov[8];
#pragma unroll
                for (int j = 0; j < 4; ++j) {
                    ov[2 * j] = bf_lo(ca[j]) * (w0[2 * j] * bf_lo(cp0[j]) + w1[2 * j] * bf_lo(cp1[j]) + w2[2 * j] * bf_lo(cp2[j])) + bf_lo(cga[j]) * bf_lo(y[j]);
                    ov[2 * j + 1] = bf_hi(ca[j]) * (w0[2 * j + 1] * bf_hi(cp0[j]) + w1[2 * j + 1] * bf_hi(cp1[j]) + w2[2 * j + 1] * bf_hi(cp2[j])) + bf_hi(cga[j]) * bf_hi(y[j]);
                }
                u32x4 wv_; wv_.x = cvt_pk_bf16(ov[0], ov[1]); wv_.y = cvt_pk_bf16(ov[2], ov[3]); wv_.z = cvt_pk_bf16(ov[4], ov[5]); wv_.w = cvt_pk_bf16(ov[6], ov[7]);
                *(u32x4*)(MOUT + e) = wv_;
                ca = na; cga = nga; cp2 = np2; cp1 = np1; cp0 = np0;
            }
#undef MG_LOAD
        }
    }
    __syncthreads();
#undef RESC
#undef KBASE
#undef MLOAD
#undef MASKT
#undef SEAM_K0
#undef HALF_STEP
}
#undef ROW
#undef VMW
#undef VMWN
#undef SLOAD_H
#undef SWRITE_HK
#undef SWRITE_HV
#undef SWRITE_H

enum { ORDER_NATURAL = 0, ORDER_PAIRED = 2, ORDER_XCD = 4, ORDER_LPT = 8 };
struct AttnItem { int bh, qb0, qb1; };
__device__ __forceinline__ AttnItem attn_decode(int L, int nb, int nh, int nhkv, int nqb, int nx, int order) {
    const int G = nh / nhkv; AttnItem it; int x;
    if ((order & ORDER_XCD) && (nb * nhkv) % 8 == 0) { const int xcd = L & 7, k = L >> 3, per = G * nx, gi = k / per, r = k - gi * per;
        it.bh = (gi * 8 + xcd) * G + r / nx; x = r % nx; }
    else { it.bh = L / nx; x = L - it.bh * nx; }
    if (order & ORDER_PAIRED) { it.qb0 = x; it.qb1 = nqb - 1 - x; }
    else { it.qb0 = it.qb1 = x; }
    return it;
}
struct AttnTensors { const bf16_t* Q; const bf16_t* K; const bf16_t* V; bf16_t* O; const unsigned* M; };
template <int QS, int KS, int OS>
__device__ __forceinline__ BlockRef attn_ref(const AttnItem& it, int pass, const AttnTensors& X, int nh, int nhkv, int sq, int skv, int p0base) {
    const int qb = pass ? it.qb1 : it.qb0, b = it.bh / nh, h = it.bh - b * nh, kvh = h / (nh / nhkv);
    BlockRef r; const size_t t0 = (size_t)b * sq + (size_t)qb * QB;
    r.Q = X.Q + t0 * QS + h * D; r.O = X.O + t0 * OS + h * D;
    r.K = X.K + (size_t)b * skv * KS + kvh * D; r.V = X.V + (size_t)b * skv * KS + kvh * D;
    r.M = X.M ? X.M + t0 * 128 : nullptr; r.P0 = p0base + qb * QB;
    return r;
}
__device__ __forceinline__ int attn_kmax(int stride, int order, int nb, int nh, int nhkv, int nqb, int nx) {
    if (order & ORDER_LPT) { const int G = nh / nhkv, rg = (G * nqb + stride - 1) / stride; return rg * (nb * nhkv / 8); }
    return (nx * nb * nh + stride - 1) / stride;
}
__device__ __forceinline__ bool attn_item_at(int k, int first, int stride, int order, int nb, int nh, int nhkv, int nqb, int nx, AttnItem& it) {
    if (order & ORDER_LPT) {
        const int x = first & 7, slot = first >> 3, G = nh / nhkv, nblk = G * nqb, rg = (nblk + stride - 1) / stride;
        const int gi = k / rg, kk = k - gi * rg, sl = (gi & 1) ? stride - 1 - slot : slot;
        const int pos = (kk & 1) ? stride - 1 - sl : sl, s = kk * stride + pos;
        if (s >= nblk) return false;
        it.bh = (gi * 8 + x) * G + (s % G); it.qb0 = it.qb1 = nqb - 1 - s / G; return true;
    }
    const int L = first + k * stride; if (L >= nx * nb * nh) return false;
    it = attn_decode(L, nb, nh, nhkv, nqb, nx, order); return true;
}
template <int QS, int KS, int OS, bool SEL, int QREG, bool MERGE>
__device__ __forceinline__ void attn_phase(char* lds, const AttnTensors& X, const MergeArgs& MG, int nb, int nh, int nhkv, int sq, int skv, int p0base, int order, int stride, int first, const int wid) {
    const int W = 1 << 30;
    const int nqb = sq / QB, nx = (order & ORDER_PAIRED) ? nqb / 2 : nqb;
    AttnItem it; int k = 0, pass = 0; const int kmax = attn_kmax(stride, order, nb, nh, nhkv, nqb, nx);
    while (k < kmax && !attn_item_at(k, first, stride, order, nb, nh, nhkv, nqb, nx, it)) ++k;
    if (k >= kmax) return;
    BlockRef cur = attn_ref<QS, KS, OS>(it, 0, X, nh, nhkv, sq, skv, p0base);
    Seam S;
    attn_prime<QS, KS>(cur, W, lds, S, wid);
    for (;;) {
        const bool more_pass = pass == 0 && it.qb1 != it.qb0;
        AttnItem itn = it; int passn = pass + 1, kn = k; bool last = false;
        if (!more_pass) { passn = 0; kn = k + 1; while (kn < kmax && !attn_item_at(kn, first, stride, order, nb, nh, nhkv, nqb, nx, itn)) ++kn; if (kn >= kmax) { last = true; itn = it; kn = k; } }
        const BlockRef nxt = last ? cur : attn_ref<QS, KS, OS>(itn, passn, X, nh, nhkv, sq, skv, p0base);
        attn_block<QS, KS, OS, SEL, QREG, MERGE>(cur, nxt, skv, W, lds, S, MG, wid);
        if (last) break;
        cur = nxt; it = itn; pass = passn; k = kn;
    }
    asm volatile("s_waitcnt vmcnt(0)" ::: "memory");
    __syncthreads();
}
}


namespace ix {
constexpr int KCH = 256;
constexpr int BUFB = KCH * 128;
template <int CTRL> __device__ __forceinline__ int dpp_mov(int v) { return __builtin_amdgcn_update_dpp(0, v, CTRL, 0xF, 0xF, true); }
__device__ __forceinline__ int half_sum(int v) {
    v += dpp_mov<0xB1>(v); v += dpp_mov<0x4E>(v); v += dpp_mov<0x141>(v); v += dpp_mov<0x140>(v);
    return v + __shfl_xor(v, 16);
}
__device__ __forceinline__ float half_min(float v) {
    v = fminf(v, __int_as_float(dpp_mov<0xB1>(__float_as_int(v)))); v = fminf(v, __int_as_float(dpp_mov<0x4E>(__float_as_int(v))));
    v = fminf(v, __int_as_float(dpp_mov<0x141>(__float_as_int(v)))); v = fminf(v, __int_as_float(dpp_mov<0x140>(__float_as_int(v))));
    return fminf(v, __shfl_xor(v, 16));
}
__device__ __forceinline__ float half_max(float v) {
    v = fmaxf(v, __int_as_float(dpp_mov<0xB1>(__float_as_int(v)))); v = fmaxf(v, __int_as_float(dpp_mov<0x4E>(__float_as_int(v))));
    v = fmaxf(v, __int_as_float(dpp_mov<0x141>(__float_as_int(v)))); v = fmaxf(v, __int_as_float(dpp_mov<0x140>(__float_as_int(v))));
    return fmaxf(v, __shfl_xor(v, 16));
}
__device__ __forceinline__ int excl_scan64(int v, int lane, int& total) {
    int s = v;
#pragma unroll
    for (int o = 1; o <= 32; o <<= 1) { const int t = __shfl_up(s, o); s += (lane >= o) ? t : 0; }
    total = __shfl(s, 63);
    return s - v;
}
__device__ __forceinline__ void tie_fix(unsigned& ge0, unsigned& ge1, unsigned gt0, unsigned gt1, int need, int lane) {
    unsigned eq0 = ge0 & ~gt0, eq1 = ge1 & ~gt1;
    const int c0 = __popc(eq0), c1 = __popc(eq1);
    int tot0, tot1; const int pre0 = excl_scan64(c0, lane, tot0); const int pre1 = tot0 + excl_scan64(c1, lane, tot1);
    int t0 = need - pre0; t0 = t0 < 0 ? 0 : (t0 > c0 ? c0 : t0);
    int t1 = need - pre1; t1 = t1 < 0 ? 0 : (t1 > c1 ? c1 : t1);
    while (__popc(eq0) > t0) eq0 &= ~(0x80000000u >> __clz(eq0));
    while (__popc(eq1) > t1) eq1 &= ~(0x80000000u >> __clz(eq1));
    ge0 = gt0 | eq0; ge1 = gt1 | eq1;
}
__device__ __forceinline__ unsigned nib16(unsigned w, int hi) {
    unsigned x = (w >> (4 * hi)) & 0x0F0F0F0Fu; x = (x | (x >> 4)) & 0x00FF00FFu; x = (x | (x >> 8)) & 0xFFFFu; return x;
}
__device__ __forceinline__ void store_row(unsigned* row, unsigned g0, unsigned g1, int lane) {
    const int hi = lane & 1, e = lane & ~1;
    const unsigned a0 = __shfl(g0, e), b0 = __shfl(g0, e + 1), a1 = __shfl(g1, e), b1 = __shfl(g1, e + 1);
    row[lane] = nib16(a0, hi) | (nib16(b0, hi) << 16);
    row[64 + lane] = nib16(a1, hi) | (nib16(b1, hi) << 16);
}
constexpr int LDS_SIDE = 65536;
__device__ __forceinline__ void indexer_phase(const Frame& F, const bf16_t* QI, const bf16_t* KI, const float* WI, unsigned* MASK, const pg8::SideConv& SD) {
    const int tid = F.tid_(), lane = F.lane_(), w = F.wave, r = lane & 31, hi = lane >> 5;
    LAS unsigned char* lds = F.lds;
    const float NEG = -__builtin_inff();
    int sq = 0, spar = 0; bool pend0 = false, pend1 = false; size_t pd0 = 0, pd1 = 0;
    for (int rnd = 0; rnd < 4; ++rnd) {
        const int p = (rnd & 1) ? (F.G - 1 - F.bid) : F.bid; const int sidx = rnd * F.G + p;
        if (sidx >= NB * (SEQ / 16)) continue;
        const int qg = (SEQ / 16 - 1) - (sidx >> 2), b = sidx & 3;
        const int q0 = qg * 16, nkeys = q0 + 16, nkt = (nkeys + 31) >> 5, nch = (nkeys + KCH - 1) / KCH;
        const size_t tb = (size_t)b * SEQ;
        const int tq = q0 + 2 * w + hi;
        bf16x8 afr[4];
        { const int qsel = (r >> 2) & 1, head = (r & 3) + 4 * (r >> 3);
          const bf16_t* qp = QI + (tb + q0 + 2 * w + qsel) * 1024 + head * 64 + 8 * hi;
#pragma unroll
          for (int s = 0; s < 4; ++s) afr[s] = *(const bf16x8*)(qp + 16 * s); }
        f32x4 wv[4];
#pragma unroll
        for (int i = 0; i < 4; ++i) wv[i] = *(const f32x4*)(WI + (tb + tq) * 16 + 4 * i);
        float sc[128];
#pragma unroll
        for (int i = 0; i < 128; ++i) sc[i] = NEG;
        const int skey = 8 * w + (lane >> 3), ssl = lane & 7;
        const bf16_t* ksrc = KI + (tb + skey) * 64 + ((ssl ^ ((skey >> 1) & 7)) * 8);
#define IX_STAGE(chunk, buf) do { _Pragma("unroll") for (int i = 0; i < 4; ++i) \
            __builtin_amdgcn_global_load_lds((const unsigned*)(ksrc + ((size_t)(chunk) * KCH + 64 * i) * 64), (LAS unsigned*)(lds + (buf) * BUFB + (64 * i + 8 * w) * 128), 16, 0, 0); } while (0)
        for (int rep22 = 0; rep22 < (REP_PHASE == 22 ? 2 : 1); ++rep22) {
        IX_STAGE(0, 0);
        asm volatile("s_waitcnt vmcnt(0)" ::: "memory");
        __syncthreads();
        int boff[4];
#pragma unroll
        for (int s = 0; s < 4; ++s) boff[s] = r * 128 + (((2 * s + hi) ^ ((r >> 1) & 7)) * 16);
        for (int c = 0; c < nch; ++c) {
            const bool more = (c + 1 < nch);
            if (more) IX_STAGE(c + 1, (c + 1) & 1);
            {   LAS unsigned char* told = lds + LDS_SIDE + (spar ^ 1) * 2 * 16640; LAS unsigned char* tnew = lds + LDS_SIDE + spar * 2 * 16640;
                if (pend0) SD.consume(told, pd0, w, lane);
                if (pend1) SD.consume(told + 16640, pd1, w, lane);
                const int ja = SD.j0 + sq * SD.G + SD.c, jb = ja + SD.G;
                pend0 = ja < SD.jn; pend1 = jb < SD.jn;
                if (pend0) { pd0 = SD.issue(ja, tnew, w, lane); ++sq; }
                if (pend1) { pd1 = SD.issue(jb, tnew + 16640, w, lane); ++sq; }
                spar ^= 1; }
            LAS unsigned char* kb = lds + (c & 1) * BUFB;
#pragma unroll
            for (int g = 0; g < 2; ++g) {
                float s4[4] = {NEG, NEG, NEG, NEG};
                if (c * 8 + g * 4 < nkt) {
#pragma unroll
                    for (int p2 = 0; p2 < 2; ++p2) {
                        const int k0 = g * 4 + 2 * p2, kt0 = c * 8 + k0;
                        f32x16 a0 = {}, a1 = {};
#pragma unroll
                        for (int s = 0; s < 4; ++s) {
                            const bf16x8 b0 = *(const LAS bf16x8*)(kb + k0 * 4096 + boff[s]), b1 = *(const LAS bf16x8*)(kb + (k0 + 1) * 4096 + boff[s]);
                            a0 = __builtin_amdgcn_mfma_f32_32x32x16_bf16(afr[s], b0, a0, 0, 0, 0); a1 = __builtin_amdgcn_mfma_f32_32x32x16_bf16(afr[s], b1, a1, 0, 0, 0); }
#define IX_RELU(x) __int_as_float(max(__float_as_int(x), 0))
                        f32x2 q0 = {0.f, 0.f}, q1 = {0.f, 0.f};
#pragma unroll
                        for (int h = 0; h < 16; h += 2) {
                            const f32x2 ww = {wv[h >> 2][h & 3], wv[h >> 2][(h & 3) + 1]};
                            const f32x2 r0 = {IX_RELU(a0[h]), IX_RELU(a0[h + 1])};
                            const f32x2 r1 = {IX_RELU(a1[h]), IX_RELU(a1[h + 1])};
                            q0 = ww * r0 + q0; q1 = ww * r1 + q1; }
                        s4[2 * p2] = (kt0 * 32 + r <= tq) ? (q0[0] + q0[1]) : NEG;
                        s4[2 * p2 + 1] = ((kt0 + 1) * 32 + r <= tq) ? (q1[0] + q1[1]) : NEG;
#undef IX_RELU
                    }
                }
#define IX_INS(cc) case cc: _Pragma("unroll") for (int k = 0; k < 4; ++k) sc[(cc) * 4 + k] = s4[k]; break;
                switch (c * 2 + g) { IX_INS(0) IX_INS(1) IX_INS(2) IX_INS(3) IX_INS(4) IX_INS(5) IX_INS(6) IX_INS(7) IX_INS(8) IX_INS(9) IX_INS(10) IX_INS(11) IX_INS(12) IX_INS(13) IX_INS(14) IX_INS(15)
                                     IX_INS(16) IX_INS(17) IX_INS(18) IX_INS(19) IX_INS(20) IX_INS(21) IX_INS(22) IX_INS(23) IX_INS(24) IX_INS(25) IX_INS(26) IX_INS(27) IX_INS(28) IX_INS(29) IX_INS(30) IX_INS(31) default: break; }
#undef IX_INS
            }
            asm volatile("s_waitcnt vmcnt(0)" ::: "memory");
            __syncthreads();
        }
        }
#undef IX_STAGE
        float tau = -3.0e38f; int tiemode = 0, need = 0;
        for (int rep20 = 0; rep20 < (REP_PHASE == 20 ? 2 : 1); ++rep20) {
            tiemode = 0; need = 0;
            float lo = 0.f, hiv = 0.f; int done = (tq + 1 <= TOPK) ? 1 : 0;
            if (!done) {
                float mn = __builtin_inff(), mx = NEG;
#pragma unroll
                for (int c = 0; c < 16; ++c) if (c < nch) {
#pragma unroll
                    for (int k = 0; k < 8; ++k) { const float v = sc[c * 8 + k]; mx = fmaxf(mx, v); mn = fminf(mn, (v == NEG) ? __builtin_inff() : v); } }
                lo = half_min(mn); mx = half_max(mx);
                hiv = mx + fabsf(mx) * 1e-6f + 1e-30f;
            }
            for (int it = 0; it < 64 && __any(!done); ++it) {
                const unsigned ul = __float_as_uint(lo), uh = __float_as_uint(hiv);
                const unsigned kl = (ul & 0x80000000u) ? ~ul : (ul | 0x80000000u), kh = (uh & 0x80000000u) ? ~uh : (uh | 0x80000000u);
                const bool adj = (kh - kl) <= 1u;
                const unsigned km = kl + ((kh - kl) >> 1);
                const float kmid = __uint_as_float((km & 0x80000000u) ? (km ^ 0x80000000u) : ~km);
                const float fmid = 0.5f * (lo + hiv);
                const float mid = (it < 24 && fmid > lo && fmid < hiv) ? fmid : kmid;
                const float piv = adj ? hiv : mid;
                int cnt = 0;
#pragma unroll
                for (int c = 0; c < 16; ++c) if (c < nch) {
#pragma unroll
                    for (int k = 0; k < 8; ++k) cnt += (sc[c * 8 + k] >= piv) ? 1 : 0; }
                cnt = half_sum(cnt);
                if (!done) {
                    if (adj) { tau = lo; tiemode = 1; need = TOPK - cnt; done = 1; }
                    else if (cnt == TOPK) { tau = mid; done = 1; }
                    else if (cnt > TOPK) lo = mid; else hiv = mid;
                }
            }
        }
        unsigned wA0 = 0u, wA1 = 0u, wB0 = 0u, wB1 = 0u;
#define IX_BAL(RA, RB, KT, LN, OP) { const unsigned long long bl_ = __ballot(sc[KT] OP tau); \
            asm volatile("s_nop 1\n\tv_writelane_b32 %0, %2, %4\n\tv_writelane_b32 %1, %3, %4" : "+v"(RA), "+v"(RB) : "s"((unsigned)bl_), "s"((unsigned)(bl_ >> 32)), "n"(LN)); }
#define IX_REP8(M, RA, RB, b, o, OP) M(RA, RB, (b) + 0, (b) - (o) + 0, OP) M(RA, RB, (b) + 1, (b) - (o) + 1, OP) M(RA, RB, (b) + 2, (b) - (o) + 2, OP) M(RA, RB, (b) + 3, (b) - (o) + 3, OP) \
                                     M(RA, RB, (b) + 4, (b) - (o) + 4, OP) M(RA, RB, (b) + 5, (b) - (o) + 5, OP) M(RA, RB, (b) + 6, (b) - (o) + 6, OP) M(RA, RB, (b) + 7, (b) - (o) + 7, OP)
#define IX_REP64(M, RA, RB, b, OP) IX_REP8(M, RA, RB, (b) + 0, b, OP) IX_REP8(M, RA, RB, (b) + 8, b, OP) IX_REP8(M, RA, RB, (b) + 16, b, OP) IX_REP8(M, RA, RB, (b) + 24, b, OP) \
                                   IX_REP8(M, RA, RB, (b) + 32, b, OP) IX_REP8(M, RA, RB, (b) + 40, b, OP) IX_REP8(M, RA, RB, (b) + 48, b, OP) IX_REP8(M, RA, RB, (b) + 56, b, OP)
        IX_REP64(IX_BAL, wA0, wB0, 0, >=)
        IX_REP64(IX_BAL, wA1, wB1, 64, >=)
        if (__any(tiemode)) {
            unsigned gA0 = 0u, gA1 = 0u, gB0 = 0u, gB1 = 0u;
            IX_REP64(IX_BAL, gA0, gB0, 0, >)
            IX_REP64(IX_BAL, gA1, gB1, 64, >)
            const int tieA = __builtin_amdgcn_readlane(tiemode, 0), tieB = __builtin_amdgcn_readlane(tiemode, 32);
            const int needA = __builtin_amdgcn_readlane(need, 0), needB = __builtin_amdgcn_readlane(need, 32);
            if (tieA) tie_fix(wA0, wA1, gA0, gA1, needA, lane);
            if (tieB) tie_fix(wB0, wB1, gB0, gB1, needB, lane);
        }
        unsigned* ra = MASK + (tb + q0 + 2 * w) * 128;
        store_row(ra, wA0, wA1, lane);
        store_row(ra + 128, wB0, wB1, lane);
#undef IX_BAL
#undef IX_REP8
#undef IX_REP64
        __syncthreads();
    }
    {   LAS unsigned char* told = lds + LDS_SIDE + (spar ^ 1) * 2 * 16640;
        if (pend0) SD.consume(told, pd0, w, lane);
        if (pend1) SD.consume(told + 16640, pd1, w, lane); }
    SD.leftover(sq, w, lane);
}
}


#ifdef PROBE_MASK
__device__ __forceinline__ void probe_mask_check(const Frame& F) {
    const unsigned* MASK = F.W<unsigned>(WS_MASK); unsigned* flag = F.W<unsigned>(WS_CTL + CTL_CNT + 1024);
    for (int t = F.bid * 8 + F.wave; t < T; t += F.G * 8) {
        const int s = t & (SEQ - 1);
        int cnt = 0, bad = 0;
#pragma unroll
        for (int i = 0; i < 2; ++i) {
            const int o = i * 64 + F.lane_(); const unsigned w = MASK[(size_t)t * 128 + o];
            cnt += __popc(w);
            const int tile = o >> 1, hi = o & 1;
#pragma unroll
            for (int b = 0; b < 32; ++b) if ((w >> b) & 1u) { const int r = b & 15; const int key = tile * 64 + (b >> 4) * 32 + (r & 3) + 8 * (r >> 2) + 4 * hi; if (key > s) bad = 1; }
        }
        cnt = (int)wave_sum((float)cnt);
        const int want = (s + 1 < TOPK) ? s + 1 : TOPK;
        if (cnt != want) bad = 1;
        if (__any(bad) && F.lane_() == 0) atomicAdd(flag, 1u);
    }
}
#endif
__device__ __forceinline__ void p4_merge(const Frame& F) {
    const bf16_t* A = F.W<bf16_t>(WS_ABUF); const bf16_t* P = F.W<bf16_t>(WS_PBUF); const bf16_t* GA = F.W<bf16_t>(WS_GABUF); const bf16_t* Y = F.W<bf16_t>(WS_YATT);
    bf16_t* M = F.W<bf16_t>(WS_MERGED); const float* cw = F.I<float>(IN_CONV_W);
    for (int r = F.bid * 2 + (F.tid_() >> 8); r < T; r += F.G * 2) {
        const int c = (F.tid_() & 255) * 8, s = r & (SEQ - 1);
        const u32x4 a = *(const u32x4*)(A + (size_t)r * DM + c), p2 = *(const u32x4*)(P + (size_t)r * DM + c);
        u32x4 p1 = (u32x4){0u, 0u, 0u, 0u}, p0 = (u32x4){0u, 0u, 0u, 0u};
        if (s >= 1) p1 = *(const u32x4*)(P + (size_t)(r - 1) * DM + c);
        if (s >= 2) p0 = *(const u32x4*)(P + (size_t)(r - 2) * DM + c);
#if MILESTONE >= 4
        const u32x4 ga = *(const u32x4*)(GA + (size_t)r * DM + c), y = *(const u32x4*)(Y + (size_t)r * DM + c);
#else
        const u32x4 ga = (u32x4){0u, 0u, 0u, 0u}, y = (u32x4){0u, 0u, 0u, 0u}; (void)GA; (void)Y;
#endif
        float o[8];
#pragma unroll
        for (int j = 0; j < 4; ++j) {
            const float w0l = cw[c + 2 * j], w1l = cw[DM + c + 2 * j], w2l = cw[2 * DM + c + 2 * j];
            const float w0h = cw[c + 2 * j + 1], w1h = cw[DM + c + 2 * j + 1], w2h = cw[2 * DM + c + 2 * j + 1];
            o[2 * j] = bf_lo(a[j]) * (w0l * bf_lo(p0[j]) + w1l * bf_lo(p1[j]) + w2l * bf_lo(p2[j])) + bf_lo(ga[j]) * bf_lo(y[j]);
            o[2 * j + 1] = bf_hi(a[j]) * (w0h * bf_hi(p0[j]) + w1h * bf_hi(p1[j]) + w2h * bf_hi(p2[j])) + bf_hi(ga[j]) * bf_hi(y[j]);
        }
        u32x4 w; w.x = cvt_pk_bf16(o[0], o[1]); w.y = cvt_pk_bf16(o[2], o[3]); w.z = cvt_pk_bf16(o[4], o[5]); w.w = cvt_pk_bf16(o[6], o[7]);
        *(u32x4*)(M + (size_t)r * DM + c) = w;
    }
}


__device__ __forceinline__ void p9_route(const Frame& F, const bf16_t* h) {
    const float* wrt = F.W<float>(WS_WRT); const float* br = F.I<float>(IN_B_ROUTER);
    unsigned* cnt = F.W<unsigned>(WS_CTL + CTL_CNT);
    int* slot_e = F.W<int>(WS_SLOTE); int* slot_r = F.W<int>(WS_SLOTR); float* slot_g = F.W<float>(WS_SLOTG); float* rs2o = F.W<float>(WS_RS2);
    LAS float* part = (LAS float*)F.lds;
    LAS float* ssp = (LAS float*)(F.lds + 16384);
    const int lane = F.lane_(), w = F.wave, tg = w & 3, kh = w >> 2, tok = lane & 15, kq = lane >> 4;
    for (int u = F.bid; u < T / 64; u += F.G) {
        const int t0 = u * 64 + tg * 16;
        const bf16_t* hp = h + (size_t)(t0 + tok) * DM + kh * 1024 + 4 * kq;
        const float* w0 = wrt + (size_t)tok * DM + kh * 1024 + 4 * kq;
        const float* w1 = w0 + (size_t)16 * DM;
        f32x4 acc0 = (f32x4){0.f, 0.f, 0.f, 0.f}, acc1 = (f32x4){0.f, 0.f, 0.f, 0.f}; float ss = 0.f;
#pragma unroll 4
        for (int s = 0; s < 64; ++s) {
            const u32x2 ab = *(const u32x2*)(hp + 16 * s); const f32x4 a = (f32x4){bf_lo(ab.x), bf_hi(ab.x), bf_lo(ab.y), bf_hi(ab.y)};
            const f32x4 b0 = *(const f32x4*)(w0 + 16 * s), b1 = *(const f32x4*)(w1 + 16 * s);
            ss += a[0] * a[0] + a[1] * a[1] + a[2] * a[2] + a[3] * a[3];
#pragma unroll
            for (int j = 0; j < 4; ++j) { acc0 = __builtin_amdgcn_mfma_f32_16x16x4f32(a[j], b0[j], acc0, 0, 0, 0); acc1 = __builtin_amdgcn_mfma_f32_16x16x4f32(a[j], b1[j], acc1, 0, 0, 0); }
        }
        ss += __shfl_xor(ss, 16); ss += __shfl_xor(ss, 32);
        if (kq == 0) ssp[kh * 64 + tg * 16 + tok] = ss;
#pragma unroll
        for (int i = 0; i < 4; ++i) { part[(kh * 64 + tg * 16 + 4 * kq + i) * 32 + tok] = acc0[i]; part[(kh * 64 + tg * 16 + 4 * kq + i) * 32 + 16 + tok] = acc1[i]; }
        __syncthreads();
        if (F.tid_() < 64) {
            const int t = u * 64 + F.tid_();
            const float rs = __builtin_amdgcn_rsqf((ssp[F.tid_()] + ssp[64 + F.tid_()]) * (1.0f / DM) + NORM_EPS);
            float lg[32];
#pragma unroll
            for (int e = 0; e < 32; ++e) lg[e] = (part[F.tid_() * 32 + e] + part[(64 + F.tid_()) * 32 + e]) * rs + br[e];
            unsigned chosen = 0u; float tv[4]; int ti[4];
#pragma unroll
            for (int p = 0; p < 4; ++p) {
                float best = -__builtin_inff(); int bi = 0;
#pragma unroll
                for (int e = 0; e < 32; ++e) { const bool ok = !((chosen >> e) & 1u) && (lg[e] > best); best = ok ? lg[e] : best; bi = ok ? e : bi; }
                chosen |= 1u << bi; tv[p] = best; ti[p] = bi;
            }
            const float e1 = __expf(tv[1] - tv[0]), e2 = __expf(tv[2] - tv[0]), e3 = __expf(tv[3] - tv[0]);
            const float inv = 1.0f / (1.0f + e1 + e2 + e3);
            const float gt[4] = {inv, e1 * inv, e2 * inv, e3 * inv};
            rs2o[t] = rs;
#pragma unroll
            for (int p = 0; p < 4; ++p) {
                const unsigned rk = atomicAdd(cnt + ti[p], 1u);
                slot_e[t * 4 + p] = ti[p]; slot_r[t * 4 + p] = (int)rk; slot_g[t * 4 + p] = gt[p];
            }
        }
        __syncthreads();
    }
}

__device__ __forceinline__ void p10_gather(const Frame& F, const bf16_t* hb) {
    LAS int* off = (LAS int*)F.lds;
    const unsigned* cnt = F.W<unsigned>(WS_CTL + CTL_CNT);
    int* tile_e = F.W<int>(WS_TILEE);
    if (F.tid_() == 0) { int o = 0; for (int e = 0; e < NEXP; ++e) { off[e] = o; o += ((int)cnt[e] + 255) & ~255; } off[NEXP] = o; }
    __syncthreads();
    if (F.bid == 0) {
        const int nmt = off[NEXP] >> 8;
        for (int m = F.tid_(); m < nmt; m += 512) { int e = 0; for (int q = 1; q < NEXP; ++q) e = (off[q] <= m * 256) ? q : e; tile_e[m] = e; }
        if (F.tid_() == 0) tile_e[511] = nmt;
    }
    const int* slot_e = F.W<int>(WS_SLOTE); const int* slot_r = F.W<int>(WS_SLOTR); const float* slot_g = F.W<float>(WS_SLOTG); const float* rs2 = F.W<float>(WS_RS2);
    int* pos = F.W<int>(WS_POS); float* rss = F.W<float>(WS_RSS); float* gws = F.W<float>(WS_GWS); unsigned char* as = F.W<unsigned char>(WS_ASORT); const float* gffn = F.I<float>(IN_NORM_FFN);
    for (int t = F.bid * 8 + F.wave; t < T; t += F.G * 8) {
        u32x2 v[4];
#pragma unroll
        for (int i = 0; i < 4; ++i) { const int c = (i * 64 + F.lane_()) * 8;
            const u32x4 hv = *(const u32x4*)(hb + (size_t)t * DM + c); const f32x4 g0 = *(const f32x4*)(gffn + c), g1 = *(const f32x4*)(gffn + c + 4);
            v[i] = pack_fp8x8(bf_lo(hv.x) * g0[0], bf_hi(hv.x) * g0[1], bf_lo(hv.y) * g0[2], bf_hi(hv.y) * g0[3], bf_lo(hv.z) * g1[0], bf_hi(hv.z) * g1[1], bf_lo(hv.w) * g1[2], bf_hi(hv.w) * g1[3]); }
        const float rs = rs2[t];
        const u32x4 se = *(const u32x4*)(slot_e + t * 4), sr = *(const u32x4*)(slot_r + t * 4); const f32x4 sg = *(const f32x4*)(slot_g + t * 4);
        int pp[4];
#pragma unroll
        for (int k = 0; k < 4; ++k) pp[k] = off[se[k]] + (int)sr[k];
#pragma unroll
        for (int k = 0; k < 4; ++k) {
            const int p = pp[k];
#pragma unroll
            for (int i = 0; i < 4; ++i) *(u32x2*)(as + (size_t)p * DM + (i * 64 + F.lane_()) * 8) = v[i];
            if (F.lane_() == 0) { rss[p] = rs; gws[p] = sg[k]; }
        }
        if (F.lane_() == 0) *(u32x4*)(pos + t * 4) = (u32x4){(unsigned)pp[0], (unsigned)pp[1], (unsigned)pp[2], (unsigned)pp[3]};
    }
}

struct SchedMoE { int G, c, nM, nN; const char* A; const char* Bt; const LAS int* tile_e; size_t tstep, estep;
    __device__ __forceinline__ bool next(int i, Unit& u) const {
        const int L = i * G + c; if (L >= nM * nN) return false;
        int pm, pn; pg8::tile_of(L, nM, nN, pm, pn); const int e = tile_e[pm];
        u.pm = pm; u.pn = pn; u.a = A + (size_t)pm * tstep; u.b = Bt + (size_t)e * estep + (size_t)pn * tstep; u.kind = 0; u.aux = e; return true; }
};
struct EpiSwiglu { const float* rss; const float* bgu; unsigned char* hdn;
    struct Pre { };
    __device__ __forceinline__ Pre pre(const Unit&, int, int, int, int) const { return Pre{}; }
    __device__ __forceinline__ void operator()(const f32x4 (&acc)[2][2][4][2], const Unit& u, int wr, int wc, int fr, int fq, const Pre&) const {
        const int cw = 128 * u.pn + 32 * wc + 8 * fq; const float* bg = bgu + (size_t)u.aux * 4096 + cw;
        const f32x4 bg0 = *(const f32x4*)bg, bg1 = *(const f32x4*)(bg + 4), bu0 = *(const f32x4*)(bg + 2048), bu1 = *(const f32x4*)(bg + 2052);
        float rsv[8];
#pragma unroll
        for (int q = 0; q < 8; ++q) rsv[q] = rss[u.pm * 256 + (q >> 2) * 128 + wr * 64 + (q & 3) * 16 + fr];
#pragma unroll
        for (int ai = 0; ai < 2; ++ai)
#pragma unroll
            for (int m = 0; m < 4; ++m) {
                const int row = u.pm * 256 + ai * 128 + wr * 64 + m * 16 + fr; const float rs = rsv[ai * 4 + m] * (1.0f / W8_SCALE);
                f32x4 o[2];
#pragma unroll
                for (int n = 0; n < 2; ++n)
#pragma unroll
                    for (int j = 0; j < 4; ++j) {
                        float g = acc[ai][0][m][n][j] * rs + (n ? bg1[j] : bg0[j]); float up = acc[ai][1][m][n][j] * rs + (n ? bu1[j] : bu0[j]);
                        g = fminf(g, 7.0f); up = fminf(fmaxf(up, -7.0f), 7.0f);
                        o[n][j] = (up + 1.0f) * g * __builtin_amdgcn_rcpf(1.0f + __expf(-1.702f * g));
                    }
                *(u32x2*)(hdn + (size_t)row * DFF + cw) = pack_fp8x8(o[0][0], o[0][1], o[0][2], o[0][3], o[1][0], o[1][1], o[1][2], o[1][3]);
            }
    }
};
constexpr float YS_SCALE = 16.0f;
struct EpiDown { const float* gws; const float* bdn; unsigned char* ys;
    struct Pre { float gwv[8]; };
    __device__ __forceinline__ Pre pre(const Unit& u, int wr, int wc, int fr, int fq) const {
        Pre p;
#pragma unroll
        for (int q = 0; q < 8; ++q) p.gwv[q] = gws[u.pm * 256 + (q >> 2) * 128 + wr * 64 + (q & 3) * 16 + fr];
        return p;
    }
    __device__ __forceinline__ void operator()(const f32x4 (&acc)[2][2][4][2], const Unit& u, int wr, int wc, int fr, int fq, const Pre& pr) const {
        const int c0 = 256 * u.pn + 32 * wc + 8 * fq; const float* bp = bdn + (size_t)u.aux * DM + c0;
        const f32x4 b00 = *(const f32x4*)bp, b01 = *(const f32x4*)(bp + 4), b10 = *(const f32x4*)(bp + 128), b11 = *(const f32x4*)(bp + 132); const float (&gwv)[8] = pr.gwv;
#pragma unroll
        for (int ai = 0; ai < 2; ++ai)
#pragma unroll
            for (int m = 0; m < 4; ++m) {
                const int row = u.pm * 256 + ai * 128 + wr * 64 + m * 16 + fr; const float gw = gwv[ai * 4 + m] * YS_SCALE;
                constexpr float iw = 1.0f / W8_SCALE;
                const f32x4 o0 = (acc[ai][0][m][0] * iw + b00) * gw, o1 = (acc[ai][0][m][1] * iw + b01) * gw, o2 = (acc[ai][1][m][0] * iw + b10) * gw, o3 = (acc[ai][1][m][1] * iw + b11) * gw;
                *(u32x2*)(ys + (size_t)row * DM + c0) = pack_fp8x8(o0[0], o0[1], o0[2], o0[3], o1[0], o1[1], o1[2], o1[3]);
                *(u32x2*)(ys + (size_t)row * DM + c0 + 128) = pack_fp8x8(o2[0], o2[1], o2[2], o2[3], o3[0], o3[1], o3[2], o3[3]);
            }
    }
};

__device__ __forceinline__ void p_final(const Frame& F, const bf16_t* h) {
    const float* g = F.I<float>(IN_NORM_FINAL); const unsigned char* ys = F.W<unsigned char>(WS_YS); const int* pos = F.W<int>(WS_POS);
    const int ln = F.lane_();
    u32x4 pnext = (u32x4){0u, 0u, 0u, 0u};
    { const int r0 = F.bid * 8 + F.wave; if (r0 < T) pnext = *(const u32x4*)(pos + r0 * 4); }
    for (int r = F.bid * 8 + F.wave; r < T; r += F.G * 8) {
        f32x4 v[8]; float ss = 0.f;
        const int ps0 = (int)pnext.x, ps1 = (int)pnext.y, ps2 = (int)pnext.z, ps3 = (int)pnext.w;
        { const int rn = r + F.G * 8; if (rn < T) pnext = *(const u32x4*)(pos + rn * 4); }
#pragma unroll
        for (int i = 0; i < 4; ++i) {
            const int c = (i * 64 + ln) * 8;
            const u32x4 hh = *(const u32x4*)(h + (size_t)r * DM + c);
            const u32x2 y0 = *(const u32x2*)(ys + (size_t)ps0 * DM + c), y1 = *(const u32x2*)(ys + (size_t)ps1 * DM + c), y2 = *(const u32x2*)(ys + (size_t)ps2 * DM + c), y3 = *(const u32x2*)(ys + (size_t)ps3 * DM + c);
            f32x4 a, b;
            constexpr float iy = 1.0f / YS_SCALE;
#define FIN_Y(W, HI) ((__builtin_amdgcn_cvt_pk_f32_fp8((int)y0.W, HI) + __builtin_amdgcn_cvt_pk_f32_fp8((int)y1.W, HI)) + (__builtin_amdgcn_cvt_pk_f32_fp8((int)y2.W, HI) + __builtin_amdgcn_cvt_pk_f32_fp8((int)y3.W, HI)))
            { const f32x2 s0 = FIN_Y(x, false), s1 = FIN_Y(x, true), s2 = FIN_Y(y, false), s3 = FIN_Y(y, true);
              a[0] = bf_lo(hh.x) + s0[0] * iy; a[1] = bf_hi(hh.x) + s0[1] * iy; a[2] = bf_lo(hh.y) + s1[0] * iy; a[3] = bf_hi(hh.y) + s1[1] * iy;
              b[0] = bf_lo(hh.z) + s2[0] * iy; b[1] = bf_hi(hh.z) + s2[1] * iy; b[2] = bf_lo(hh.w) + s3[0] * iy; b[3] = bf_hi(hh.w) + s3[1] * iy; }
#undef FIN_Y
            v[2 * i] = a; v[2 * i + 1] = b;
            ss += a[0] * a[0] + a[1] * a[1] + a[2] * a[2] + a[3] * a[3] + b[0] * b[0] + b[1] * b[1] + b[2] * b[2] + b[3] * b[3];
        }
        ss = wave_sum(ss);
        float rs = __builtin_amdgcn_rsqf(ss * (1.0f / DM) + NORM_EPS);
#ifdef PROBE_MASK
        if (F.W<unsigned>(WS_CTL + CTL_CNT + 1024)[0] != 0u) rs = __builtin_nanf("");
#endif
#pragma unroll
        for (int i = 0; i < 4; ++i) {
            const int c = (i * 64 + ln) * 8;
            const f32x4 g0 = *(const f32x4*)(g + c), g1 = *(const f32x4*)(g + c + 4);
            *(f32x4*)(F.a->out + (size_t)r * DM + c) = v[2 * i] * rs * g0; *(f32x4*)(F.a->out + (size_t)r * DM + c + 4) = v[2 * i + 1] * rs * g1;
        }
    }
}

constexpr int N_PHASES = 14;
__global__ void __launch_bounds__(512, 2) fwd_kernel(Args args) {
    extern __shared__ __attribute__((aligned(16))) unsigned char lds_raw[];
    Frame F; F.a = &args; F.ws = args.ws; F.lds = (LAS unsigned char*)lds_raw;
    F.wave = __builtin_amdgcn_readfirstlane(threadIdx.x >> 6); F.G = gridDim.x; F.bid = blockIdx.x;
    volatile LAS unsigned* misc = (volatile LAS unsigned*)(F.lds + LDS_MISC);
    if (F.tid_() < 64) misc[F.tid_()] = 0u;
    __syncthreads();
    XcdBarrier bar; bar.bar = F.W<unsigned>(WS_CTL + CTL_BAR); bar.x = 0; bar.st = misc; bar.wv = F.wave;
#if !N_LAUNCH_PER_PHASE
    bar = xcd_barrier_post(F.W<unsigned>(WS_CTL + CTL_BAR), misc, F.wave);
#define GRID_BAR() xcd_barrier(bar)
#else
#define GRID_BAR() do { } while (0)
#endif
    const int lo = args.ph_lo, hi = args.ph_hi;
#ifndef ONLY_PHASE
#define ONLY_PHASE -1
#endif
#define IN(k) ((ONLY_PHASE < 0 || ONLY_PHASE == (k)) && lo <= (k) && (k) < hi)
#define BOTH(k) (IN(k) && IN((k) + 1))

    if (IN(0)) { p0_prologue(F); if (BOTH(0)) GRID_BAR(); }
#if REP_PHASE == 0
    if (IN(0)) { p0_prologue(F); if (BOTH(0)) GRID_BAR(); }
#endif
    if (IN(1)) {
        SchedG1F S8{F.G, F.bid, F.W<char>(WS_XB8), F.W<char>(WS_WINT)};
        SchedG1 S{F.G, F.G - 1 - F.bid, F.W<char>(WS_XB), F.W<char>(WS_WINT), F.W<char>(WS_MEMB), F.W<char>(WS_WKVT)};
        EpiG1 E{F.W<float>(WS_RS0), F.W<float>(WS_RSMEM), F.W<float>(WS_ROPEQK), F.W<float>(WS_ROPEI), F.W<bf16_t>(WS_ABUF), F.W<bf16_t>(WS_PBUF), F.W<bf16_t>(WS_GABUF),
                F.W<bf16_t>(WS_QB), F.W<bf16_t>(WS_KB), F.W<bf16_t>(WS_VB), F.W<bf16_t>(WS_QIB), F.W<bf16_t>(WS_KIB), F.W<float>(WS_WIB), F.W<bf16_t>(WS_KX), F.W<bf16_t>(WS_VX), 1.0f / W8_SCALE};
        pg8::SideConv SD{F.I<float>(IN_W_GU), F.W<unsigned char>(WS_WGUT), 1, 0, SJ_GU_P1, F.G, F.bid};
        const int sdone8 = pg8::gemm_phase<EpiG1, SchedG1F, pg8::SideConv, true>(F.lds, DM, S8, E, F.wave, SD);
        E.sc = 1.0f; SD.j0 += sdone8 * F.G;
        const int sdone = pg8::gemm_phase(F.lds, DM * 2, S, E, F.wave, SD);
        SD.leftover(sdone, F.wave, F.lane_());
        if (BOTH(1)) GRID_BAR();
    }
#if REP_PHASE == 1
    if (IN(1)) {
        SchedG1F S8{F.G, F.bid, F.W<char>(WS_XB8), F.W<char>(WS_WINT)};
        SchedG1 S{F.G, F.G - 1 - F.bid, F.W<char>(WS_XB), F.W<char>(WS_WINT), F.W<char>(WS_MEMB), F.W<char>(WS_WKVT)};
        EpiG1 E{F.W<float>(WS_RS0), F.W<float>(WS_RSMEM), F.W<float>(WS_ROPEQK), F.W<float>(WS_ROPEI), F.W<bf16_t>(WS_ABUF), F.W<bf16_t>(WS_PBUF), F.W<bf16_t>(WS_GABUF),
                F.W<bf16_t>(WS_QB), F.W<bf16_t>(WS_KB), F.W<bf16_t>(WS_VB), F.W<bf16_t>(WS_QIB), F.W<bf16_t>(WS_KIB), F.W<float>(WS_WIB), F.W<bf16_t>(WS_KX), F.W<bf16_t>(WS_VX), 1.0f / W8_SCALE};
        pg8::SideConv SD{F.I<float>(IN_W_GU), F.W<unsigned char>(WS_WGUT), 1, 0, SJ_GU_P1, F.G, F.bid};
        const int sdone8 = pg8::gemm_phase<EpiG1, SchedG1F, pg8::SideConv, true>(F.lds, DM, S8, E, F.wave, SD);
        E.sc = 1.0f; SD.j0 += sdone8 * F.G;
        const int sdone = pg8::gemm_phase(F.lds, DM * 2, S, E, F.wave, SD);
        SD.leftover(sdone, F.wave, F.lane_());
        if (BOTH(1)) GRID_BAR();
    }
#endif
#if MILESTONE >= 4
    if (IN(2)) { pg8::SideConv SD{F.I<float>(IN_W_GU), F.W<unsigned char>(WS_WGUT), 1, SJ_GU_P1, SJ_GU_P2, F.G, F.bid};
                 ix::indexer_phase(F, F.W<bf16_t>(WS_QIB), F.W<bf16_t>(WS_KIB), F.W<float>(WS_WIB), F.W<unsigned>(WS_MASK), SD); if (BOTH(2)) GRID_BAR(); }
#if REP_PHASE == 2
    if (IN(2)) { pg8::SideConv SD{F.I<float>(IN_W_GU), F.W<unsigned char>(WS_WGUT), 1, SJ_GU_P1, SJ_GU_P2, F.G, F.bid};
                 ix::indexer_phase(F, F.W<bf16_t>(WS_QIB), F.W<bf16_t>(WS_KIB), F.W<float>(WS_WIB), F.W<unsigned>(WS_MASK), SD); if (BOTH(2)) GRID_BAR(); }
#endif
    if (IN(3)) {
        att::AttnTensors X{F.W<bf16_t>(WS_QB), F.W<bf16_t>(WS_KB), F.W<bf16_t>(WS_VB), F.W<bf16_t>(WS_YATT), F.W<unsigned>(WS_MASK)};
        att::MergeArgs MG{F.ws, F.I<float>(IN_CONV_W)};
        att::attn_phase<DM, 512, DM, true, 6, true>((char*)lds_raw, X, MG, NB, NHEAD, NKVH, SEQ, SEQ, 0, att::ORDER_PAIRED | att::ORDER_XCD, F.G, F.bid, F.wave);
        if (BOTH(3)) GRID_BAR();
    }
#if REP_PHASE == 3
    if (IN(3)) {
        att::AttnTensors X{F.W<bf16_t>(WS_QB), F.W<bf16_t>(WS_KB), F.W<bf16_t>(WS_VB), F.W<bf16_t>(WS_YATT), F.W<unsigned>(WS_MASK)};
        att::MergeArgs MG{F.ws, F.I<float>(IN_CONV_W)};
        att::attn_phase<DM, 512, DM, true, 6, true>((char*)lds_raw, X, MG, NB, NHEAD, NKVH, SEQ, SEQ, 0, att::ORDER_PAIRED | att::ORDER_XCD, F.G, F.bid, F.wave);
        if (BOTH(3)) GRID_BAR();
    }
#endif
#endif
#ifdef PROBE_MASK
    if (IN(4)) { probe_mask_check(F); GRID_BAR(); }
#endif
    if (IN(5)) {
        SchedDense S{F.G, F.bid, 64, 8, F.W<char>(WS_MERGED), F.W<char>(WS_WOUTT), (size_t)256 * DM * 2};
        EpiResid<true> E{F.I<float>(IN_X), F.W<bf16_t>(WS_H1B), F.W<float>(WS_CTL + CTL_SS1)};
        pg8::SideConv SD{F.I<float>(IN_W_GU), F.W<unsigned char>(WS_WGUT), 1, SJ_GU_P2, SJ_GU, F.G, F.bid};
        const int sdone = pg8::gemm_phase(F.lds, DM * 2, S, E, F.wave, SD);
        SD.leftover(sdone, F.wave, F.lane_());
        if (BOTH(5)) GRID_BAR();
    }
#if REP_PHASE == 5
    if (IN(5)) {
        SchedDense S{F.G, F.bid, 64, 8, F.W<char>(WS_MERGED), F.W<char>(WS_WOUTT), (size_t)256 * DM * 2};
        EpiResid<true> E{F.I<float>(IN_X), F.W<bf16_t>(WS_H1B), nullptr};
        pg8::gemm_phase(F.lds, DM * 2, S, E, F.wave);
        if (BOTH(5)) GRID_BAR();
    }
#endif
#if MILESTONE >= 3
    if (IN(6)) {
        SchedDense S{F.G, F.bid, 64, 2, F.W<char>(WS_H1B), F.W<char>(WS_WQT), (size_t)256 * DM * 2};
        EpiScaleBf16 E{F.W<float>(WS_CTL + CTL_SS1), F.W<bf16_t>(WS_QX), 512};
        pg8::gemm_phase(F.lds, DM * 2, S, E, F.wave);
        if (BOTH(6)) GRID_BAR();
    }
#if REP_PHASE == 6
    if (IN(6)) {
        SchedDense S{F.G, F.bid, 64, 2, F.W<char>(WS_H1B), F.W<char>(WS_WQT), (size_t)256 * DM * 2};
        EpiScaleBf16 E{F.W<float>(WS_CTL + CTL_SS1), F.W<bf16_t>(WS_QX), 512};
        pg8::gemm_phase(F.lds, DM * 2, S, E, F.wave);
        if (BOTH(6)) GRID_BAR();
    }
#endif
    if (IN(7)) {
        att::AttnTensors X{F.W<bf16_t>(WS_QX), F.W<bf16_t>(WS_KX), F.W<bf16_t>(WS_VX), F.W<bf16_t>(WS_OX), nullptr};
        att::attn_phase<512, 512, 512, false, 6, false>((char*)lds_raw, X, att::MergeArgs{}, NB, XHEAD, XHEAD, SEQ, MEML, 1 << 20, att::ORDER_NATURAL, F.G, F.bid, F.wave);
        if (BOTH(7)) GRID_BAR();
    }
#if REP_PHASE == 7
    if (IN(7)) {
        att::AttnTensors X{F.W<bf16_t>(WS_QX), F.W<bf16_t>(WS_KX), F.W<bf16_t>(WS_VX), F.W<bf16_t>(WS_OX), nullptr};
        att::attn_phase<512, 512, 512, false, 6, false>((char*)lds_raw, X, att::MergeArgs{}, NB, XHEAD, XHEAD, SEQ, MEML, 1 << 20, att::ORDER_NATURAL, F.G, F.bid, F.wave);
        if (BOTH(7)) GRID_BAR();
    }
#endif
    if (IN(8)) {
        SchedDense S{F.G, F.bid, 64, 8, F.W<char>(WS_OX), F.W<char>(WS_WOXT), (size_t)256 * 512 * 2};
        EpiResid<false> E{F.W<bf16_t>(WS_H1B), F.W<bf16_t>(WS_H2B), nullptr};
        pg8::gemm_phase(F.lds, 512 * 2, S, E, F.wave);
        if (BOTH(8)) GRID_BAR();
    }
#if REP_PHASE == 8
    if (IN(8)) {
        SchedDense S{F.G, F.bid, 64, 8, F.W<char>(WS_OX), F.W<char>(WS_WOXT), (size_t)256 * 512 * 2};
        EpiResid<false> E{F.W<bf16_t>(WS_H1B), F.W<bf16_t>(WS_H2B), nullptr};
        pg8::gemm_phase(F.lds, 512 * 2, S, E, F.wave);
        if (BOTH(8)) GRID_BAR();
    }
#endif
#endif
    const bf16_t* h2b = F.W<bf16_t>(WS_H2B);
#if MILESTONE >= 2
    if (IN(9)) { p9_route(F, h2b); if (BOTH(9)) GRID_BAR(); }
    if (IN(10)) { p10_gather(F, h2b); if (BOTH(10)) GRID_BAR(); }
#if REP_PHASE == 10
    if (IN(10)) { p10_gather(F, h2b); if (BOTH(10)) GRID_BAR(); }
#endif
    if (IN(11)) {
        const int* te = F.W<int>(WS_TILEE); LAS int* tel = (LAS int*)(F.lds + LDS_MISC + 1024);
        tel[F.tid_()] = te[F.tid_()]; __syncthreads();
        SchedMoE S{F.G, F.bid, tel[511], 16, F.W<char>(WS_ASORT), F.W<char>(WS_WGUT), tel, (size_t)256 * DM, (size_t)4096 * DM};
        EpiSwiglu E{F.W<float>(WS_RSS), F.I<float>(IN_B_GU), F.W<unsigned char>(WS_HDN)};
        pg8::SideConv SD{F.I<float>(IN_W_DN), F.W<unsigned char>(WS_WDNT), 0, 0, SJ_DN, F.G, F.bid};
        const int sdone = pg8::gemm_phase<EpiSwiglu, SchedMoE, pg8::SideConv, true>(F.lds, DM, S, E, F.wave, SD);
        SD.leftover(sdone, F.wave, F.lane_());
        if (BOTH(11)) GRID_BAR();
    }
#if REP_PHASE == 11
    if (IN(11)) {
        const int* te = F.W<int>(WS_TILEE); LAS int* tel = (LAS int*)(F.lds + LDS_MISC + 1024);
        tel[F.tid_()] = te[F.tid_()]; __syncthreads();
        SchedMoE S{F.G, F.bid, tel[511], 16, F.W<char>(WS_ASORT), F.W<char>(WS_WGUT), tel, (size_t)256 * DM, (size_t)4096 * DM};
        EpiSwiglu E{F.W<float>(WS_RSS), F.I<float>(IN_B_GU), F.W<unsigned char>(WS_HDN)};
        pg8::SideConv SD{F.I<float>(IN_W_DN), F.W<unsigned char>(WS_WDNT), 0, 0, SJ_DN, F.G, F.bid};
        const int sdone = pg8::gemm_phase<EpiSwiglu, SchedMoE, pg8::SideConv, true>(F.lds, DM, S, E, F.wave, SD);
        SD.leftover(sdone, F.wave, F.lane_());
        if (BOTH(11)) GRID_BAR();
    }
#endif
    if (IN(12)) {
        const int* te = F.W<int>(WS_TILEE); LAS int* tel = (LAS int*)(F.lds + LDS_MISC + 1024);
        tel[F.tid_()] = te[F.tid_()]; __syncthreads();
        SchedMoE S{F.G, F.bid, tel[511], 8, F.W<char>(WS_HDN), F.W<char>(WS_WDNT), tel, (size_t)256 * DFF, (size_t)DM * DFF};
        EpiDown E{F.W<float>(WS_GWS), F.I<float>(IN_B_DN), F.W<unsigned char>(WS_YS)};
        pg8::gemm_phase<EpiDown, SchedMoE, pg8::SideNone, true>(F.lds, DFF, S, E, F.wave);
        if (BOTH(12)) GRID_BAR();
    }
#if REP_PHASE == 12
    if (IN(12)) {
        const int* te = F.W<int>(WS_TILEE); LAS int* tel = (LAS int*)(F.lds + LDS_MISC + 1024);
        tel[F.tid_()] = te[F.tid_()]; __syncthreads();
        SchedMoE S{F.G, F.bid, tel[511], 8, F.W<char>(WS_HDN), F.W<char>(WS_WDNT), tel, (size_t)256 * DFF, (size_t)DM * DFF};
        EpiDown E{F.W<float>(WS_GWS), F.I<float>(IN_B_DN), F.W<unsigned char>(WS_YS)};
        pg8::gemm_phase<EpiDown, SchedMoE, pg8::SideNone, true>(F.lds, DFF, S, E, F.wave);
        if (BOTH(12)) GRID_BAR();
    }
#endif
    if (IN(13)) { p_final(F, h2b); }
#if REP_PHASE == 13
    if (IN(13)) { p_final(F, h2b); }
#endif
#endif
#undef IN
#undef BOTH
}

extern "C" void kernel_launch(void* const* d_in, const int* in_sizes, int n_in, void* d_out, int out_size, void* d_ws, size_t ws_size, hipStream_t stream) {
    static int grid = 0;
    if (grid == 0) {
        if (n_in != 21 || out_size != T * DM || ws_size < WS_END) { fprintf(stderr, "kernel_launch: unexpected shapes (n_in %d, out %d, ws %zu < %zu)\n", n_in, out_size, ws_size, (size_t)WS_END); grid = -1; return; }
        int dev = 0, cus = 0, per_cu = 0;
        if (hipGetDevice(&dev) != hipSuccess || hipDeviceGetAttribute(&cus, hipDeviceAttributeMultiprocessorCount, dev) != hipSuccess) { grid = -1; return; }
        if (hipFuncSetAttribute((const void*)fwd_kernel, hipFuncAttributeMaxDynamicSharedMemorySize, LDS_BYTES) != hipSuccess) { fprintf(stderr, "kernel_launch: hipFuncSetAttribute failed\n"); grid = -1; return; }
        if (hipOccupancyMaxActiveBlocksPerMultiprocessor(&per_cu, (const void*)fwd_kernel, 512, LDS_BYTES) != hipSuccess || per_cu < 1) { fprintf(stderr, "kernel_launch: occupancy query says %d\n", per_cu); (void)hipGetLastError(); per_cu = 1; }
        grid = cus;
    }
    if (grid < 0) return;
    (void)hipMemsetAsync((char*)d_ws + WS_CTL, 0, CTL_BYTES, stream);
    Args a{};
    for (int i = 0; i < 21; ++i) a.in[i] = d_in[i];
    a.out = (float*)d_out; a.ws = (unsigned char*)d_ws;
#if N_LAUNCH_PER_PHASE
    for (int p = 0; p < N_PHASES; ++p) {
#if MILESTONE == 1
        if (!(p == 0 || p == 1 || p == 4 || p == 5 || p == 13)) continue;
#endif
#if MILESTONE == 2
        if (!(p == 0 || p == 1 || p == 4 || p == 5 || p >= 9)) continue;
#endif
#if MILESTONE == 3
        if (!(p == 0 || p == 1 || p >= 4)) continue;
#endif
        a.ph_lo = p; a.ph_hi = p + 1;
        hipLaunchKernelGGL(fwd_kernel, dim3(grid), dim3(512), LDS_BYTES, stream, a);
    }
#else
    a.ph_lo = 0; a.ph_hi = N_PHASES;
    hipLaunchKernelGGL(fwd_kernel, dim3(grid), dim3(512), LDS_BYTES, stream, a);
#endif
}
```

```cpp
#include <hip/hip_runtime.h>
#include <stdio.h>
#include <stdint.h>

#ifndef N_LAUNCH_PER_PHASE
#define N_LAUNCH_PER_PHASE 0
#endif
#ifndef REP_PHASE
#define REP_PHASE -1
#endif
#ifndef MILESTONE
#define MILESTONE 4
#endif

#define LAS __attribute__((address_space(3)))
typedef unsigned short bf16_t;
typedef short bf16x8 __attribute__((ext_vector_type(8)));
typedef float f32x2 __attribute__((ext_vector_type(2)));
typedef float f32x4 __attribute__((ext_vector_type(4)));
typedef float f32x16 __attribute__((ext_vector_type(16)));
typedef unsigned u32x4 __attribute__((ext_vector_type(4)));
typedef unsigned u32x2 __attribute__((ext_vector_type(2)));

constexpr int NB = 4, SEQ = 4096, T = NB * SEQ, DM = 2048, DIN = 14416;
constexpr int NHEAD = 16, HD = 128, NKVH = 4, IHEAD = 16, IDIM = 64, TOPK = 256;
constexpr int MEML = 256, XHEAD = 4;
constexpr int NEXP = 32, DFF = 2048, TOPE = 4;
constexpr float NORM_EPS = 1e-6f;
constexpr int C_CB = 0, C_CC = 2048, C_CX = 4096, C_Q = 6144, C_K = 8192, C_V = 8704, C_QI = 9216, C_KI = 10240, C_WI = 10304, C_GC = 10320, C_GA = 12368;
constexpr int TL_A = 0, TL_P = 16, TL_G = 32, TL_Q = 40, TL_K = 48, TL_V = 50, TL_QI = 52, TL_KI = 56, N1_TILES = 57, N1P = N1_TILES * 256;
constexpr int CAP_ROWS = T * TOPE + NEXP * 256;
constexpr int MAX_MT = CAP_ROWS / 256;

constexpr size_t al256(size_t x) { return (x + 255) & ~(size_t)255; }
constexpr size_t WS_CTL = 0;
constexpr size_t CTL_BAR = 0;
constexpr size_t CTL_CNT = 16384;
constexpr size_t CTL_SS1 = 32768;
constexpr size_t CTL_BYTES = CTL_SS1 + (size_t)T * 4;
constexpr size_t WS_XB = al256(CTL_BYTES);
constexpr size_t WS_RS0 = WS_XB + (size_t)T * DM * 2;
constexpr size_t WS_RSMEM = WS_RS0 + (size_t)T * 4;
constexpr size_t WS_ROPEQK = WS_RSMEM + 4096;
constexpr size_t WS_ROPEI = WS_ROPEQK + (size_t)T * 32 * 4;
constexpr size_t WS_MEMB = WS_ROPEI + (size_t)T * 16 * 4;
constexpr size_t WS_WINT = WS_MEMB + (size_t)NB * MEML * DM * 2;
constexpr size_t WS_WOUTT = WS_WINT + (size_t)N1P * DM * 2;
constexpr size_t WS_WQT = WS_WOUTT + (size_t)DM * DM * 2;
constexpr size_t WS_WKVT = WS_WQT + (size_t)512 * DM * 2;
constexpr size_t WS_WOXT = WS_WKVT + (size_t)1024 * DM * 2;
constexpr size_t WS_WGUT = WS_WOXT + (size_t)DM * 512 * 2;
constexpr size_t WS_WDNT = WS_WGUT + (size_t)NEXP * 4096 * DM * 2;
constexpr size_t WS_WRT = WS_WDNT + (size_t)NEXP * DM * DFF * 2;
constexpr size_t WS_ABUF = WS_WRT + (size_t)NEXP * DM * 4;
constexpr size_t WS_PBUF = WS_ABUF + (size_t)T * DM * 2;
constexpr size_t WS_GABUF = WS_PBUF + (size_t)T * DM * 2;
constexpr size_t WS_QB = WS_GABUF + (size_t)T * DM * 2;
constexpr size_t WS_KB = WS_QB + (size_t)T * DM * 2;
constexpr size_t WS_VB = WS_KB + (size_t)T * 512 * 2;
constexpr size_t WS_QIB = WS_VB + (size_t)T * 512 * 2;
constexpr size_t WS_KIB = WS_QIB + (size_t)T * 1024 * 2;
constexpr size_t WS_WIB = WS_KIB + (size_t)T * 64 * 2;
constexpr size_t WS_MASK = WS_WIB + (size_t)T * 16 * 4;
constexpr size_t WS_YATT = WS_MASK + (size_t)T * 128 * 4;
constexpr size_t WS_MERGED = WS_YATT + (size_t)T * DM * 2;
constexpr size_t WS_H1 = WS_MERGED + (size_t)T * DM * 2;
constexpr size_t WS_H1B = WS_H1 + (size_t)T * DM * 4;
constexpr size_t WS_QX = WS_H1B + (size_t)T * DM * 2;
constexpr size_t WS_KX = WS_QX + (size_t)T * 512 * 2;
constexpr size_t WS_VX = WS_KX + (size_t)NB * MEML * 512 * 2;
constexpr size_t WS_OX = WS_VX + (size_t)NB * MEML * 512 * 2;
constexpr size_t WS_H2 = WS_OX + (size_t)T * 512 * 2;
constexpr size_t WS_H2B = WS_H2 + (size_t)T * DM * 4;
constexpr size_t WS_SLOTE = WS_H2B + (size_t)T * DM * 2;
constexpr size_t WS_SLOTR = WS_SLOTE + (size_t)T * 4 * 4;
constexpr size_t WS_SLOTG = WS_SLOTR + (size_t)T * 4 * 4;
constexpr size_t WS_RS2 = WS_SLOTG + (size_t)T * 4 * 4;
constexpr size_t WS_POS = WS_RS2 + (size_t)T * 4;
constexpr size_t WS_RSS = WS_POS + (size_t)T * 4 * 4;
constexpr size_t WS_GWS = WS_RSS + (size_t)CAP_ROWS * 4;
constexpr size_t WS_TILEE = WS_GWS + (size_t)CAP_ROWS * 4;
constexpr size_t WS_ASORT = WS_TILEE + 2048;
constexpr size_t WS_HDN = WS_ASORT + (size_t)CAP_ROWS * DM * 2;
constexpr size_t WS_YS = WS_HDN + (size_t)CAP_ROWS * DFF * 2;
constexpr size_t WS_TIE = WS_YS + (size_t)CAP_ROWS * DM * 2;
constexpr size_t WS_XB8 = WS_TIE;
constexpr size_t WS_END = WS_TIE + (size_t)256 * 8 * 128 * 64 * 4;

__device__ __forceinline__ unsigned cvt_pk_bf16(float lo, float hi) { unsigned r; asm volatile("v_cvt_pk_bf16_f32 %0, %1, %2" : "=v"(r) : "v"(lo), "v"(hi)); return r; }
__device__ __forceinline__ u32x2 pack_fp8x8(float a0, float a1, float a2, float a3, float a4, float a5, float a6, float a7) {
    int lo = 0, hi = 0;
    lo = __builtin_amdgcn_cvt_pk_fp8_f32(a0, a1, lo, false); lo = __builtin_amdgcn_cvt_pk_fp8_f32(a2, a3, lo, true);
    hi = __builtin_amdgcn_cvt_pk_fp8_f32(a4, a5, hi, false); hi = __builtin_amdgcn_cvt_pk_fp8_f32(a6, a7, hi, true);
    return (u32x2){(unsigned)lo, (unsigned)hi};
}
constexpr float W8_SCALE = 64.0f;
__device__ __forceinline__ float bf2f(unsigned short b) { return __uint_as_float(((unsigned)b) << 16); }
__device__ __forceinline__ float bf_lo(unsigned w) { return __uint_as_float(w << 16); }
__device__ __forceinline__ float bf_hi(unsigned w) { return __uint_as_float(w & 0xffff0000u); }
__device__ __forceinline__ float sigmoidf_(float x) { return __builtin_amdgcn_rcpf(1.0f + __expf(-x)); }
__device__ __forceinline__ f32x4 sigmoid4(const f32x4& x, float s) {
    f32x4 z = x * (s * -1.4426950408889634f), e;
#pragma unroll
    for (int j = 0; j < 4; ++j) e[j] = __builtin_amdgcn_exp2f(z[j]);
    e = e + 1.0f;
#pragma unroll
    for (int j = 0; j < 4; ++j) e[j] = __builtin_amdgcn_rcpf(e[j]);
    return e;
}
__device__ __forceinline__ int lane_id() { int x; asm volatile("v_mbcnt_lo_u32_b32 %0, -1, 0\n\tv_mbcnt_hi_u32_b32 %0, -1, %0" : "=v"(x)); return x; }
__device__ __forceinline__ float wave_sum(float v) {
#pragma unroll
    for (int o = 32; o >= 1; o >>= 1) v += __shfl_xor(v, o);
    return v;
}

#define XB_TMO      128
#define XB_XCNT(j)  (256  + 64 * (j))
#define XB_XSUB(j)  (1280 + 64 * (j))
#define XB_XGEN(j)  (2304 + 64 * (j))
#define XB_TOP      3328
#define XB_TOPGEN   3392
#define XCD_BAR_WORDS 3456
#define XB_SPIN_CAP (1u << 18)

__device__ __forceinline__ unsigned xb_ld(unsigned* p)              { return __hip_atomic_load(p, __ATOMIC_RELAXED, __HIP_MEMORY_SCOPE_AGENT); }
__device__ __forceinline__ unsigned xb_add(unsigned* p, unsigned v) { return __hip_atomic_fetch_add(p, v, __ATOMIC_RELAXED, __HIP_MEMORY_SCOPE_AGENT); }
__device__ __forceinline__ unsigned xb_xcc_id() { return (unsigned)__builtin_amdgcn_s_getreg((3 << 11) | 20) & 0xFu; }
#define XB_SPIN(cond, bar) do { unsigned _sp = 0; while (cond) { __builtin_amdgcn_s_sleep(1); \
    if ((++_sp & 255u) == 0u) { if (xb_ld(&(bar)[XB_TMO])) break; if (_sp > XB_SPIN_CAP) { atomicAdd(&(bar)[XB_TMO], 1u); break; } } } } while (0)

struct XcdBarrier { unsigned* bar; unsigned x; volatile LAS unsigned* st; int wv; };

__device__ __forceinline__ XcdBarrier xcd_barrier_post(unsigned* bar, volatile LAS unsigned* st, int wv) {
    XcdBarrier b; b.bar = bar; b.x = xb_xcc_id(); b.st = st; b.wv = wv;
    if (wv == 0 && lane_id() == 0) (void)xb_add(&bar[XB_XCNT(b.x)], 1u);
    return b;
}
__device__ __forceinline__ void xcd_barrier_complete(unsigned* bar, unsigned x, unsigned& nloc, unsigned& nx) {
    const unsigned G = gridDim.x * gridDim.y * gridDim.z;
    unsigned sum, cnt, mine, sp = 0u;
    for (;;) {
        sum = 0u; cnt = 0u; mine = 0u;
#pragma unroll
        for (unsigned j = 0; j < 16; ++j) { const unsigned c = xb_ld(&bar[XB_XCNT(j)]); sum += c; cnt += (c > 0u) ? 1u : 0u; mine = (j == x) ? c : mine; }
        if (sum == G) break;
        __builtin_amdgcn_s_sleep(1);
        if ((++sp & 255u) == 0u) { if (xb_ld(&bar[XB_TMO])) break; if (sp > XB_SPIN_CAP) { atomicAdd(&bar[XB_TMO], 1u); break; } }
    }
    nloc = mine > 0u ? mine : 1u; nx = cnt > 0u ? cnt : 1u;
}
__device__ __forceinline__ void xcd_barrier(const XcdBarrier& b) {
    asm volatile("s_waitcnt vmcnt(0)" ::: "memory");
    __syncthreads();
    if (b.wv == 0 && lane_id() == 0) {
        unsigned* bar = b.bar;
        __builtin_amdgcn_s_waitcnt(0);
        unsigned nloc = b.st[0], nx = b.st[1];
        if (nloc == 0u) { xcd_barrier_complete(bar, b.x, nloc, nx); b.st[0] = nloc; b.st[1] = nx; }
        const unsigned old = xb_add(&bar[XB_XSUB(b.x)], 1u);
        const unsigned gen = old / nloc;
        if (old + 1u == (gen + 1u) * nloc) {
            __builtin_amdgcn_fence(__ATOMIC_RELEASE, "agent");
            asm volatile("s_waitcnt vmcnt(0)" ::: "memory");
            const unsigned og = xb_add(&bar[XB_TOP], 1u);
            const unsigned tg = og / nx;
            if (og + 1u == (tg + 1u) * nx) xb_add(&bar[XB_TOPGEN], 1u);
            else XB_SPIN(xb_ld(&bar[XB_TOPGEN]) == tg, bar);
            __builtin_amdgcn_fence(__ATOMIC_ACQUIRE, "agent");
            xb_add(&bar[XB_XGEN(b.x)], 1u);
            asm volatile("s_waitcnt vmcnt(0)" ::: "memory");
        } else {
            XB_SPIN(xb_ld(&bar[XB_XGEN(b.x)]) == gen, bar);
            __builtin_amdgcn_fence(__ATOMIC_ACQUIRE, "agent");
            asm volatile("s_waitcnt vmcnt(0)" ::: "memory");
        }
    }
    __syncthreads();
}

constexpr int LDS_CT = 131072;
namespace pg8 {
constexpr int BM = 256, BK = 64, HALF = 128, HTB = HALF * BK * 2, STAGE_BYTES = 8 * HTB, NXCD = 8, WGM = 8;
__device__ __forceinline__ int lds_byte(int r, int c) { const int st = (r >> 4) * 2 + (c >> 5), rr = r & 15, cc = c & 31, ob = rr * 64 + cc * 2; return st * 1024 + (ob ^ (((ob >> 9) & 1) << 5)); }
__device__ __forceinline__ void stage_rc(int b, int& R, int& C) { const int st = b / 1024, sb = b % 1024, swz = sb ^ (((sb >> 9) & 1) << 5); R = (st >> 1) * 16 + swz / 64; C = (st & 1) * 32 + (swz % 64) / 2; }
__device__ __forceinline__ int perm32(int rho) { const int n = rho >> 4, i = rho & 15; return 8 * (i >> 2) + 4 * n + (i & 3); }

struct Unit { const char* a; const char* b; int pm, pn, kind, aux; };

__device__ __forceinline__ void tile_of(int L, int nM, int nN, int& pm, int& pn) {
    const int nwg = nM * nN; int wgid = L;
    { const int q = nwg / NXCD, r = nwg % NXCD, xcd = wgid % NXCD, off = wgid / NXCD; wgid = (xcd < r ? xcd * (q + 1) : r * (q + 1) + (xcd - r) * q) + off; }
    const int nig = WGM * nN, gid = wgid / nig, fm = gid * WGM, gsz = (nM - fm) < WGM ? (nM - fm) : WGM;
    pm = fm + ((wgid % nig) % gsz); pn = (wgid % nig) / gsz;
}


struct SideNone { static constexpr bool ON = false; };
struct SideConv {
    static constexpr bool ON = true;
    const float* src; unsigned char* dst; int gu; int j0, jn; int G, c;
    __device__ __forceinline__ void decode(int j, size_t& soff, int& sld, size_t& doff) const {
        if (gu) { const int e = j >> 11, r = j & 2047, nt = r >> 4, kt = r & 15, n0 = nt * 32, w = n0 & 255, tile = n0 >> 8;
            const int sc = (w < 128) ? 128 * tile + w : 2048 + 128 * tile + (w - 128);
            sld = 4096; soff = (size_t)e * 2048 * 4096 + (size_t)(kt * 128) * 4096 + sc; doff = (size_t)e * 4096 * 2048 + (size_t)n0 * 2048 + kt * 128; }
        else { const int e = j >> 10, r = j & 1023, nt = r >> 4, kt = r & 15, n0 = nt * 32;
            sld = 2048; soff = (size_t)e * 2048 * 2048 + (size_t)(kt * 128) * 2048 + n0; doff = (size_t)e * 2048 * 2048 + (size_t)n0 * 2048 + kt * 128; }
    }
    __device__ __forceinline__ size_t issue(int j, LAS unsigned char* tile, int wid, int lane) const {
        size_t soff, doff; int sld; decode(j, soff, sld, doff);
        const float* sp = src + soff + (size_t)(16 * wid + (lane >> 3)) * sld + (lane & 7) * 4;
        __builtin_amdgcn_global_load_lds((const unsigned*)sp, (LAS unsigned*)(tile + (2 * wid) * 1040), 16, 0, 2);
        __builtin_amdgcn_global_load_lds((const unsigned*)(sp + (size_t)8 * sld), (LAS unsigned*)(tile + (2 * wid + 1) * 1040), 16, 0, 2);
        return doff;
    }
    __device__ __forceinline__ void consume(const LAS unsigned char* tile, size_t doff, int wid, int lane) const {
        float sv[8];
#pragma unroll
        for (int j = 0; j < 8; ++j) sv[j] = *(const LAS float*)(tile + (lane & 15) * 1040 + j * 128 + (4 * wid + (lane >> 4)) * 4);
        __builtin_nontemporal_store(pack_fp8x8(sv[0] * W8_SCALE, sv[1] * W8_SCALE, sv[2] * W8_SCALE, sv[3] * W8_SCALE, sv[4] * W8_SCALE, sv[5] * W8_SCALE, sv[6] * W8_SCALE, sv[7] * W8_SCALE),
                                    (u32x2*)(dst + doff + (size_t)(4 * wid + (lane >> 4)) * 2048 + 8 * (lane & 15)));
    }
    __device__ __forceinline__ void leftover(int done, int wid, int lane) const {
        for (int q = done; j0 + q * G + c < jn; q += 4) {
            float v[4][8]; size_t doff[4]; bool ok[4];
#pragma unroll
            for (int u = 0; u < 4; ++u) {
                const int j = j0 + (q + u) * G + c; ok[u] = j < jn;
                size_t soff; int sld; decode(ok[u] ? j : j0 + q * G + c, soff, sld, doff[u]);
                const float* sp = src + soff + (size_t)(16 * wid + 8 * (lane >> 5)) * sld + (lane & 31);
#pragma unroll
                for (int r = 0; r < 8; ++r) v[u][r] = __builtin_nontemporal_load(sp + (size_t)r * sld);
            }
#pragma unroll
            for (int u = 0; u < 4; ++u)
                if (ok[u]) *(u32x2*)(dst + doff[u] + (size_t)(lane & 31) * 2048 + 16 * wid + 8 * (lane >> 5)) = pack_fp8x8(v[u][0] * W8_SCALE, v[u][1] * W8_SCALE, v[u][2] * W8_SCALE, v[u][3] * W8_SCALE, v[u][4] * W8_SCALE, v[u][5] * W8_SCALE, v[u][6] * W8_SCALE, v[u][7] * W8_SCALE);
        }
    }
};

typedef int i32x4_ __attribute__((ext_vector_type(4)));
typedef int i32x8_ __attribute__((ext_vector_type(8)));
template <class Epi, class Sched, class Side = SideNone, bool FP8 = false>
__device__ __forceinline__ int gemm_phase(LAS unsigned char* lds, const int RB, const Sched& S, const Epi& E, const int wid, const Side& SD = Side{}) {
    const int lane = lane_id(), tid = wid * 64 + lane, wr = wid >> 2, wc = wid & 3, fr = lane & 15, fq = lane >> 4;
    const int nt = RB / 128;
    unsigned voffA[2], voffB[2];
#pragma unroll
    for (int i = 0; i < 2; ++i) { int R, C; stage_rc(tid * 16 + i * 8192, R, C); const int Rb = (R & ~31) + perm32(R & 31);
        voffA[i] = (unsigned)(R * RB + C * 2); voffB[i] = (unsigned)(Rb * RB + C * 2); }
    const size_t kstep = (size_t)(BK * 2);
    const size_t hstep = (size_t)HALF * RB;
    const unsigned ldsw = (unsigned)wid * 1024u;
    const int aoff = lds_byte(wr * 64 + fr, fq * 8), boff = lds_byte(wc * 32 + fr, fq * 8);
#define PG8_SA(b, h) (((b) * 2 + (h)) * HTB)
#define PG8_SB(b, h) ((4 + (b) * 2 + (h)) * HTB)
#define PG8_STAGE(bufoff, gbase, voff) do { _Pragma("unroll") for (int _i = 0; _i < 2; ++_i) \
        __builtin_amdgcn_global_load_lds((const unsigned*)((const char*)(gbase) + (voff)[_i]), (LAS unsigned*)(lds + (bufoff) + ldsw + _i * 8192), 16, 0, 0); } while (0)
#define PG8_LDA(dst, b, h) do { if constexpr (FP8) { _Pragma("unroll") for (int m = 0; m < 4; ++m) dst##8[m] = __builtin_shufflevector(*(const LAS i32x4_*)(lds + PG8_SA(b, h) + aoff + m * 2048), *(const LAS i32x4_*)(lds + PG8_SA(b, h) + aoff + m * 2048 + 1024), 0, 1, 2, 3, 4, 5, 6, 7); } \
        else { _Pragma("unroll") for (int m = 0; m < 4; ++m) _Pragma("unroll") for (int k = 0; k < 2; ++k) dst[m][k] = *(const LAS bf16x8*)(lds + PG8_SA(b, h) + aoff + m * 2048 + k * 1024); } } while (0)
#define PG8_LDB(dst, b, h) do { if constexpr (FP8) { _Pragma("unroll") for (int n = 0; n < 2; ++n) dst##8[n] = __builtin_shufflevector(*(const LAS i32x4_*)(lds + PG8_SB(b, h) + boff + n * 2048), *(const LAS i32x4_*)(lds + PG8_SB(b, h) + boff + n * 2048 + 1024), 0, 1, 2, 3, 4, 5, 6, 7); } \
        else { _Pragma("unroll") for (int n = 0; n < 2; ++n) _Pragma("unroll") for (int k = 0; k < 2; ++k) dst[n][k] = *(const LAS bf16x8*)(lds + PG8_SB(b, h) + boff + n * 2048 + k * 1024); } } while (0)
#define PG8_CAT(X) X
#define PG8_MMA(ai, bj, At, Bt) do { if constexpr (FP8) __builtin_amdgcn_sched_barrier(0); __builtin_amdgcn_s_setprio(1); _Pragma("unroll") for (int m = 0; m < 4; ++m) _Pragma("unroll") for (int n = 0; n < 2; ++n) { \
        if constexpr (FP8) asm volatile("v_mfma_scale_f32_16x16x128_f8f6f4 %0, %1, %2, %0, %3, %3 op_sel_hi:[0,0,0]" : "+v"(acc[ai][bj][m][n]) : "v"(Bt##8[n]), "v"(At##8[m]), "v"(mx_one));   \
        else { _Pragma("unroll") for (int k = 0; k < 2; ++k) acc[ai][bj][m][n] = __builtin_amdgcn_mfma_f32_16x16x32_bf16(Bt[n][k], At[m][k], acc[ai][bj][m][n], 0, 0, 0); } } \
        __builtin_amdgcn_s_setprio(0); if constexpr (FP8) __builtin_amdgcn_sched_barrier(0); } while (0)
#define PG8_WAIT_V(n) asm volatile("s_waitcnt vmcnt(" #n ")" ::: "memory")
#define PG8_WAIT_L(n) asm volatile("s_waitcnt lgkmcnt(" #n ")" ::: "memory")
#define PG8_BAR __builtin_amdgcn_s_barrier()
#define PG8_SCHED __builtin_amdgcn_sched_barrier(0)
    Unit cur, nxt; int ui = 0;
    int sq = 0; bool s_have = false; size_t s_doff = 0;
    if (!S.next(0, cur)) return 0;
    f32x4 acc[2][2][4][2];
#pragma unroll
    for (int a = 0; a < 2; ++a)
#pragma unroll
        for (int b = 0; b < 2; ++b)
#pragma unroll
            for (int m = 0; m < 4; ++m)
#pragma unroll
                for (int n = 0; n < 2; ++n) acc[a][b][m][n] = (f32x4){0.f, 0.f, 0.f, 0.f};
    bf16x8 At[4][2], B0[2][2], B1[2][2];
    const int mx_one = 0x7F7F7F7F;
    i32x8_ At8[4], B08[2], B18[2];
    const char* cA = cur.a; const char* cB = cur.b;
    PG8_STAGE(PG8_SB(0, 0), cB, voffB); PG8_STAGE(PG8_SA(0, 0), cA, voffA); PG8_STAGE(PG8_SB(0, 1), cB + hstep, voffB); PG8_STAGE(PG8_SA(0, 1), cA + hstep, voffA);
    if (wr == 1) PG8_BAR;
    PG8_WAIT_V(4); PG8_BAR;
    PG8_STAGE(PG8_SB(1, 0), cB + kstep, voffB); PG8_STAGE(PG8_SA(1, 0), cA + kstep, voffA); PG8_STAGE(PG8_SB(1, 1), cB + hstep + kstep, voffB);
    PG8_WAIT_V(6); PG8_BAR;
    for (;;) {
        const bool has_next = S.next(ui + 1, nxt);
        const char* nA = has_next ? nxt.a : cA; const char* nB = has_next ? nxt.b : cB;
        const int lzp = lane_id(); const typename Epi::Pre pre = E.pre(cur, wr, wc, lzp & 15, lzp >> 4);
        for (int t = 0; t < nt; t += 2) {
            const bool last = (t == nt - 2);
            const char* a1 = cA + (size_t)(t + 1) * kstep;
            const char* a2 = last ? nA : cA + (size_t)(t + 2) * kstep; const char* b2 = last ? nB : cB + (size_t)(t + 2) * kstep;
            const char* a3 = a2 + kstep; const char* b3 = b2 + kstep;
            PG8_LDB(B0, 0, 0); PG8_SCHED; PG8_LDA(At, 0, 0); PG8_STAGE(PG8_SA(1, 1), a1 + hstep, voffA);
            PG8_WAIT_L(8); PG8_BAR; PG8_WAIT_L(0); PG8_MMA(0, 0, At, B0); PG8_BAR; PG8_SCHED;
            PG8_LDB(B1, 0, 1);
            float sv[8]; const bool s_st = Side::ON && s_have;
            if constexpr (Side::ON) { if (s_st) {
#pragma unroll
                for (int j = 0; j < 8; ++j) sv[j] = *(const LAS float*)(lds + LDS_CT + (lane & 15) * 1040 + j * 128 + (4 * wid + (lane >> 4)) * 4); } }
            PG8_STAGE(PG8_SB(0, 0), b2, voffB);
            PG8_BAR; PG8_WAIT_L(0);
            u32x2 sw; if constexpr (Side::ON) { if (s_st) sw = pack_fp8x8(sv[0] * W8_SCALE, sv[1] * W8_SCALE, sv[2] * W8_SCALE, sv[3] * W8_SCALE, sv[4] * W8_SCALE, sv[5] * W8_SCALE, sv[6] * W8_SCALE, sv[7] * W8_SCALE); }
            PG8_MMA(0, 1, At, B1); PG8_BAR;
            PG8_LDA(At, 0, 1);
            if constexpr (Side::ON) { if (s_st) *(u32x2*)(SD.dst + s_doff + (size_t)(4 * wid + (lane >> 4)) * 2048 + 8 * (lane & 15)) = sw; }
            PG8_STAGE(PG8_SA(0, 0), a2, voffA);
            PG8_BAR; PG8_WAIT_L(0); PG8_MMA(1, 0, At, B0); PG8_BAR; PG8_SCHED;
            PG8_STAGE(PG8_SB(0, 1), b2 + hstep, voffB);
            if (Side::ON && s_st) { PG8_WAIT_V(7); } else { PG8_WAIT_V(6); }
            PG8_BAR; PG8_MMA(1, 1, At, B1); PG8_BAR;
            PG8_LDB(B0, 1, 0); PG8_SCHED; PG8_LDA(At, 1, 0);
            if constexpr (Side::ON) {
                s_have = false;
                if (SD.j0 + sq * SD.G + SD.c < SD.jn) { size_t soff; int sld; SD.decode(SD.j0 + sq * SD.G + SD.c, soff, sld, s_doff);
                    const float* sp = SD.src + soff + (size_t)(16 * wid + (lane >> 3)) * sld + (lane & 7) * 4;
                    __builtin_amdgcn_global_load_lds((const unsigned*)sp, (LAS unsigned*)(lds + LDS_CT + (2 * wid) * 1040), 16, 0, 2);
                    __builtin_amdgcn_global_load_lds((const unsigned*)(sp + (size_t)8 * sld), (LAS unsigned*)(lds + LDS_CT + (2 * wid + 1) * 1040), 16, 0, 2);
                    s_have = true; ++sq; }
            }
            PG8_STAGE(PG8_SA(0, 1), a2 + hstep, voffA);
            PG8_WAIT_L(8); PG8_BAR; PG8_WAIT_L(0); PG8_MMA(0, 0, At, B0); PG8_BAR; PG8_SCHED;
            PG8_LDB(B1, 1, 1); PG8_STAGE(PG8_SB(1, 0), b3, voffB);
            PG8_BAR; PG8_WAIT_L(0); PG8_MMA(0, 1, At, B1); PG8_BAR;
            PG8_LDA(At, 1, 1); PG8_STAGE(PG8_SA(1, 0), a3, voffA);
            PG8_BAR; PG8_WAIT_L(0); PG8_MMA(1, 0, At, B0); PG8_BAR; PG8_SCHED;
            PG8_STAGE(PG8_SB(1, 1), b3 + hstep, voffB);
            PG8_WAIT_V(6); PG8_BAR; PG8_MMA(1, 1, At, B1); PG8_BAR;
        }
        if constexpr (FP8) asm volatile("s_nop 15\n s_nop 7" ::: "memory");
        { const int lz = lane_id(); E(acc, cur, wr, wc, lz & 15, lz >> 4, pre); }
        if (!has_next) break;
#pragma unroll
        for (int a = 0; a < 2; ++a)
#pragma unroll
            for (int b = 0; b < 2; ++b)
#pragma unroll
                for (int m = 0; m < 4; ++m)
#pragma unroll
                    for (int n = 0; n < 2; ++n) acc[a][b][m][n] = (f32x4){0.f, 0.f, 0.f, 0.f};
        cur = nxt; cA = nA; cB = nB; ++ui;
    }
    PG8_WAIT_V(0);
    if (wr == 0) PG8_BAR;
    PG8_BAR;
    if constexpr (Side::ON) { if (s_have) {
        float sv[8];
#pragma unroll
        for (int j = 0; j < 8; ++j) sv[j] = *(const LAS float*)(lds + LDS_CT + (lane & 15) * 1040 + j * 128 + (4 * wid + (lane >> 4)) * 4);
        *(u32x2*)(SD.dst + s_doff + (size_t)(4 * wid + (lane >> 4)) * 2048 + 8 * (lane & 15)) =
            pack_fp8x8(sv[0] * W8_SCALE, sv[1] * W8_SCALE, sv[2] * W8_SCALE, sv[3] * W8_SCALE, sv[4] * W8_SCALE, sv[5] * W8_SCALE, sv[6] * W8_SCALE, sv[7] * W8_SCALE); } }
#undef PG8_SA
#undef PG8_SB
#undef PG8_STAGE
#undef PG8_LDA
#undef PG8_LDB
#undef PG8_MMA
#undef PG8_WAIT_V
#undef PG8_WAIT_L
#undef PG8_BAR
#undef PG8_SCHED
#undef PG8_CAT
    return sq;
}
}
using pg8::Unit;

struct Args { const void* in[21]; float* out; unsigned char* ws; int ph_lo, ph_hi; };
enum { IN_X = 0, IN_MEM, IN_POS, IN_NORM_MIX, IN_W_IN, IN_CONV_W, IN_W_OUT, IN_NORM_XATTN, IN_NORM_MEM, IN_WQ_X, IN_WK_X, IN_WV_X, IN_WO_X, IN_NORM_FFN,
       IN_W_ROUTER, IN_B_ROUTER, IN_W_GU, IN_B_GU, IN_W_DN, IN_B_DN, IN_NORM_FINAL };
constexpr int LDS_BYTES = 163840;
constexpr int LDS_MISC = 155648;

struct Frame {
    const Args* a; unsigned char* ws; LAS unsigned char* lds; int wave, G, bid;
    __device__ __forceinline__ int lane_() const { return lane_id(); }
    __device__ __forceinline__ int tid_() const { return wave * 64 + lane_id(); }
    template <class Tp> __device__ __forceinline__ Tp* W(size_t off) const { return (Tp*)(ws + off); }
    template <class Tp> __device__ __forceinline__ const Tp* I(int k) const { return (const Tp*)a->in[k]; }
};

__constant__ float c_invfreq[16] = {1.000000000e+00f, 4.403665960e-01f, 1.939227432e-01f, 8.539710194e-02f, 3.760603070e-02f, 1.656044088e-02f, 7.292664610e-03f, 3.211446106e-03f,
                                    1.414213562e-03f, 6.227724371e-04f, 2.742481884e-04f, 1.207697351e-04f, 5.318295734e-05f, 2.341999971e-05f, 1.031338525e-05f, 4.541670478e-06f};

__device__ __forceinline__ int win_src_col(int c) {
    const int tile = c >> 8, w = c & 255;
    if (tile < TL_P) { const int i = tile - TL_A; return w < 128 ? C_CB + 128 * i + w : C_GC + 128 * i + (w - 128); }
    if (tile < TL_G) { const int i = tile - TL_P; return w < 128 ? C_CC + 128 * i + w : C_CX + 128 * i + (w - 128); }
    if (tile < TL_Q) return C_GA + 256 * (tile - TL_G) + w;
    if (tile < TL_V) {
        const int col = (tile < TL_K) ? 256 * (tile - TL_Q) + w : 256 * (tile - TL_K) + w; const int base = (tile < TL_K) ? C_Q : C_K;
        const int d = col & 127; int pd = d;
        if (d < 32) { const int f = d >> 3, r = d & 7; pd = (r < 4) ? 4 * f + r : 16 + 4 * f + (r - 4); }
        return base + (col & ~127) + pd;
    }
    if (tile < TL_QI) return C_V + 256 * (tile - TL_V) + w;
    if (tile < TL_KI) { const int col = 256 * (tile - TL_QI) + w; const int d = col & 63; int pd = d;
        if (d < 16) { const int f = d >> 3, r = d & 7; pd = (r < 4) ? 4 * f + r : 8 + 4 * f + (r - 4); }
        return C_QI + (col & ~63) + pd; }
    if (w < 64) { int pd = w; if (w < 16) { const int f = w >> 3, r = w & 7; pd = (r < 4) ? 4 * f + r : 8 + 4 * f + (r - 4); } return C_KI + pd; }
    if (w < 80) return C_WI + (w - 64);
    return -1;
}

enum { MAP_ID = 0, MAP_WIN = 1, MAP_KV = 2, MAP_GU = 3 };
struct TJob { const float* src; const float* src2; const float* scale; bf16_t* dst; int src_ld, K, n0, k0, map, f8; };
__device__ __forceinline__ void tjob_load(const TJob& J, int wave, int lane, f32x4 (&R)[8]) {
    const int n = J.n0 + 32 * wave + (lane & 7) * 4;
    const float* sp = J.src; int sc = n;
    if (J.map == MAP_WIN) sc = win_src_col(n);
    else if (J.map == MAP_KV) { if (n >= 512) { sp = J.src2; sc = n - 512; } }
    else if (J.map == MAP_GU) { const int tile = n >> 8, w = n & 255; sc = (w < 128) ? 128 * tile + w : 2048 + 128 * tile + (w - 128); }
    const float* p = sp + (size_t)(J.k0 + 8 * (lane >> 3)) * J.src_ld + (sc >= 0 ? sc : 0);
#pragma unroll
    for (int j = 0; j < 8; ++j) { R[j] = (sc >= 0) ? __builtin_nontemporal_load((const f32x4*)(p + (size_t)j * J.src_ld)) : (f32x4){0.f, 0.f, 0.f, 0.f}; }
}
__device__ __forceinline__ void tjob_store(const TJob& J, int wave, int lane, const f32x4 (&R)[8]) {
    const int n = J.n0 + 32 * wave + (lane & 7) * 4, k = J.k0 + 8 * (lane >> 3);
    f32x4 s0 = (f32x4){1.f, 1.f, 1.f, 1.f}, s1 = s0;
    if (J.scale) { s0 = *(const f32x4*)(J.scale + k); s1 = *(const f32x4*)(J.scale + k + 4); }
    if (J.f8) {
        s0 *= W8_SCALE; s1 *= W8_SCALE;
#pragma unroll
        for (int c = 0; c < 4; ++c)
            __builtin_nontemporal_store(pack_fp8x8(R[0][c] * s0[0], R[1][c] * s0[1], R[2][c] * s0[2], R[3][c] * s0[3], R[4][c] * s1[0], R[5][c] * s1[1], R[6][c] * s1[2], R[7][c] * s1[3]),
                                        (u32x2*)((unsigned char*)J.dst + (size_t)(n + c) * J.K + k));
        return;
    }
#pragma unroll
    for (int c = 0; c < 4; ++c) {
        u32x4 w;
        w.x = cvt_pk_bf16(R[0][c] * s0[0], R[1][c] * s0[1]); w.y = cvt_pk_bf16(R[2][c] * s0[2], R[3][c] * s0[3]);
        w.z = cvt_pk_bf16(R[4][c] * s1[0], R[5][c] * s1[1]); w.w = cvt_pk_bf16(R[6][c] * s1[2], R[7][c] * s1[3]);
        __builtin_nontemporal_store(w, (u32x4*)(J.dst + (size_t)(n + c) * J.K + k));
    }
}

__device__ __forceinline__ void row_cvt(const float* src, bf16_t* dst, float* rs, int lane, unsigned char* dst8 = nullptr) {
    float ss = 0.f;
#pragma unroll
    for (int i = 0; i < 4; ++i) {
        const int c = (i * 64 + lane) * 8;
        const f32x4 a = *(const f32x4*)(src + c), b = *(const f32x4*)(src + c + 4);
        ss += a[0] * a[0] + a[1] * a[1] + a[2] * a[2] + a[3] * a[3] + b[0] * b[0] + b[1] * b[1] + b[2] * b[2] + b[3] * b[3];
        u32x4 w; w.x = cvt_pk_bf16(a[0], a[1]); w.y = cvt_pk_bf16(a[2], a[3]); w.z = cvt_pk_bf16(b[0], b[1]); w.w = cvt_pk_bf16(b[2], b[3]);
        *(u32x4*)(dst + c) = w;
        if (dst8) *(u32x2*)(dst8 + c) = pack_fp8x8(a[0], a[1], a[2], a[3], b[0], b[1], b[2], b[3]);
    }
    ss = wave_sum(ss);
    if (lane == 0) *rs = __builtin_amdgcn_rsqf(ss * (1.0f / DM) + NORM_EPS);
}

constexpr int SJ_GU = NEXP * 32 * 64, SJ_GU_P1 = 256 * 160, SJ_GU_P2 = SJ_GU_P1 + 256 * 64, SJ_DN = NEXP * 32 * 32;
constexpr int J_WIN = N1_TILES * 32, J_WOUT = 8 * 32, J_WQ = 2 * 32, J_WKV = 4 * 32, J_WOX = 8 * 8, J_GU = 16 * 32, J_DN = 8 * 32;
constexpr int TJ0 = J_WIN, TJ1 = TJ0 + J_WOUT, TJ2 = TJ1 + J_WQ, TJ3 = TJ2 + J_WKV, TJ_EARLY = TJ3 + J_WOX, TJ5 = TJ_EARLY + NEXP * J_GU, TJ_ALL = TJ5 + NEXP * J_DN;
__device__ __forceinline__ TJob tjob_decode(const Frame& F, int j) {
    TJob J; J.src2 = nullptr; J.scale = nullptr; J.src_ld = DM; J.K = DM; J.map = MAP_ID; J.f8 = 0;
    if (j < TJ0) { const int nt = j >> 5, kt = j & 31; J.src = F.I<float>(IN_W_IN); J.src_ld = DIN; J.scale = F.I<float>(IN_NORM_MIX); J.dst = F.W<bf16_t>(WS_WINT); J.map = MAP_WIN; J.n0 = nt * 256; J.k0 = kt * 64; J.f8 = nt < TL_P || (nt >= TL_G && nt < TL_QI); if (J.f8) J.dst += (size_t)nt * 128 * DM; }
    else if (j < TJ1) { const int q = j - TJ0, nt = q >> 5, kt = q & 31; J.src = F.I<float>(IN_W_OUT); J.dst = F.W<bf16_t>(WS_WOUTT); J.n0 = nt * 256; J.k0 = kt * 64; }
    else if (j < TJ2) { const int q = j - TJ1, nt = q >> 5, kt = q & 31; J.src = F.I<float>(IN_WQ_X); J.src_ld = 512; J.scale = F.I<float>(IN_NORM_XATTN); J.dst = F.W<bf16_t>(WS_WQT); J.n0 = nt * 256; J.k0 = kt * 64; }
    else if (j < TJ3) { const int q = j - TJ2, nt = q >> 5, kt = q & 31; J.src = F.I<float>(IN_WK_X); J.src2 = F.I<float>(IN_WV_X); J.src_ld = 512; J.scale = F.I<float>(IN_NORM_MEM); J.dst = F.W<bf16_t>(WS_WKVT); J.map = MAP_KV; J.n0 = nt * 256; J.k0 = kt * 64; }
    else if (j < TJ_EARLY) { const int q = j - TJ3, nt = q >> 3, kt = q & 7; J.src = F.I<float>(IN_WO_X); J.dst = F.W<bf16_t>(WS_WOXT); J.K = 512; J.n0 = nt * 256; J.k0 = kt * 64; }
    else if (j < TJ5) { const int q = j - TJ_EARLY, e = q / J_GU, r = q % J_GU, nt = r >> 5, kt = r & 31;
        J.src = F.I<float>(IN_W_GU) + (size_t)e * DM * 4096; J.src_ld = 4096; J.scale = F.I<float>(IN_NORM_FFN); J.dst = F.W<bf16_t>(WS_WGUT) + (size_t)e * 4096 * DM; J.map = MAP_GU; J.n0 = nt * 256; J.k0 = kt * 64; }
    else { const int q = j - TJ5, e = q / J_DN, r = q % J_DN, nt = r >> 5, kt = r & 31;
        J.src = F.I<float>(IN_W_DN) + (size_t)e * DFF * DM; J.dst = F.W<bf16_t>(WS_WDNT) + (size_t)e * DM * DFF; J.K = DFF; J.n0 = nt * 256; J.k0 = kt * 64; }
    return J;
}
template <int NS>
__device__ __forceinline__ void convert_weights(const Frame& F, int jlo, int jhi, int first, int step) {
    f32x4 R[NS][8]; TJob J[NS]; int jj[NS];
    const int wv = F.wave, ln = F.lane_();
    int j = jlo + first;
#pragma unroll
    for (int s = 0; s < NS - 1; ++s) { jj[s] = j; if (j < jhi) { J[s] = tjob_decode(F, j); tjob_load(J[s], wv, ln, R[s]); } j += step; }
    for (;;) {
        bool done = false;
#pragma unroll
        for (int s = 0; s < NS; ++s) {
            if (!done) {
                constexpr int dummy = 0; (void)dummy;
                const int sl = (s + NS - 1) % NS;
                jj[sl] = j; if (j < jhi) { J[sl] = tjob_decode(F, j); tjob_load(J[sl], wv, ln, R[sl]); } j += step;
                if (jj[s] >= jhi) done = true; else tjob_store(J[s], wv, ln, R[s]);
            }
        }
        if (done) break;
    }
}

__device__ __forceinline__ void p0_prologue(const Frame& F) {
    const int G = F.G, bid = F.bid;
    convert_weights<3>(F, 0, TJ_EARLY, bid, G);
    {   const int ln = F.lane_(); f32x4 cur[8], nxt[8];
        int r = bid * 8 + F.wave;
#define P0_SRC(rr) ((rr) < T ? F.I<float>(IN_X) + (size_t)(rr) * DM : F.I<float>(IN_MEM) + (size_t)((rr) - T) * DM)
#define P0_LOAD(R_, rr) do { const float* s_ = P0_SRC(rr); _Pragma("unroll") for (int i = 0; i < 4; ++i) { R_[2 * i] = *(const f32x4*)(s_ + (i * 64 + ln) * 8); R_[2 * i + 1] = *(const f32x4*)(s_ + (i * 64 + ln) * 8 + 4); } } while (0)
        if (r < T + NB * MEML) P0_LOAD(cur, r);
        for (; r < T + NB * MEML; r += G * 8) {
            const int rn = r + G * 8;
            if (rn < T + NB * MEML) P0_LOAD(nxt, rn);
            bf16_t* dst = r < T ? F.W<bf16_t>(WS_XB) + (size_t)r * DM : F.W<bf16_t>(WS_MEMB) + (size_t)(r - T) * DM;
            float* rsp = r < T ? F.W<float>(WS_RS0) + r : F.W<float>(WS_RSMEM) + (r - T);
            unsigned char* dst8 = r < T ? F.W<unsigned char>(WS_XB8) + (size_t)r * DM : nullptr;
            float ss = 0.f;
#pragma unroll
            for (int i = 0; i < 4; ++i) {
                const int c = (i * 64 + ln) * 8; const f32x4 a = cur[2 * i], b = cur[2 * i + 1];
                ss += a[0] * a[0] + a[1] * a[1] + a[2] * a[2] + a[3] * a[3] + b[0] * b[0] + b[1] * b[1] + b[2] * b[2] + b[3] * b[3];
                u32x4 w; w.x = cvt_pk_bf16(a[0], a[1]); w.y = cvt_pk_bf16(a[2], a[3]); w.z = cvt_pk_bf16(b[0], b[1]); w.w = cvt_pk_bf16(b[2], b[3]);
                *(u32x4*)(dst + c) = w;
                if (dst8) *(u32x2*)(dst8 + c) = pack_fp8x8(a[0], a[1], a[2], a[3], b[0], b[1], b[2], b[3]);
            }
            ss = wave_sum(ss);
            if (ln == 0) *rsp = __builtin_amdgcn_rsqf(ss * (1.0f / DM) + NORM_EPS);
#pragma unroll
            for (int i = 0; i < 8; ++i) cur[i] = nxt[i];
        }
#undef P0_LOAD
#undef P0_SRC
    }
    for (int i = bid * 512 + F.tid_(); i < T * 24; i += G * 512) {
        const int t = i / 24, f = i % 24;
        const float inv = f < 16 ? c_invfreq[f] : c_invfreq[2 * (f - 16)];
        const float ang = (float)F.I<int>(IN_POS)[t] * inv;
        double rev = (double)ang * 0.15915494309189533577; rev -= __builtin_rint(rev);
        const float rv = (float)rev;
        const float sn = __builtin_amdgcn_sinf(rv), cs = __builtin_amdgcn_cosf(rv);
        if (f < 16) { F.W<float>(WS_ROPEQK)[t * 32 + f] = cs; F.W<float>(WS_ROPEQK)[t * 32 + 16 + f] = sn; }
        else { F.W<float>(WS_ROPEI)[t * 16 + (f - 16)] = cs; F.W<float>(WS_ROPEI)[t * 16 + 8 + (f - 16)] = sn; }
    }
    for (int i = bid * 512 + F.tid_(); i < NEXP * DM; i += G * 512) {
        const int e = i / DM, k = i % DM;
        F.W<float>(WS_WRT)[i] = F.I<float>(IN_NORM_FFN)[k] * F.I<float>(IN_W_ROUTER)[k * NEXP + e];
    }
}

enum { KD_A = 0, KD_P, KD_G, KD_Q, KD_K, KD_V, KD_QI, KD_KI, KD_KVX };
struct SchedG1F {
    int G, c; const char* xb8; const char* wint;
    static constexpr int NT8 = TL_P + (TL_QI - TL_G);
    __device__ __forceinline__ bool next(int i, Unit& u) const {
        int L = i * G + c;
        if (G == 256) {
            if (i == 8) { if (c >= 176) return false; L = 2048 + c; }
            else if (i == 9) { if (c >= 80) return false; L = 2224 + c; }
            else if (i > 9) return false;
        }
        if (L >= 64 * NT8) return false;
        int pm, pn; pg8::tile_of(L, 64, NT8, pm, pn); if (pn >= TL_P) pn += TL_G - TL_P; u.pm = pm; u.pn = pn; u.a = xb8 + (size_t)pm * 256 * DM; u.b = wint + (size_t)pn * 256 * DM * 2;
        u.kind = pn < TL_P ? KD_A : pn < TL_Q ? KD_G : pn < TL_K ? KD_Q : pn < TL_V ? KD_K : KD_V; u.aux = 0; return true;
    }
};
struct SchedG1 {
    int G, c; const char* xb; const char* wint; const char* memb; const char* wkvt;
    __device__ __forceinline__ bool next(int i, Unit& u) const {
        constexpr int NT = N1_TILES - SchedG1F::NT8;
        const int L = i * G + c; constexpr int NW1 = 64 * NT;
        if (L < NW1) { int pm, pn; pg8::tile_of(L, 64, NT, pm, pn); pn = pn < TL_G - TL_P ? TL_P + pn : TL_QI + (pn - (TL_G - TL_P)); u.pm = pm; u.pn = pn; u.a = xb + (size_t)pm * 256 * DM * 2; u.b = wint + (size_t)pn * 256 * DM * 2;
            u.kind = pn < TL_P ? KD_A : pn < TL_G ? KD_P : pn < TL_Q ? KD_G : pn < TL_K ? KD_Q : pn < TL_V ? KD_K : pn < TL_QI ? KD_V : pn < TL_KI ? KD_QI : KD_KI; u.aux = 0; return true; }
        const int q = L - NW1; if (q >= 16) return false;
        u.pm = q & 3; u.pn = q >> 2; u.a = memb + (size_t)u.pm * 256 * DM * 2; u.b = wkvt + (size_t)u.pn * 256 * DM * 2; u.kind = KD_KVX; u.aux = 0; return true;
    }
};
__device__ __forceinline__ void st_bf16x8(bf16_t* p, const f32x4& a, const f32x4& b) {
    u32x4 w; w.x = cvt_pk_bf16(a[0], a[1]); w.y = cvt_pk_bf16(a[2], a[3]); w.z = cvt_pk_bf16(b[0], b[1]); w.w = cvt_pk_bf16(b[2], b[3]);
    *(u32x4*)p = w;
}
struct EpiG1 {
    const float* rs0; const float* rsmem; const float* ropeqk; const float* ropei;
    bf16_t* abuf; bf16_t* pbuf; bf16_t* gabuf; bf16_t* qb; bf16_t* kb; bf16_t* vb; bf16_t* qib; bf16_t* kib; float* wib; bf16_t* kx; bf16_t* vx; float sc;
    struct Pre { };
    __device__ __forceinline__ Pre pre(const Unit&, int, int, int, int) const { return Pre{}; }
    __device__ __forceinline__ void operator()(const f32x4 (&acc)[2][2][4][2], const Unit& u, int wr, int wc, int fr, int fq, const Pre&) const {
        const int kind = u.kind, pn = u.pn;
        const int cw = 32 * wc + 8 * fq;
        const int rowb = u.pm * 256 + wr * 64 + fr;
        float rsv[8];
        { const float* rsp = (kind == KD_KVX) ? rsmem : rs0;
#pragma unroll
          for (int q = 0; q < 8; ++q) rsv[q] = rsp[rowb + (q >> 2) * 128 + (q & 3) * 16] * sc; }
        const bool rotqk = (kind == KD_Q || kind == KD_K) && (wc == 0);
        const bool roti = (kind == KD_QI && ((wc & 1) == 0) && fq < 2) || (kind == KD_KI && wc == 0 && fq < 2);
#pragma unroll
        for (int ai = 0; ai < 2; ++ai) {
            f32x4 cs[4], sn[4];
#pragma unroll
            for (int q = 0; q < 4; ++q) { cs[q] = (f32x4){1.f, 1.f, 1.f, 1.f}; sn[q] = (f32x4){0.f, 0.f, 0.f, 0.f}; }
            if (rotqk) {
#pragma unroll
                for (int q = 0; q < 4; ++q) { const float* tp = ropeqk + (size_t)(rowb + ai * 128 + q * 16) * 32 + 4 * fq; cs[q] = *(const f32x4*)tp; sn[q] = *(const f32x4*)(tp + 16); }
            } else if (roti) {
#pragma unroll
                for (int q = 0; q < 4; ++q) { const float* tp = ropei + (size_t)(rowb + ai * 128 + q * 16) * 16 + 4 * fq; cs[q] = *(const f32x4*)tp; sn[q] = *(const f32x4*)(tp + 8); }
            }
#pragma unroll
            for (int m = 0; m < 4; ++m) {
                const int row = rowb + ai * 128 + m * 16, q = m;
                const float rs = rsv[ai * 4 + m];
                if (kind == KD_KVX) {
                    bf16_t* o = (pn < 2 ? kx : vx) + (size_t)row * 512 + 256 * (pn & 1) + cw;
#pragma unroll
                    for (int bj = 0; bj < 2; ++bj) st_bf16x8(o + 128 * bj, acc[ai][bj][m][0] * rs, acc[ai][bj][m][1] * rs);
                } else if (kind == KD_A) {
                    st_bf16x8(abuf + (size_t)row * DM + 128 * (pn - TL_A) + cw, acc[ai][0][m][0] * rs * sigmoid4(acc[ai][1][m][0], rs), acc[ai][0][m][1] * rs * sigmoid4(acc[ai][1][m][1], rs));
                } else if (kind == KD_P) {
                    const float r2 = rs * rs;
                    st_bf16x8(pbuf + (size_t)row * DM + 128 * (pn - TL_P) + cw, acc[ai][0][m][0] * acc[ai][1][m][0] * r2, acc[ai][0][m][1] * acc[ai][1][m][1] * r2);
                } else if (kind == KD_G) {
#pragma unroll
                    for (int bj = 0; bj < 2; ++bj)
                        st_bf16x8(gabuf + (size_t)row * DM + 256 * (pn - TL_G) + 128 * bj + cw, sigmoid4(acc[ai][bj][m][0], rs), sigmoid4(acc[ai][bj][m][1], rs));
                } else if (kind == KD_Q || kind == KD_K) {
                    bf16_t* o = (kind == KD_Q) ? qb + (size_t)row * DM + 256 * (pn - TL_Q) + cw : kb + (size_t)row * 512 + 256 * (pn - TL_K) + cw;
#pragma unroll
                    for (int bj = 0; bj < 2; ++bj) {
                        const f32x4 x1 = acc[ai][bj][m][0] * rs, x2 = acc[ai][bj][m][1] * rs;
                        if (rotqk) st_bf16x8(o + 128 * bj, x1 * cs[q] - x2 * sn[q], x2 * cs[q] + x1 * sn[q]);
                        else st_bf16x8(o + 128 * bj, x1, x2);
                    }
                } else if (kind == KD_V) {
#pragma unroll
                    for (int bj = 0; bj < 2; ++bj) st_bf16x8(vb + (size_t)row * 512 + 256 * (pn - TL_V) + 128 * bj + cw, acc[ai][bj][m][0] * rs, acc[ai][bj][m][1] * rs);
                } else if (kind == KD_QI) {
#pragma unroll
                    for (int bj = 0; bj < 2; ++bj) {
                        const f32x4 x1 = acc[ai][bj][m][0] * rs, x2 = acc[ai][bj][m][1] * rs;
                        bf16_t* o = qib + (size_t)row * 1024 + 256 * (pn - TL_QI) + 128 * bj + cw;
                        if (roti) st_bf16x8(o, x1 * cs[q] - x2 * sn[q], x2 * cs[q] + x1 * sn[q]); else st_bf16x8(o, x1, x2);
                    }
                } else {
                    const f32x4 x1 = acc[ai][0][m][0] * rs, x2 = acc[ai][0][m][1] * rs;
                    if (wc < 2) {
                        if (roti) st_bf16x8(kib + (size_t)row * 64 + cw, x1 * cs[q] - x2 * sn[q], x2 * cs[q] + x1 * sn[q]);
                        else st_bf16x8(kib + (size_t)row * 64 + cw, x1, x2);
                    } else if (wc == 2 && fq < 2) {
                        *(f32x4*)(wib + (size_t)row * 16 + 8 * fq) = x1 * 0.03125f; *(f32x4*)(wib + (size_t)row * 16 + 8 * fq + 4) = x2 * 0.03125f;
                    }
                }
            }
        }
    }
};

struct SchedDense { int G, c, nM, nN; const char* A; const char* Bt; size_t tstep;
    __device__ __forceinline__ bool next(int i, Unit& u) const {
        const int L = i * G + c; if (L >= nM * nN) return false;
        int pm, pn; pg8::tile_of(L, nM, nN, pm, pn); u.pm = pm; u.pn = pn; u.a = A + (size_t)pm * tstep; u.b = Bt + (size_t)pn * tstep; u.kind = 0; u.aux = 0; return true; }
};
template <bool RF32>
struct EpiResid { const void* resid; bf16_t* hb; float* ss;
    struct Pre { };
    __device__ __forceinline__ Pre pre(const Unit&, int, int, int, int) const { return Pre{}; }
    __device__ __forceinline__ void operator()(const f32x4 (&acc)[2][2][4][2], const Unit& u, int wr, int wc, int fr, int fq, const Pre&) const {
        const size_t off0 = (size_t)(u.pm * 256 + wr * 64 + fr) * DM + u.pn * 256 + 32 * wc + 8 * fq;
        u32x4 rb[2][4][2];
        if (!RF32) {
#pragma unroll
            for (int ai = 0; ai < 2; ++ai)
#pragma unroll
                for (int m = 0; m < 4; ++m)
#pragma unroll
                    for (int bj = 0; bj < 2; ++bj) rb[ai][m][bj] = *(const u32x4*)((const bf16_t*)resid + off0 + (size_t)(ai * 128 + m * 16) * DM + 128 * bj);
        }
#pragma unroll
        for (int ai = 0; ai < 2; ++ai) {
            f32x4 r0[4][2], r1[4][2];
#pragma unroll
            for (int m = 0; m < 4; ++m)
#pragma unroll
                for (int bj = 0; bj < 2; ++bj) {
                    const size_t off = off0 + (size_t)(ai * 128 + m * 16) * DM + 128 * bj;
                    if (RF32) { r0[m][bj] = *(const f32x4*)((const float*)resid + off); r1[m][bj] = *(const f32x4*)((const float*)resid + off + 4); }
                    else { const u32x4 rbv = rb[ai][m][bj];
                        r0[m][bj] = (f32x4){bf_lo(rbv.x), bf_hi(rbv.x), bf_lo(rbv.y), bf_hi(rbv.y)}; r1[m][bj] = (f32x4){bf_lo(rbv.z), bf_hi(rbv.z), bf_lo(rbv.w), bf_hi(rbv.w)}; }
                }
#pragma unroll
            for (int m = 0; m < 4; ++m) {
                const int row = u.pm * 256 + ai * 128 + wr * 64 + m * 16 + fr; float sq = 0.f;
#pragma unroll
                for (int bj = 0; bj < 2; ++bj) {
                    const size_t off = off0 + (size_t)(ai * 128 + m * 16) * DM + 128 * bj;
                    const f32x4 v0 = acc[ai][bj][m][0] + r0[m][bj], v1 = acc[ai][bj][m][1] + r1[m][bj];
                    st_bf16x8(hb + off, v0, v1);
                    sq += v0[0] * v0[0] + v0[1] * v0[1] + v0[2] * v0[2] + v0[3] * v0[3] + v1[0] * v1[0] + v1[1] * v1[1] + v1[2] * v1[2] + v1[3] * v1[3];
                }
                if (ss) { sq += __shfl_xor(sq, 16); sq += __shfl_xor(sq, 32); if (fq == 0) atomicAdd(ss + row, sq); }
            }
        }
    }
};
struct EpiScaleBf16 { const float* ss; bf16_t* out; int ldo;
    struct Pre { float rsv[8]; };
    __device__ __forceinline__ Pre pre(const Unit& u, int wr, int wc, int fr, int fq) const {
        Pre p;
#pragma unroll
        for (int q = 0; q < 8; ++q) p.rsv[q] = ss[u.pm * 256 + (q >> 2) * 128 + wr * 64 + (q & 3) * 16 + fr];
        return p;
    }
    __device__ __forceinline__ void operator()(const f32x4 (&acc)[2][2][4][2], const Unit& u, int wr, int wc, int fr, int fq, const Pre& pr) const {
        const float (&rsv)[8] = pr.rsv;
#pragma unroll
        for (int ai = 0; ai < 2; ++ai)
#pragma unroll
            for (int m = 0; m < 4; ++m) {
                const int row = u.pm * 256 + ai * 128 + wr * 64 + m * 16 + fr; const float rs = __builtin_amdgcn_rsqf(rsv[ai * 4 + m] * (1.0f / DM) + NORM_EPS);
#pragma unroll
                for (int bj = 0; bj < 2; ++bj) st_bf16x8(out + (size_t)row * ldo + u.pn * 256 + 128 * bj + 32 * wc + 8 * fq, acc[ai][bj][m][0] * rs, acc[ai][bj][m][1] * rs);
            }
    }
};

namespace att {
constexpr int D = 128, NW = 8, QBLK = 32, KVBLK = 64, QB = NW * QBLK;
constexpr int SHM_V = KVBLK * D * 2, SHM_K = KVBLK * D * 2;
constexpr int LDS_QOFF = 2 * SHM_V + 2 * SHM_K + NW * 64 * 4;
constexpr int LDS_BYTES_ATT = LDS_QOFF + NW * 8192;
static_assert(LDS_BYTES_ATT <= 135168, "attention LDS map");
constexpr float SCALE = 0.08838834764831845f;
constexpr float THR = 8.f;
typedef short s16x4 __attribute__((ext_vector_type(4)));
#define KSWZ(row, colB) ((row) * 256 + ((colB) ^ (((row) & 7) << 4)))
#define SBAR() __builtin_amdgcn_sched_barrier(0)
__device__ __forceinline__ int v_st(int k, int c) { const int kk = (k & ~0xC) | ((k & 4) << 1) | ((k & 8) >> 1); return ((kk >> 3) * 4 + (c >> 5)) * 512 + ((kk & 7) * 32 + (c & 31)) * 2; }
__device__ __forceinline__ int v_rd_base(int lane) { return ((lane & 3) << 3) | (((lane >> 2) & 3) << 6) | (((lane >> 4) & 1) << 5) | (((lane >> 5) & 1) << 8); }
constexpr int v_rd_off(int d0, int ks, int half) { return d0 * 512 + ks * 4096 + half * 2048; }
__device__ __forceinline__ int crow(int r, int hi) { return (r & 3) + 8 * (r >> 2) + 4 * hi; }
__device__ __forceinline__ bf16x8 load8(const bf16_t* p) { return *reinterpret_cast<const bf16x8*>(p); }
__device__ __forceinline__ void mask_tile(f32x16& p0, f32x16& p1, int dq, unsigned W) {
    const float NEG = -__builtin_inff();
#pragma unroll
    for (int r = 0; r < 16; ++r) {
        const int c = (r & 3) + 8 * (r >> 2);
        if ((unsigned)(dq - c) >= W) p0[r] = NEG;
        if ((unsigned)(dq - c - 32) >= W) p1[r] = NEG;
    }
}
__device__ __forceinline__ unsigned sel_bit_mask(unsigned w, int b) { unsigned m; asm("v_bfe_i32 %0, %1, %2, 1" : "=v"(m) : "v"(w), "n"(b)); return m; }
template <bool SEL>
__device__ __forceinline__ void partialSM(f32x16& p0, f32x16& p1, float& m_reg, float& mn, float& alpha, unsigned selw) {
    float pmax = p0[0];
#pragma unroll
    for (int r = 1; r < 16; ++r) pmax = fmaxf(pmax, p0[r]);
#pragma unroll
    for (int r = 0; r < 16; ++r) pmax = fmaxf(pmax, p1[r]);
    { auto rr = __builtin_amdgcn_permlane32_swap(__float_as_uint(pmax), __float_as_uint(pmax), false, false);
      pmax = fmaxf(__uint_as_float(rr[0]), __uint_as_float(rr[1])); }
    constexpr float C2 = 1.4426950408889634f * SCALE;
    if (__builtin_expect(__all((pmax - m_reg) * SCALE <= THR), 1)) { mn = m_reg; alpha = 1.f; }
    else { mn = fmaxf(m_reg, pmax); alpha = __builtin_amdgcn_exp2f((m_reg - mn) * C2); m_reg = mn; }
    const float mnL = -mn * C2;
#pragma unroll
    for (int r = 0; r < 16; ++r) p0[r] = fmaf(p0[r], C2, mnL);
#pragma unroll
    for (int r = 0; r < 16; ++r) p1[r] = fmaf(p1[r], C2, mnL);
#pragma unroll
    for (int r = 0; r < 16; ++r) p0[r] = __builtin_amdgcn_exp2f(p0[r]);
    if (SEL) {
#pragma unroll
        for (int r = 0; r < 16; ++r) p0[r] = __uint_as_float(__float_as_uint(p0[r]) & sel_bit_mask(selw, r));
    }
}
template <bool SEL>
__device__ __forceinline__ void finishSM(f32x16& p0, f32x16& p1, float alpha, float& l_reg, bf16x8& pa0, bf16x8& pa1, bf16x8& pa2, bf16x8& pa3, unsigned selw) {
#pragma unroll
    for (int r = 0; r < 16; ++r) p1[r] = __builtin_amdgcn_exp2f(p1[r]);
    if (SEL) {
#pragma unroll
        for (int r = 0; r < 16; ++r) p1[r] = __uint_as_float(__float_as_uint(p1[r]) & sel_bit_mask(selw, 16 + r));
    }
    float ps = 0;
#pragma unroll
    for (int r = 0; r < 16; ++r) ps += p0[r];
#pragma unroll
    for (int r = 0; r < 16; ++r) ps += p1[r];
    { auto rr = __builtin_amdgcn_permlane32_swap(__float_as_uint(ps), __float_as_uint(ps), false, false);
      ps = __uint_as_float(rr[0]) + __uint_as_float(rr[1]); }
    l_reg = l_reg * alpha + ps;
#define PK4(P, B_, OUT) do { unsigned a0 = cvt_pk_bf16(P[B_+0], P[B_+1]), a1 = cvt_pk_bf16(P[B_+2], P[B_+3]);                          \
        unsigned b0 = cvt_pk_bf16(P[B_+4], P[B_+5]), b1 = cvt_pk_bf16(P[B_+6], P[B_+7]);                                             \
        auto r0 = __builtin_amdgcn_permlane32_swap(a0, b0, false, false); auto r1 = __builtin_amdgcn_permlane32_swap(a1, b1, false, false); \
        u32x4 w = {r0[0], r1[0], r0[1], r1[1]}; OUT = *reinterpret_cast<bf16x8*>(&w); } while (0)
    PK4(p0, 0, pa0); PK4(p0, 8, pa1); PK4(p1, 0, pa2); PK4(p1, 8, pa3);
#undef PK4
}
template <int KB, int QREG>
__device__ __forceinline__ void qkt(f32x16& p0, f32x16& p1, const char* K_lds, int r32, int hi, const bf16x8* qr, const char* qlds) {
    p0 = f32x16{}; p1 = f32x16{};
    const char* kb[4];
#pragma unroll
    for (int dd = 0; dd < 4; ++dd) kb[dd] = K_lds + KB * SHM_K + KSWZ(r32, (dd * 16 + hi * 8) * 2);
#pragma unroll
    for (int d0 = 0; d0 < 8; ++d0) { const char* a = kb[d0 & 3] + (d0 >> 2) * 128;
        bf16x8 b0 = *reinterpret_cast<const bf16x8*>(a);
        bf16x8 b1 = *reinterpret_cast<const bf16x8*>(a + 32 * 256);
        const bf16x8 qf = (d0 < QREG) ? qr[d0 < QREG ? d0 : 0] : *reinterpret_cast<const bf16x8*>(qlds + (d0 - QREG) * 1024);
        p0 = __builtin_amdgcn_mfma_f32_32x32x16_bf16(b0, qf, p0, 0, 0, 0);
        p1 = __builtin_amdgcn_mfma_f32_32x32x16_bf16(b1, qf, p1, 0, 0, 0); }
}
template <int VB>
__device__ __forceinline__ void pv_tile(f32x16* o, int vb0, bf16x8 pa0, bf16x8 pa1, bf16x8 pa2, bf16x8 pa3) {
#define TRRD(dst, off) asm volatile("ds_read_b64_tr_b16 %0, %1 offset:%2" : "=&v"(dst) : "v"(vb0), "i"(off) : "memory")
#define PV_D0(d0) do { s16x4 l0, l1, l2, l3, h0, h1, h2, h3; constexpr int b_ = VB * SHM_V + v_rd_off(d0, 0, 0); \
        TRRD(l0, b_); TRRD(h0, b_ + 2048); TRRD(l1, b_ + 4096); TRRD(h1, b_ + 6144); TRRD(l2, b_ + 8192); TRRD(h2, b_ + 10240); TRRD(l3, b_ + 12288); TRRD(h3, b_ + 14336); \
        asm volatile("s_waitcnt lgkmcnt(0)" ::: "memory"); SBAR(); \
        o[d0] = __builtin_amdgcn_mfma_f32_32x32x16_bf16(pa0, (bf16x8){l0[0], l0[1], l0[2], l0[3], h0[0], h0[1], h0[2], h0[3]}, o[d0], 0, 0, 0);   \
        o[d0] = __builtin_amdgcn_mfma_f32_32x32x16_bf16(pa1, (bf16x8){l1[0], l1[1], l1[2], l1[3], h1[0], h1[1], h1[2], h1[3]}, o[d0], 0, 0, 0);   \
        o[d0] = __builtin_amdgcn_mfma_f32_32x32x16_bf16(pa2, (bf16x8){l2[0], l2[1], l2[2], l2[3], h2[0], h2[1], h2[2], h2[3]}, o[d0], 0, 0, 0);   \
        o[d0] = __builtin_amdgcn_mfma_f32_32x32x16_bf16(pa3, (bf16x8){l3[0], l3[1], l3[2], l3[3], h3[0], h3[1], h3[2], h3[3]}, o[d0], 0, 0, 0); } while (0)
    PV_D0(0); PV_D0(1); PV_D0(2); PV_D0(3);
#undef PV_D0
#undef TRRD
}
struct BlockRef { const bf16_t* Q; const bf16_t* K; const bf16_t* V; bf16_t* O; const unsigned* M; int P0; };
struct MergeArgs { unsigned char* ws; const float* cw; };
struct Seam { bf16x8 qr[8]; bf16x8 st_v0, st_v1, st_k0, st_k1; };
__device__ __forceinline__ int swa_jlo(int P0, int W) { const int lowk = P0 - W + 1; return lowk > 0 ? lowk / KVBLK : 0; }
#define ROW(p, k0, rr) ((p) + (size_t)((k0) + (rr)) * KS + sc)
#define VMW() asm volatile("s_waitcnt vmcnt(0)" ::: "memory")
#define VMWN(n) asm volatile("s_waitcnt vmcnt(%0)" :: "i"(n) : "memory")
#define SLOAD_H(Kp, Vp, k0) do { S.st_v0 = load8(ROW(Vp, k0, sr)); S.st_v1 = load8(ROW(Vp, k0, 32 + sr));              \
                         S.st_k0 = load8(ROW(Kp, k0, sr)); S.st_k1 = load8(ROW(Kp, k0, 32 + sr)); } while (0)
#define SWRITE_HK(bf) do { *(bf16x8*)(K_lds + (bf) * SHM_K + kws) = S.st_k0; *(bf16x8*)(K_lds + (bf) * SHM_K + kws + 32 * 256) = S.st_k1; } while (0)
#define SWRITE_HV(bf) do { *(bf16x8*)(V_lds + (bf) * SHM_V + vst0) = S.st_v0; *(bf16x8*)(V_lds + (bf) * SHM_V + vst1) = S.st_v1; } while (0)
#define SWRITE_H(bf) do { SWRITE_HV(bf); SWRITE_HK(bf); } while (0)
template <int QS, int KS>
__device__ __forceinline__ void attn_prime(const BlockRef& cur, int W, char* lds, Seam& S, const int wid) {
    const int lane = lane_id(), tid = wid * 64 + lane, r32 = lane & 31, hi = lane >> 5;
    const int sr = tid >> 4, sc = (tid & 15) * 8, kws = KSWZ(sr, sc * 2); char* K_lds = lds + 2 * SHM_V;
    const int kb0 = swa_jlo(cur.P0, W) * KVBLK;
#pragma unroll
    for (int d0 = 0; d0 < 8; ++d0) S.qr[d0] = load8(cur.Q + (size_t)(wid * QBLK + r32) * QS + d0 * 16 + hi * 8);
    SLOAD_H(cur.K, cur.V, kb0); VMW(); SWRITE_HK(0);
    __syncthreads();
}
template <int QS, int KS, int OS, bool SEL, int QREG, bool MERGE>
__device__ __forceinline__ void attn_block(const BlockRef& cur, const BlockRef& nxt, int skv, int W, char* lds, Seam& S, const MergeArgs& MG, const int wid) {
    const int lane = lane_id(), tid = wid * 64 + lane, r32 = lane & 31, hi = lane >> 5;
    const int j_lo = swa_jlo(cur.P0, W);
    int j_hi = (cur.P0 + QB - 1) / KVBLK + 1; if (j_hi > skv / KVBLK) j_hi = skv / KVBLK;
    const int NT = j_hi - j_lo;
    const int kbn = swa_jlo(nxt.P0, W) * KVBLK;
    const int qlo = cur.P0 + wid * QBLK, qm = qlo + r32 - 4 * hi;
    char* V_lds = lds; char* K_lds = lds + 2 * SHM_V;
    float* ws = (float*)(lds + 2 * SHM_V + 2 * SHM_K) + wid * 64; float* li_l = ws, * al_l = ws + 32;
    float m_reg = -1e30f, l_reg = 0; f32x16 o[4] = {};
    const int sr = tid >> 4, sc = (tid & 15) * 8, vst0 = v_st(sr, sc), vst1 = v_st(32 + sr, sc), kws = KSWZ(sr, sc * 2);
    const int vb0 = (int)(uintptr_t)V_lds + v_rd_base(lane);
    const bf16_t* Kh = cur.K; const bf16_t* Vh = cur.V;
    const unsigned moff = (unsigned)((wid * QBLK + r32) * 128 + hi);
#define RESC(a) do { if (__any((a) < 1.f)) { if (hi == 0) al_l[r32] = (a); asm volatile("s_waitcnt lgkmcnt(0)" ::: "memory");              \
                     for (int d_ = 0; d_ < 4; ++d_) for (int r = 0; r < 16; ++r) o[d_][r] *= al_l[crow(r, hi)]; } } while (0)
#define KBASE(t) ((j_lo + (t)) * KVBLK)
#define MLOAD(t) (SEL ? cur.M[moff + 2u * (unsigned)(j_lo + (t))] : 0u)
#define MASKT(P0_, P1_, t) do { } while (0)
    constexpr int NQL = 8;
#define SEAM_K0() do { VMWN(NQL); SWRITE_HK(0); SBAR(); } while (0)
    f32x16 pA0, pA1, pB0, pB1; float mnA, mnB, alA, alB; bf16x8 pa0, pa1, pa2, pa3; unsigned mwA = 0u, mwB = 0u;
    const char* qlds = lds + LDS_QOFF + wid * 8192 + lane * 16;
    if (QREG < 8) {
#pragma unroll
        for (int d0 = QREG; d0 < 8; ++d0) *(bf16x8*)(lds + LDS_QOFF + wid * 8192 + lane * 16 + (d0 - QREG) * 1024) = S.qr[d0];
    }
    SWRITE_HV(0); SBAR();
    mwA = MLOAD(0);
    if (NT > 1) { SLOAD_H(Kh, Vh, KBASE(1)); }
    SBAR(); qkt<0, QREG>(pA0, pA1, K_lds, r32, hi, S.qr, qlds);
    MASKT(pA0, pA1, 0); partialSM<SEL>(pA0, pA1, m_reg, mnA, alA, mwA);
    if (NT > 1) { VMW(); SWRITE_H(1); }
    __syncthreads();
#define HALF_STEP(PX0, PX1, mnX, alX, mwX, PY0, PY1, alY, mwY, t, KB, VB, SB) do {                                            \
        SBAR(); qkt<KB, QREG>(PX0, PX1, K_lds, r32, hi, S.qr, qlds);                                                                     \
        finishSM<SEL>(PY0, PY1, alY, l_reg, pa0, pa1, pa2, pa3, mwY); SBAR();                                                 \
        mwX = MLOAD(t);                                                                                                       \
        if ((t) + 1 < NT) { SLOAD_H(Kh, Vh, KBASE((t) + 1)); SBAR(); }                                                        \
        pv_tile<VB>(o, vb0, pa0, pa1, pa2, pa3); MASKT(PX0, PX1, (t)); partialSM<SEL>(PX0, PX1, m_reg, mnX, alX, mwX);        \
        __syncthreads();                                                                                                      \
        if ((t) + 1 < NT) { VMW(); SWRITE_H(SB); }                                                                            \
        RESC(alX); __syncthreads(); } while (0)
    for (int t = 1; t + 1 < NT; t += 2) {
        HALF_STEP(pB0, pB1, mnB, alB, mwB, pA0, pA1, alA, mwA, t, 1, 0, 0);
        HALF_STEP(pA0, pA1, mnA, alA, mwA, pB0, pB1, alB, mwB, t + 1, 0, 1, 1);
    }
    const bool even = (NT & 1) == 0;
    if (even) { SBAR(); mwB = MLOAD(NT - 1); qkt<1, QREG>(pB0, pB1, K_lds, r32, hi, S.qr, qlds); SBAR(); }
    SLOAD_H(nxt.K, nxt.V, kbn); SBAR();
#pragma unroll
    for (int d0 = 0; d0 < 8; ++d0) S.qr[d0] = load8(nxt.Q + (size_t)(wid * QBLK + r32) * QS + d0 * 16 + hi * 8);
    SBAR();
    finishSM<SEL>(pA0, pA1, alA, l_reg, pa0, pa1, pa2, pa3, mwA); SBAR();
    pv_tile<0>(o, vb0, pa0, pa1, pa2, pa3);
    if (even) { MASKT(pB0, pB1, NT - 1); partialSM<SEL>(pB0, pB1, m_reg, mnB, alB, mwB); __syncthreads(); RESC(alB);
        finishSM<SEL>(pB0, pB1, alB, l_reg, pa0, pa1, pa2, pa3, mwB); SBAR(); pv_tile<1>(o, vb0, pa0, pa1, pa2, pa3); }
    SBAR(); SEAM_K0();
    if (hi == 0) li_l[r32] = l_reg; asm volatile("s_waitcnt lgkmcnt(0)" ::: "memory");
    float rli[16];
#pragma unroll
    for (int r = 0; r < 16; ++r) rli[r] = __builtin_amdgcn_rcpf(li_l[crow(r, hi)]);
    {
        char* stg = lds + LDS_QOFF + wid * 8192;
#pragma unroll
        for (int r = 0; r < 16; ++r) { const int orow = crow(r, hi);
#pragma unroll
            for (int d0 = 0; d0 < 4; ++d0) { const float v = o[d0][r] * rli[r];
                const float vn = __shfl_xor(v, 1);
                if ((r32 & 1) == 0) *(unsigned*)(stg + orow * 256 + (d0 * 32 + r32) * 2) = cvt_pk_bf16(v, vn); } }
        asm volatile("s_waitcnt lgkmcnt(0)" ::: "memory");
        const int ch = lane & 15, rq = lane >> 4;
        if (!MERGE) {
            bf16_t* Ow = cur.O + (size_t)(wid * QBLK) * OS + ch * 8;
#pragma unroll
            for (int p = 0; p < 8; ++p) { const int row = 4 * p + rq; *(u32x4*)(Ow + (size_t)row * OS) = *(const u32x4*)(stg + row * 256 + ch * 16); }
        } else {
            const bf16_t* Obase = (const bf16_t*)(MG.ws + WS_YATT); const bf16_t* MA = (const bf16_t*)(MG.ws + WS_ABUF); const bf16_t* MP = (const bf16_t*)(MG.ws + WS_PBUF);
            const bf16_t* MGA = (const bf16_t*)(MG.ws + WS_GABUF); bf16_t* MOUT = (bf16_t*)(MG.ws + WS_MERGED);
            const size_t eoff = (size_t)(cur.O - Obase) + (size_t)(wid * QBLK) * OS + ch * 8;
            const int colg = (int)((cur.O - Obase) % OS) + ch * 8;
            float w0[8], w1[8], w2[8];
#pragma unroll
            for (int j = 0; j < 8; ++j) { w0[j] = MG.cw[colg + j]; w1[j] = MG.cw[OS + colg + j]; w2[j] = MG.cw[2 * OS + colg + j]; }
            u32x4 ca, cga, cp2, cp1, cp0, na, nga, np2, np1, np0;
#define MG_LOAD(p_, A_, GA_, P2_, P1_, P0_) do { const int row_ = 4 * (p_) + rq, spos_ = cur.P0 + wid * QBLK + row_; const size_t e_ = eoff + (size_t)row_ * OS; \
                A_ = *(const u32x4*)(MA + e_); GA_ = *(const u32x4*)(MGA + e_); P2_ = *(const u32x4*)(MP + e_); \
                P1_ = (u32x4){0u, 0u, 0u, 0u}; P0_ = (u32x4){0u, 0u, 0u, 0u}; \
                if (spos_ >= 1) P1_ = *(const u32x4*)(MP + e_ - OS); if (spos_ >= 2) P0_ = *(const u32x4*)(MP + e_ - 2 * OS); } while (0)
            MG_LOAD(0, ca, cga, cp2, cp1, cp0);
#pragma unroll 1
            for (int p = 0; p < 8; ++p) {
                const int row = 4 * p + rq;
                const size_t e = eoff + (size_t)row * OS;
                const u32x4 y = *(const u32x4*)(stg + row * 256 + ch * 16);
                if (p < 7) MG_LOAD(p + 1, na, nga, np2, np1, np0);
                float ov[8];
#pragma unroll
                for (int j = 0; j < 4; ++j) {
                    ov[2 * j] = bf_lo(ca[j]) * (w0[2 * j] * bf_lo(cp0[j]) + w1[2 * j] * bf_lo(cp1[j]) + w2[2 * j] * bf_lo(cp2[j])) + bf_lo(cga[j]) * bf_lo(y[j]);
                    ov[2 * j + 1] = bf_hi(ca[j]) * (w0[2 * j + 1] * bf_hi(cp0[j]) + w1[2 * j + 1] * bf_hi(cp1[j]) + w2[2 * j + 1] * bf_hi(cp2[j])) + bf_hi(cga[j]) * bf_hi(y[j]);
                }
                u32x4 wv_; wv_.x = cvt_pk_bf16(ov[0], ov[1]); wv_.y = cvt_pk_bf16(ov[2], ov[3]); wv_.z = cvt_pk_bf16(ov[4], ov[5]); wv_.w = cvt_pk_bf16(ov[6], ov[7]);
                *(u32x4*)(MOUT + e) = wv_;
                ca = na; cga = nga; cp2 = np2; cp1 = np1; cp0 = np0;
            }
#undef MG_LOAD
        }
    }
    __syncthreads();
#undef RESC
#undef KBASE
#undef MLOAD
#undef MASKT
#undef SEAM_K0
#undef HALF_STEP
}
#undef ROW
#undef VMW
#undef VMWN
#undef SLOAD_H
#undef SWRITE_HK
#undef SWRITE_HV
#undef SWRITE_H

enum { ORDER_NATURAL = 0, ORDER_PAIRED = 2, ORDER_XCD = 4, ORDER_LPT = 8 };
struct AttnItem { int bh, qb0, qb1; };
__device__ __forceinline__ AttnItem attn_decode(int L, int nb, int nh, int nhkv, int nqb, int nx, int order) {
    const int G = nh / nhkv; AttnItem it; int x;
    if ((order & ORDER_XCD) && (nb * nhkv) % 8 == 0) { const int xcd = L & 7, k = L >> 3, per = G * nx, gi = k / per, r = k - gi * per;
        it.bh = (gi * 8 + xcd) * G + r / nx; x = r % nx; }
    else { it.bh = L / nx; x = L - it.bh * nx; }
    if (order & ORDER_PAIRED) { it.qb0 = x; it.qb1 = nqb - 1 - x; }
    else { it.qb0 = it.qb1 = x; }
    return it;
}
struct AttnTensors { const bf16_t* Q; const bf16_t* K; const bf16_t* V; bf16_t* O; const unsigned* M; };
template <int QS, int KS, int OS>
__device__ __forceinline__ BlockRef attn_ref(const AttnItem& it, int pass, const AttnTensors& X, int nh, int nhkv, int sq, int skv, int p0base) {
    const int qb = pass ? it.qb1 : it.qb0, b = it.bh / nh, h = it.bh - b * nh, kvh = h / (nh / nhkv);
    BlockRef r; const size_t t0 = (size_t)b * sq + (size_t)qb * QB;
    r.Q = X.Q + t0 * QS + h * D; r.O = X.O + t0 * OS + h * D;
    r.K = X.K + (size_t)b * skv * KS + kvh * D; r.V = X.V + (size_t)b * skv * KS + kvh * D;
    r.M = X.M ? X.M + t0 * 128 : nullptr; r.P0 = p0base + qb * QB;
    return r;
}
__device__ __forceinline__ int attn_kmax(int stride, int order, int nb, int nh, int nhkv, int nqb, int nx) {
    if (order & ORDER_LPT) { const int G = nh / nhkv, rg = (G * nqb + stride - 1) / stride; return rg * (nb * nhkv / 8); }
    return (nx * nb * nh + stride - 1) / stride;
}
__device__ __forceinline__ bool attn_item_at(int k, int first, int stride, int order, int nb, int nh, int nhkv, int nqb, int nx, AttnItem& it) {
    if (order & ORDER_LPT) {
        const int x = first & 7, slot = first >> 3, G = nh / nhkv, nblk = G * nqb, rg = (nblk + stride - 1) / stride;
        const int gi = k / rg, kk = k - gi * rg, sl = (gi & 1) ? stride - 1 - slot : slot;
        const int pos = (kk & 1) ? stride - 1 - sl : sl, s = kk * stride + pos;
        if (s >= nblk) return false;
        it.bh = (gi * 8 + x) * G + (s % G); it.qb0 = it.qb1 = nqb - 1 - s / G; return true;
    }
    const int L = first + k * stride; if (L >= nx * nb * nh) return false;
    it = attn_decode(L, nb, nh, nhkv, nqb, nx, order); return true;
}
template <int QS, int KS, int OS, bool SEL, int QREG, bool MERGE>
__device__ __forceinline__ void attn_phase(char* lds, const AttnTensors& X, const MergeArgs& MG, int nb, int nh, int nhkv, int sq, int skv, int p0base, int order, int stride, int first, const int wid) {
    const int W = 1 << 30;
    const int nqb = sq / QB, nx = (order & ORDER_PAIRED) ? nqb / 2 : nqb;
    AttnItem it; int k = 0, pass = 0; const int kmax = attn_kmax(stride, order, nb, nh, nhkv, nqb, nx);
    while (k < kmax && !attn_item_at(k, first, stride, order, nb, nh, nhkv, nqb, nx, it)) ++k;
    if (k >= kmax) return;
    BlockRef cur = attn_ref<QS, KS, OS>(it, 0, X, nh, nhkv, sq, skv, p0base);
    Seam S;
    attn_prime<QS, KS>(cur, W, lds, S, wid);
    for (;;) {
        const bool more_pass = pass == 0 && it.qb1 != it.qb0;
        AttnItem itn = it; int passn = pass + 1, kn = k; bool last = false;
        if (!more_pass) { passn = 0; kn = k + 1; while (kn < kmax && !attn_item_at(kn, first, stride, order, nb, nh, nhkv, nqb, nx, itn)) ++kn; if (kn >= kmax) { last = true; itn = it; kn = k; } }
        const BlockRef nxt = last ? cur : attn_ref<QS, KS, OS>(itn, passn, X, nh, nhkv, sq, skv, p0base);
        attn_block<QS, KS, OS, SEL, QREG, MERGE>(cur, nxt, skv, W, lds, S, MG, wid);
        if (last) break;
        cur = nxt; it = itn; pass = passn; k = kn;
    }
    asm volatile("s_waitcnt vmcnt(0)" ::: "memory");
    __syncthreads();
}
}


namespace ix {
constexpr int KCH = 256;
constexpr int BUFB = KCH * 128;
template <int CTRL> __device__ __forceinline__ int dpp_mov(int v) { return __builtin_amdgcn_update_dpp(0, v, CTRL, 0xF, 0xF, true); }
__device__ __forceinline__ int half_sum(int v) {
    v += dpp_mov<0xB1>(v); v += dpp_mov<0x4E>(v); v += dpp_mov<0x141>(v); v += dpp_mov<0x140>(v);
    return v + __shfl_xor(v, 16);
}
__device__ __forceinline__ int half_sum_rl(int v, int hi) {
    v += dpp_mov<0xB1>(v); v += dpp_mov<0x4E>(v); v += dpp_mov<0x141>(v); v += dpp_mov<0x140>(v);
    const int a = __builtin_amdgcn_readlane(v, 0) + __builtin_amdgcn_readlane(v, 16), b = __builtin_amdgcn_readlane(v, 32) + __builtin_amdgcn_readlane(v, 48);
    return hi ? b : a;
}
__device__ __forceinline__ float half_min(float v) {
    v = fminf(v, __int_as_float(dpp_mov<0xB1>(__float_as_int(v)))); v = fminf(v, __int_as_float(dpp_mov<0x4E>(__float_as_int(v))));
    v = fminf(v, __int_as_float(dpp_mov<0x141>(__float_as_int(v)))); v = fminf(v, __int_as_float(dpp_mov<0x140>(__float_as_int(v))));
    return fminf(v, __shfl_xor(v, 16));
}
__device__ __forceinline__ float half_max(float v) {
    v = fmaxf(v, __int_as_float(dpp_mov<0xB1>(__float_as_int(v)))); v = fmaxf(v, __int_as_float(dpp_mov<0x4E>(__float_as_int(v))));
    v = fmaxf(v, __int_as_float(dpp_mov<0x141>(__float_as_int(v)))); v = fmaxf(v, __int_as_float(dpp_mov<0x140>(__float_as_int(v))));
    return fmaxf(v, __shfl_xor(v, 16));
}
__device__ __forceinline__ int excl_scan64(int v, int lane, int& total) {
    int s = v;
#pragma unroll
    for (int o = 1; o <= 32; o <<= 1) { const int t = __shfl_up(s, o); s += (lane >= o) ? t : 0; }
    total = __shfl(s, 63);
    return s - v;
}
__device__ __forceinline__ void tie_fix(unsigned& ge0, unsigned& ge1, unsigned gt0, unsigned gt1, int need, int lane) {
    unsigned eq0 = ge0 & ~gt0, eq1 = ge1 & ~gt1;
    const int c0 = __popc(eq0), c1 = __popc(eq1);
    int tot0, tot1; const int pre0 = excl_scan64(c0, lane, tot0); const int pre1 = tot0 + excl_scan64(c1, lane, tot1);
    int t0 = need - pre0; t0 = t0 < 0 ? 0 : (t0 > c0 ? c0 : t0);
    int t1 = need - pre1; t1 = t1 < 0 ? 0 : (t1 > c1 ? c1 : t1);
    while (__popc(eq0) > t0) eq0 &= ~(0x80000000u >> __clz(eq0));
    while (__popc(eq1) > t1) eq1 &= ~(0x80000000u >> __clz(eq1));
    ge0 = gt0 | eq0; ge1 = gt1 | eq1;
}
__device__ __forceinline__ unsigned nib16(unsigned w, int hi) {
    unsigned x = (w >> (4 * hi)) & 0x0F0F0F0Fu; x = (x | (x >> 4)) & 0x00FF00FFu; x = (x | (x >> 8)) & 0xFFFFu; return x;
}
__device__ __forceinline__ void store_row(unsigned* row, unsigned g0, unsigned g1, int lane) {
    const int hi = lane & 1, e = lane & ~1;
    const unsigned a0 = __shfl(g0, e), b0 = __shfl(g0, e + 1), a1 = __shfl(g1, e), b1 = __shfl(g1, e + 1);
    row[lane] = nib16(a0, hi) | (nib16(b0, hi) << 16);
    row[64 + lane] = nib16(a1, hi) | (nib16(b1, hi) << 16);
}
constexpr int LDS_SIDE = 65536;
__device__ __forceinline__ void indexer_phase(const Frame& F, const bf16_t* QI, const bf16_t* KI, const float* WI, unsigned* MASK, const pg8::SideConv& SD) {
    const int tid = F.tid_(), lane = F.lane_(), w = F.wave, r = lane & 31, hi = lane >> 5;
    LAS unsigned char* lds = F.lds;
    const float NEG = -__builtin_inff();
    int sq = 0, spar = 0; bool pend0 = false, pend1 = false; size_t pd0 = 0, pd1 = 0;
    for (int rnd = 0; rnd < 4; ++rnd) {
        const int p = (rnd & 1) ? (F.G - 1 - F.bid) : F.bid; const int sidx = rnd * F.G + p;
        if (sidx >= NB * (SEQ / 16)) continue;
        const int qg = (SEQ / 16 - 1) - (sidx >> 2), b = sidx & 3;
        const int q0 = qg * 16, nkeys = q0 + 16, nkt = (nkeys + 31) >> 5, nch = (nkeys + KCH - 1) / KCH;
        const size_t tb = (size_t)b * SEQ;
        const int tq = q0 + 2 * w + hi;
        bf16x8 afr[4];
        { const int qsel = (r >> 2) & 1, head = (r & 3) + 4 * (r >> 3);
          const bf16_t* qp = QI + (tb + q0 + 2 * w + qsel) * 1024 + head * 64 + 8 * hi;
#pragma unroll
          for (int s = 0; s < 4; ++s) afr[s] = *(const bf16x8*)(qp + 16 * s); }
        f32x4 wv[4];
#pragma unroll
        for (int i = 0; i < 4; ++i) wv[i] = *(const f32x4*)(WI + (tb + tq) * 16 + 4 * i);
        float sc[128];
#pragma unroll
        for (int i = 0; i < 128; ++i) sc[i] = NEG;
        const int skey = 8 * w + (lane >> 3), ssl = lane & 7;
        const bf16_t* ksrc = KI + (tb + skey) * 64 + ((ssl ^ ((skey >> 1) & 7)) * 8);
#define IX_STAGE(chunk, buf) do { _Pragma("unroll") for (int i = 0; i < 4; ++i) \
            __builtin_amdgcn_global_load_lds((const unsigned*)(ksrc + ((size_t)(chunk) * KCH + 64 * i) * 64), (LAS unsigned*)(lds + (buf) * BUFB + (64 * i + 8 * w) * 128), 16, 0, 0); } while (0)
        for (int rep22 = 0; rep22 < (REP_PHASE == 22 ? 2 : 1); ++rep22) {
        IX_STAGE(0, 0);
        asm volatile("s_waitcnt vmcnt(0)" ::: "memory");
        __syncthreads();
        int boff[4];
#pragma unroll
        for (int s = 0; s < 4; ++s) boff[s] = r * 128 + (((2 * s + hi) ^ ((r >> 1) & 7)) * 16);
        for (int c = 0; c < nch; ++c) {
            const bool more = (c + 1 < nch);
            if (more) IX_STAGE(c + 1, (c + 1) & 1);
            {   LAS unsigned char* told = lds + LDS_SIDE + (spar ^ 1) * 2 * 16640; LAS unsigned char* tnew = lds + LDS_SIDE + spar * 2 * 16640;
                if (pend0) SD.consume(told, pd0, w, lane);
                if (pend1) SD.consume(told + 16640, pd1, w, lane);
                const int ja = SD.j0 + sq * SD.G + SD.c, jb = ja + SD.G;
                pend0 = ja < SD.jn; pend1 = jb < SD.jn;
                if (pend0) { pd0 = SD.issue(ja, tnew, w, lane); ++sq; }
                if (pend1) { pd1 = SD.issue(jb, tnew + 16640, w, lane); ++sq; }
                spar ^= 1; }
            LAS unsigned char* kb = lds + (c & 1) * BUFB;
#pragma unroll
            for (int g = 0; g < 2; ++g) {
                float s4[4] = {NEG, NEG, NEG, NEG};
                if (c * 8 + g * 4 < nkt) {
#pragma unroll
                    for (int p2 = 0; p2 < 2; ++p2) {
                        const int k0 = g * 4 + 2 * p2, kt0 = c * 8 + k0;
                        f32x16 a0 = {}, a1 = {};
#pragma unroll
                        for (int s = 0; s < 4; ++s) {
                            const bf16x8 b0 = *(const LAS bf16x8*)(kb + k0 * 4096 + boff[s]), b1 = *(const LAS bf16x8*)(kb + (k0 + 1) * 4096 + boff[s]);
                            a0 = __builtin_amdgcn_mfma_f32_32x32x16_bf16(afr[s], b0, a0, 0, 0, 0); a1 = __builtin_amdgcn_mfma_f32_32x32x16_bf16(afr[s], b1, a1, 0, 0, 0); }
#define IX_RELU(x) __int_as_float(max(__float_as_int(x), 0))
                        f32x2 q0 = {0.f, 0.f}, q1 = {0.f, 0.f};
#pragma unroll
                        for (int h = 0; h < 16; h += 2) {
                            const f32x2 ww = {wv[h >> 2][h & 3], wv[h >> 2][(h & 3) + 1]};
                            const f32x2 r0 = {IX_RELU(a0[h]), IX_RELU(a0[h + 1])};
                            const f32x2 r1 = {IX_RELU(a1[h]), IX_RELU(a1[h + 1])};
                            q0 = ww * r0 + q0; q1 = ww * r1 + q1; }
                        s4[2 * p2] = (kt0 * 32 + r <= tq) ? (q0[0] + q0[1]) : NEG;
                        s4[2 * p2 + 1] = ((kt0 + 1) * 32 + r <= tq) ? (q1[0] + q1[1]) : NEG;
#undef IX_RELU
                    }
                }
#define IX_INS(cc) case cc: _Pragma("unroll") for (int k = 0; k < 4; ++k) sc[(cc) * 4 + k] = s4[k]; break;
                switch (c * 2 + g) { IX_INS(0) IX_INS(1) IX_INS(2) IX_INS(3) IX_INS(4) IX_INS(5) IX_INS(6) IX_INS(7) IX_INS(8) IX_INS(9) IX_INS(10) IX_INS(11) IX_INS(12) IX_INS(13) IX_INS(14) IX_INS(15)
                                     IX_INS(16) IX_INS(17) IX_INS(18) IX_INS(19) IX_INS(20) IX_INS(21) IX_INS(22) IX_INS(23) IX_INS(24) IX_INS(25) IX_INS(26) IX_INS(27) IX_INS(28) IX_INS(29) IX_INS(30) IX_INS(31) default: break; }
#undef IX_INS
            }
            asm volatile("s_waitcnt vmcnt(0)" ::: "memory");
            __syncthreads();
        }
        }
#undef IX_STAGE
        float tau = -3.0e38f; int tiemode = 0, need = 0;
        for (int rep20 = 0; rep20 < (REP_PHASE == 20 ? 2 : 1); ++rep20) {
            tiemode = 0; need = 0;
            float lo = 0.f, hiv = 0.f; int done = (tq + 1 <= TOPK) ? 1 : 0;
            if (!done) {
                float mn = __builtin_inff(), mx = NEG;
#pragma unroll
                for (int c = 0; c < 16; ++c) if (c < nch) {
#pragma unroll
                    for (int k = 0; k < 8; ++k) { const float v = sc[c * 8 + k]; mx = fmaxf(mx, v); mn = fminf(mn, (v == NEG) ? __builtin_inff() : v); } }
                lo = half_min(mn); mx = half_max(mx);
                hiv = mx + fabsf(mx) * 1e-6f + 1e-30f;
            }
            for (int it = 0; it < 64 && __any(!done); ++it) {
                const unsigned ul = __float_as_uint(lo), uh = __float_as_uint(hiv);
                const unsigned kl = (ul & 0x80000000u) ? ~ul : (ul | 0x80000000u), kh = (uh & 0x80000000u) ? ~uh : (uh | 0x80000000u);
                const bool adj = (kh - kl) <= 1u;
                const unsigned km = kl + ((kh - kl) >> 1);
                const float kmid = __uint_as_float((km & 0x80000000u) ? (km ^ 0x80000000u) : ~km);
                const float fmid = 0.5f * (lo + hiv);
                const float mid = (it < 24 && fmid > lo && fmid < hiv) ? fmid : kmid;
                const float piv = adj ? hiv : mid;
                int lt = 0; const f32x2 pv2 = {piv, piv};
#pragma unroll
                for (int gq = 0; gq < 4; ++gq) {
                    unsigned bits = 0u;
                    if (gq * 4 < nch) {
#pragma unroll
                    for (int cc = 0; cc < 4; ++cc) { const int c = gq * 4 + cc;
#pragma unroll
                        for (int k = 0; k < 8; k += 2) { const f32x2 d = (f32x2){sc[c * 8 + k], sc[c * 8 + k + 1]} - pv2;
                            bits = __builtin_amdgcn_alignbit(bits, __float_as_uint(d[0]), 31); bits = __builtin_amdgcn_alignbit(bits, __float_as_uint(d[1]), 31); } }
                    lt += 32 - __popc(bits); }
                }
                const int cnt = half_sum_rl(lt, hi);
                if (!done) {
                    if (adj) { tau = lo; tiemode = 1; need = TOPK - cnt; done = 1; }
                    else if (cnt == TOPK) { tau = mid; done = 1; }
                    else if (cnt > TOPK) lo = mid; else hiv = mid;
                }
            }
        }
        unsigned wA0 = 0u, wA1 = 0u, wB0 = 0u, wB1 = 0u;
#define IX_BAL(RA, RB, KT, LN, OP) { const unsigned long long bl_ = __ballot(sc[KT] OP tau); \
            asm volatile("s_nop 1\n\tv_writelane_b32 %0, %2, %4\n\tv_writelane_b32 %1, %3, %4" : "+v"(RA), "+v"(RB) : "s"((unsigned)bl_), "s"((unsigned)(bl_ >> 32)), "n"(LN)); }
#define IX_REP8(M, RA, RB, b, o, OP) M(RA, RB, (b) + 0, (b) - (o) + 0, OP) M(RA, RB, (b) + 1, (b) - (o) + 1, OP) M(RA, RB, (b) + 2, (b) - (o) + 2, OP) M(RA, RB, (b) + 3, (b) - (o) + 3, OP) \
                                     M(RA, RB, (b) + 4, (b) - (o) + 4, OP) M(RA, RB, (b) + 5, (b) - (o) + 5, OP) M(RA, RB, (b) + 6, (b) - (o) + 6, OP) M(RA, RB, (b) + 7, (b) - (o) + 7, OP)
#define IX_REP64(M, RA, RB, b, OP) IX_REP8(M, RA, RB, (b) + 0, b, OP) IX_REP8(M, RA, RB, (b) + 8, b, OP) IX_REP8(M, RA, RB, (b) + 16, b, OP) IX_REP8(M, RA, RB, (b) + 24, b, OP) \
                                   IX_REP8(M, RA, RB, (b) + 32, b, OP) IX_REP8(M, RA, RB, (b) + 40, b, OP) IX_REP8(M, RA, RB, (b) + 48, b, OP) IX_REP8(M, RA, RB, (b) + 56, b, OP)
        IX_REP64(IX_BAL, wA0, wB0, 0, >=)
        IX_REP64(IX_BAL, wA1, wB1, 64, >=)
        if (__any(tiemode)) {
            unsigned gA0 = 0u, gA1 = 0u, gB0 = 0u, gB1 = 0u;
            IX_REP64(IX_BAL, gA0, gB0, 0, >)
            IX_REP64(IX_BAL, gA1, gB1, 64, >)
            const int tieA = __builtin_amdgcn_readlane(tiemode, 0), tieB = __builtin_amdgcn_readlane(tiemode, 32);
            const int needA = __builtin_amdgcn_readlane(need, 0), needB = __builtin_amdgcn_readlane(need, 32);
            if (tieA) tie_fix(wA0, wA1, gA0, gA1, needA, lane);
            if (tieB) tie_fix(wB0, wB1, gB0, gB1, needB, lane);
        }
        unsigned* ra = MASK + (tb + q0 + 2 * w) * 128;
        store_row(ra, wA0, wA1, lane);
        store_row(ra + 128, wB0, wB1, lane);
#undef IX_BAL
#undef IX_REP8
#undef IX_REP64
        __syncthreads();
    }
    {   LAS unsigned char* told = lds + LDS_SIDE + (spar ^ 1) * 2 * 16640;
        if (pend0) SD.consume(told, pd0, w, lane);
        if (pend1) SD.consume(told + 16640, pd1, w, lane); }
    SD.leftover(sq, w, lane);
}
}


#ifdef PROBE_MASK
__device__ __forceinline__ void probe_mask_check(const Frame& F) {
    const unsigned* MASK = F.W<unsigned>(WS_MASK); unsigned* flag = F.W<unsigned>(WS_CTL + CTL_CNT + 1024);
    for (int t = F.bid * 8 + F.wave; t < T; t += F.G * 8) {
        const int s = t & (SEQ - 1);
        int cnt = 0, bad = 0;
#pragma unroll
        for (int i = 0; i < 2; ++i) {
            const int o = i * 64 + F.lane_(); const unsigned w = MASK[(size_t)t * 128 + o];
            cnt += __popc(w);
            const int tile = o >> 1, hi = o & 1;
#pragma unroll
            for (int b = 0; b < 32; ++b) if ((w >> b) & 1u) { const int r = b & 15; const int key = tile * 64 + (b >> 4) * 32 + (r & 3) + 8 * (r >> 2) + 4 * hi; if (key > s) bad = 1; }
        }
        cnt = (int)wave_sum((float)cnt);
        const int want = (s + 1 < TOPK) ? s + 1 : TOPK;
        if (cnt != want) bad = 1;
        if (__any(bad) && F.lane_() == 0) atomicAdd(flag, 1u);
    }
}
#endif
__device__ __forceinline__ void p4_merge(const Frame& F) {
    const bf16_t* A = F.W<bf16_t>(WS_ABUF); const bf16_t* P = F.W<bf16_t>(WS_PBUF); const bf16_t* GA = F.W<bf16_t>(WS_GABUF); const bf16_t* Y = F.W<bf16_t>(WS_YATT);
    bf16_t* M = F.W<bf16_t>(WS_MERGED); const float* cw = F.I<float>(IN_CONV_W);
    for (int r = F.bid * 2 + (F.tid_() >> 8); r < T; r += F.G * 2) {
        const int c = (F.tid_() & 255) * 8, s = r & (SEQ - 1);
        const u32x4 a = *(const u32x4*)(A + (size_t)r * DM + c), p2 = *(const u32x4*)(P + (size_t)r * DM + c);
        u32x4 p1 = (u32x4){0u, 0u, 0u, 0u}, p0 = (u32x4){0u, 0u, 0u, 0u};
        if (s >= 1) p1 = *(const u32x4*)(P + (size_t)(r - 1) * DM + c);
        if (s >= 2) p0 = *(const u32x4*)(P + (size_t)(r - 2) * DM + c);
#if MILESTONE >= 4
        const u32x4 ga = *(const u32x4*)(GA + (size_t)r * DM + c), y = *(const u32x4*)(Y + (size_t)r * DM + c);
#else
        const u32x4 ga = (u32x4){0u, 0u, 0u, 0u}, y = (u32x4){0u, 0u, 0u, 0u}; (void)GA; (void)Y;
#endif
        float o[8];
#pragma unroll
        for (int j = 0; j < 4; ++j) {
            const float w0l = cw[c + 2 * j], w1l = cw[DM + c + 2 * j], w2l = cw[2 * DM + c + 2 * j];
            const float w0h = cw[c + 2 * j + 1], w1h = cw[DM + c + 2 * j + 1], w2h = cw[2 * DM + c + 2 * j + 1];
            o[2 * j] = bf_lo(a[j]) * (w0l * bf_lo(p0[j]) + w1l * bf_lo(p1[j]) + w2l * bf_lo(p2[j])) + bf_lo(ga[j]) * bf_lo(y[j]);
            o[2 * j + 1] = bf_hi(a[j]) * (w0h * bf_hi(p0[j]) + w1h * bf_hi(p1[j]) + w2h * bf_hi(p2[j])) + bf_hi(ga[j]) * bf_hi(y[j]);
        }
        u32x4 w; w.x = cvt_pk_bf16(o[0], o[1]); w.y = cvt_pk_bf16(o[2], o[3]); w.z = cvt_pk_bf16(o[4], o[5]); w.w = cvt_pk_bf16(o[6], o[7]);
        *(u32x4*)(M + (size_t)r * DM + c) = w;
    }
}


__device__ __forceinline__ void p9_route(const Frame& F, const bf16_t* h) {
    const float* wrt = F.W<float>(WS_WRT); const float* br = F.I<float>(IN_B_ROUTER);
    unsigned* cnt = F.W<unsigned>(WS_CTL + CTL_CNT);
    int* slot_e = F.W<int>(WS_SLOTE); int* slot_r = F.W<int>(WS_SLOTR); float* slot_g = F.W<float>(WS_SLOTG); float* rs2o = F.W<float>(WS_RS2);
    LAS float* part = (LAS float*)F.lds;
    LAS float* ssp = (LAS float*)(F.lds + 16384);
    const int lane = F.lane_(), w = F.wave, tg = w & 3, kh = w >> 2, tok = lane & 15, kq = lane >> 4;
    for (int u = F.bid; u < T / 64; u += F.G) {
        const int t0 = u * 64 + tg * 16;
        const bf16_t* hp = h + (size_t)(t0 + tok) * DM + kh * 1024 + 4 * kq;
        const float* w0 = wrt + (size_t)tok * DM + kh * 1024 + 4 * kq;
        const float* w1 = w0 + (size_t)16 * DM;
        f32x4 acc0 = (f32x4){0.f, 0.f, 0.f, 0.f}, acc1 = (f32x4){0.f, 0.f, 0.f, 0.f}; float ss = 0.f;
#pragma unroll 4
        for (int s = 0; s < 64; ++s) {
            const u32x2 ab = *(const u32x2*)(hp + 16 * s); const f32x4 a = (f32x4){bf_lo(ab.x), bf_hi(ab.x), bf_lo(ab.y), bf_hi(ab.y)};
            const f32x4 b0 = *(const f32x4*)(w0 + 16 * s), b1 = *(const f32x4*)(w1 + 16 * s);
            ss += a[0] * a[0] + a[1] * a[1] + a[2] * a[2] + a[3] * a[3];
#pragma unroll
            for (int j = 0; j < 4; ++j) { acc0 = __builtin_amdgcn_mfma_f32_16x16x4f32(a[j], b0[j], acc0, 0, 0, 0); acc1 = __builtin_amdgcn_mfma_f32_16x16x4f32(a[j], b1[j], acc1, 0, 0, 0); }
        }
        ss += __shfl_xor(ss, 16); ss += __shfl_xor(ss, 32);
        if (kq == 0) ssp[kh * 64 + tg * 16 + tok] = ss;
#pragma unroll
        for (int i = 0; i < 4; ++i) { part[(kh * 64 + tg * 16 + 4 * kq + i) * 32 + tok] = acc0[i]; part[(kh * 64 + tg * 16 + 4 * kq + i) * 32 + 16 + tok] = acc1[i]; }
        __syncthreads();
        if (F.tid_() < 64) {
            const int t = u * 64 + F.tid_();
            const float rs = __builtin_amdgcn_rsqf((ssp[F.tid_()] + ssp[64 + F.tid_()]) * (1.0f / DM) + NORM_EPS);
            float lg[32];
#pragma unroll
            for (int e = 0; e < 32; ++e) lg[e] = (part[F.tid_() * 32 + e] + part[(64 + F.tid_()) * 32 + e]) * rs + br[e];
            unsigned chosen = 0u; float tv[4]; int ti[4];
#pragma unroll
            for (int p = 0; p < 4; ++p) {
                float best = -__builtin_inff(); int bi = 0;
#pragma unroll
                for (int e = 0; e < 32; ++e) { const bool ok = !((chosen >> e) & 1u) && (lg[e] > best); best = ok ? lg[e] : best; bi = ok ? e : bi; }
                chosen |= 1u << bi; tv[p] = best; ti[p] = bi;
            }
            const float e1 = __expf(tv[1] - tv[0]), e2 = __expf(tv[2] - tv[0]), e3 = __expf(tv[3] - tv[0]);
            const float inv = 1.0f / (1.0f + e1 + e2 + e3);
            const float gt[4] = {inv, e1 * inv, e2 * inv, e3 * inv};
            rs2o[t] = rs;
#pragma unroll
            for (int p = 0; p < 4; ++p) {
                const unsigned rk = atomicAdd(cnt + ti[p], 1u);
                slot_e[t * 4 + p] = ti[p]; slot_r[t * 4 + p] = (int)rk; slot_g[t * 4 + p] = gt[p];
            }
        }
        __syncthreads();
    }
}

__device__ __forceinline__ void p10_gather(const Frame& F, const bf16_t* hb) {
    LAS int* off = (LAS int*)F.lds;
    const unsigned* cnt = F.W<unsigned>(WS_CTL + CTL_CNT);
    int* tile_e = F.W<int>(WS_TILEE);
    if (F.tid_() == 0) { int o = 0; for (int e = 0; e < NEXP; ++e) { off[e] = o; o += ((int)cnt[e] + 255) & ~255; } off[NEXP] = o; }
    __syncthreads();
    if (F.bid == 0) {
        const int nmt = off[NEXP] >> 8;
        for (int m = F.tid_(); m < nmt; m += 512) { int e = 0; for (int q = 1; q < NEXP; ++q) e = (off[q] <= m * 256) ? q : e; tile_e[m] = e; }
        if (F.tid_() == 0) tile_e[511] = nmt;
    }
    const int* slot_e = F.W<int>(WS_SLOTE); const int* slot_r = F.W<int>(WS_SLOTR); const float* slot_g = F.W<float>(WS_SLOTG); const float* rs2 = F.W<float>(WS_RS2);
    int* pos = F.W<int>(WS_POS); float* rss = F.W<float>(WS_RSS); float* gws = F.W<float>(WS_GWS); unsigned char* as = F.W<unsigned char>(WS_ASORT); const float* gffn = F.I<float>(IN_NORM_FFN);
    const int ln = F.lane_();
    f32x4 gg[8];
#pragma unroll
    for (int i = 0; i < 4; ++i) { const int c = (i * 64 + ln) * 8; gg[2 * i] = *(const f32x4*)(gffn + c); gg[2 * i + 1] = *(const f32x4*)(gffn + c + 4); }
    int t = F.bid * 8 + F.wave;
    u32x4 hv[4], hvn[4]; float rs = 0.f, rsn = 0.f; u32x4 se = {0u, 0u, 0u, 0u}, sr = se, sen = se, srn = se; f32x4 sg = {0.f, 0.f, 0.f, 0.f}, sgn = sg;
#define P10_LOAD(H_, RS_, SE_, SR_, SG_, tt) do { _Pragma("unroll") for (int i = 0; i < 4; ++i) H_[i] = *(const u32x4*)(hb + (size_t)(tt) * DM + (i * 64 + ln) * 8); \
        RS_ = rs2[tt]; SE_ = *(const u32x4*)(slot_e + (tt) * 4); SR_ = *(const u32x4*)(slot_r + (tt) * 4); SG_ = *(const f32x4*)(slot_g + (tt) * 4); } while (0)
    if (t < T) P10_LOAD(hv, rs, se, sr, sg, t);
    for (; t < T; t += F.G * 8) {
        const int tn = t + F.G * 8;
        if (tn < T) P10_LOAD(hvn, rsn, sen, srn, sgn, tn);
        u32x2 v[4];
#pragma unroll
        for (int i = 0; i < 4; ++i) { const u32x4 h = hv[i]; const f32x4 g0 = gg[2 * i], g1 = gg[2 * i + 1];
            v[i] = pack_fp8x8(bf_lo(h.x) * g0[0], bf_hi(h.x) * g0[1], bf_lo(h.y) * g0[2], bf_hi(h.y) * g0[3], bf_lo(h.z) * g1[0], bf_hi(h.z) * g1[1], bf_lo(h.w) * g1[2], bf_hi(h.w) * g1[3]); }
        int pp[4];
#pragma unroll
        for (int k = 0; k < 4; ++k) pp[k] = off[se[k]] + (int)sr[k];
#pragma unroll
        for (int k = 0; k < 4; ++k) {
            const int p = pp[k];
#pragma unroll
            for (int i = 0; i < 4; ++i) *(u32x2*)(as + (size_t)p * DM + (i * 64 + ln) * 8) = v[i];
            if (ln == 0) { rss[p] = rs; gws[p] = sg[k]; }
        }
        if (ln == 0) *(u32x4*)(pos + t * 4) = (u32x4){(unsigned)pp[0], (unsigned)pp[1], (unsigned)pp[2], (unsigned)pp[3]};
#pragma unroll
        for (int i = 0; i < 4; ++i) hv[i] = hvn[i];
        rs = rsn; se = sen; sr = srn; sg = sgn;
    }
#undef P10_LOAD
}

struct SchedMoE { int G, c, nM, nN; const char* A; const char* Bt; const LAS int* tile_e; size_t tstep, estep;
    __device__ __forceinline__ bool next(int i, Unit& u) const {
        const int L = i * G + c; if (L >= nM * nN) return false;
        int pm, pn; pg8::tile_of(L, nM, nN, pm, pn); const int e = tile_e[pm];
        u.pm = pm; u.pn = pn; u.a = A + (size_t)pm * tstep; u.b = Bt + (size_t)e * estep + (size_t)pn * tstep; u.kind = 0; u.aux = e; return true; }
};
struct EpiSwiglu { const float* rss; const float* bgu; unsigned char* hdn;
    struct Pre { };
    __device__ __forceinline__ Pre pre(const Unit&, int, int, int, int) const { return Pre{}; }
    __device__ __forceinline__ void operator()(const f32x4 (&acc)[2][2][4][2], const Unit& u, int wr, int wc, int fr, int fq, const Pre&) const {
        const int cw = 128 * u.pn + 32 * wc + 8 * fq; const float* bg = bgu + (size_t)u.aux * 4096 + cw;
        const f32x4 bg0 = *(const f32x4*)bg, bg1 = *(const f32x4*)(bg + 4), bu0 = *(const f32x4*)(bg + 2048), bu1 = *(const f32x4*)(bg + 2052);
        float rsv[8];
#pragma unroll
        for (int q = 0; q < 8; ++q) rsv[q] = rss[u.pm * 256 + (q >> 2) * 128 + wr * 64 + (q & 3) * 16 + fr];
#pragma unroll
        for (int ai = 0; ai < 2; ++ai)
#pragma unroll
            for (int m = 0; m < 4; ++m) {
                const int row = u.pm * 256 + ai * 128 + wr * 64 + m * 16 + fr; const float rs = rsv[ai * 4 + m] * (1.0f / W8_SCALE);
                f32x4 o[2];
#pragma unroll
                for (int n = 0; n < 2; ++n) {
                    f32x4 g = acc[ai][0][m][n] * rs + (n ? bg1 : bg0), up = acc[ai][1][m][n] * rs + (n ? bu1 : bu0);
#pragma unroll
                    for (int j = 0; j < 4; ++j) { g[j] = fminf(g[j], 7.0f); up[j] = __builtin_amdgcn_fmed3f(up[j], -7.0f, 7.0f); }
                    f32x4 z = g * (-1.702f * 1.4426950408889634f), e;
#pragma unroll
                    for (int j = 0; j < 4; ++j) e[j] = __builtin_amdgcn_exp2f(z[j]);
                    e = e + 1.0f;
#pragma unroll
                    for (int j = 0; j < 4; ++j) e[j] = __builtin_amdgcn_rcpf(e[j]);
                    o[n] = (up + 1.0f) * g * e;
                }
                *(u32x2*)(hdn + (size_t)row * DFF + cw) = pack_fp8x8(o[0][0], o[0][1], o[0][2], o[0][3], o[1][0], o[1][1], o[1][2], o[1][3]);
            }
    }
};
constexpr float YS_SCALE = 16.0f;
struct EpiDown { const float* gws; const float* bdn; unsigned char* ys;
    struct Pre { float gwv[8]; };
    __device__ __forceinline__ Pre pre(const Unit& u, int wr, int wc, int fr, int fq) const {
        Pre p;
#pragma unroll
        for (int q = 0; q < 8; ++q) p.gwv[q] = gws[u.pm * 256 + (q >> 2) * 128 + wr * 64 + (q & 3) * 16 + fr];
        return p;
    }
    __device__ __forceinline__ void operator()(const f32x4 (&acc)[2][2][4][2], const Unit& u, int wr, int wc, int fr, int fq, const Pre& pr) const {
        const int c0 = 256 * u.pn + 32 * wc + 8 * fq; const float* bp = bdn + (size_t)u.aux * DM + c0;
        const f32x4 b00 = *(const f32x4*)bp, b01 = *(const f32x4*)(bp + 4), b10 = *(const f32x4*)(bp + 128), b11 = *(const f32x4*)(bp + 132); const float (&gwv)[8] = pr.gwv;
#pragma unroll
        for (int ai = 0; ai < 2; ++ai)
#pragma unroll
            for (int m = 0; m < 4; ++m) {
                const int row = u.pm * 256 + ai * 128 + wr * 64 + m * 16 + fr; const float gw = gwv[ai * 4 + m] * YS_SCALE;
                constexpr float iw = 1.0f / W8_SCALE;
                const f32x4 o0 = (acc[ai][0][m][0] * iw + b00) * gw, o1 = (acc[ai][0][m][1] * iw + b01) * gw, o2 = (acc[ai][1][m][0] * iw + b10) * gw, o3 = (acc[ai][1][m][1] * iw + b11) * gw;
                *(u32x2*)(ys + (size_t)row * DM + c0) = pack_fp8x8(o0[0], o0[1], o0[2], o0[3], o1[0], o1[1], o1[2], o1[3]);
                *(u32x2*)(ys + (size_t)row * DM + c0 + 128) = pack_fp8x8(o2[0], o2[1], o2[2], o2[3], o3[0], o3[1], o3[2], o3[3]);
            }
    }
};

__device__ __forceinline__ void p_final(const Frame& F, const bf16_t* h) {
    const float* g = F.I<float>(IN_NORM_FINAL); const unsigned char* ys = F.W<unsigned char>(WS_YS); const int* pos = F.W<int>(WS_POS);
    const int ln = F.lane_(), stride = F.G * 8;
    f32x4 gg[8];
#pragma unroll
    for (int i = 0; i < 4; ++i) { const int c = (i * 64 + ln) * 8; gg[2 * i] = *(const f32x4*)(g + c); gg[2 * i + 1] = *(const f32x4*)(g + c + 4); }
    u32x4 hh[4], hhn[4]; u32x2 yy[4][4], yyn[4][4];
    u32x4 pnx = (u32x4){0u, 0u, 0u, 0u};
#define FIN_LOAD(H_, Y_, rr, P_) do { _Pragma("unroll") for (int i = 0; i < 4; ++i) { const int c_ = (i * 64 + ln) * 8; H_[i] = *(const u32x4*)(h + (size_t)(rr) * DM + c_); \
        Y_[0][i] = *(const u32x2*)(ys + (size_t)(P_).x * DM + c_); Y_[1][i] = *(const u32x2*)(ys + (size_t)(P_).y * DM + c_); \
        Y_[2][i] = *(const u32x2*)(ys + (size_t)(P_).z * DM + c_); Y_[3][i] = *(const u32x2*)(ys + (size_t)(P_).w * DM + c_); } } while (0)
    int r = F.bid * 8 + F.wave;
    if (r < T) { const u32x4 p0 = *(const u32x4*)(pos + r * 4); FIN_LOAD(hh, yy, r, p0); if (r + stride < T) pnx = *(const u32x4*)(pos + (r + stride) * 4); }
    for (; r < T; r += stride) {
        const int rn = r + stride, rnn = rn + stride;
        u32x4 pnn = (u32x4){0u, 0u, 0u, 0u};
        if (rn < T) FIN_LOAD(hhn, yyn, rn, pnx);
        if (rnn < T) pnn = *(const u32x4*)(pos + rnn * 4);
        f32x4 v[8]; float ss = 0.f;
#pragma unroll
        for (int i = 0; i < 4; ++i) {
            const u32x4 hv = hh[i]; const u32x2 y0 = yy[0][i], y1 = yy[1][i], y2 = yy[2][i], y3 = yy[3][i];
            f32x4 a, b;
            constexpr float iy = 1.0f / YS_SCALE;
#define FIN_Y(W, HI) ((__builtin_amdgcn_cvt_pk_f32_fp8((int)y0.W, HI) + __builtin_amdgcn_cvt_pk_f32_fp8((int)y1.W, HI)) + (__builtin_amdgcn_cvt_pk_f32_fp8((int)y2.W, HI) + __builtin_amdgcn_cvt_pk_f32_fp8((int)y3.W, HI)))
            { const f32x2 s0 = FIN_Y(x, false), s1 = FIN_Y(x, true), s2 = FIN_Y(y, false), s3 = FIN_Y(y, true);
              a[0] = bf_lo(hv.x) + s0[0] * iy; a[1] = bf_hi(hv.x) + s0[1] * iy; a[2] = bf_lo(hv.y) + s1[0] * iy; a[3] = bf_hi(hv.y) + s1[1] * iy;
              b[0] = bf_lo(hv.z) + s2[0] * iy; b[1] = bf_hi(hv.z) + s2[1] * iy; b[2] = bf_lo(hv.w) + s3[0] * iy; b[3] = bf_hi(hv.w) + s3[1] * iy; }
#undef FIN_Y
            v[2 * i] = a; v[2 * i + 1] = b;
            ss += a[0] * a[0] + a[1] * a[1] + a[2] * a[2] + a[3] * a[3] + b[0] * b[0] + b[1] * b[1] + b[2] * b[2] + b[3] * b[3];
        }
        ss = wave_sum(ss);
        float rs = __builtin_amdgcn_rsqf(ss * (1.0f / DM) + NORM_EPS);
#ifdef PROBE_MASK
        if (F.W<unsigned>(WS_CTL + CTL_CNT + 1024)[0] != 0u) rs = __builtin_nanf("");
#endif
#pragma unroll
        for (int i = 0; i < 4; ++i) {
            const int c = (i * 64 + ln) * 8;
            *(f32x4*)(F.a->out + (size_t)r * DM + c) = v[2 * i] * rs * gg[2 * i]; *(f32x4*)(F.a->out + (size_t)r * DM + c + 4) = v[2 * i + 1] * rs * gg[2 * i + 1];
        }
#pragma unroll
        for (int i = 0; i < 4; ++i) { hh[i] = hhn[i]; yy[0][i] = yyn[0][i]; yy[1][i] = yyn[1][i]; yy[2][i] = yyn[2][i]; yy[3][i] = yyn[3][i]; }
        pnx = pnn;
    }
#undef FIN_LOAD
}

constexpr int N_PHASES = 14;
__global__ void __launch_bounds__(512, 2) fwd_kernel(Args args) {
    extern __shared__ __attribute__((aligned(16))) unsigned char lds_raw[];
    Frame F; F.a = &args; F.ws = args.ws; F.lds = (LAS unsigned char*)lds_raw;
    F.wave = __builtin_amdgcn_readfirstlane(threadIdx.x >> 6); F.G = gridDim.x; F.bid = blockIdx.x;
    volatile LAS unsigned* misc = (volatile LAS unsigned*)(F.lds + LDS_MISC);
    if (F.tid_() < 64) misc[F.tid_()] = 0u;
    __syncthreads();
    XcdBarrier bar; bar.bar = F.W<unsigned>(WS_CTL + CTL_BAR); bar.x = 0; bar.st = misc; bar.wv = F.wave;
#if !N_LAUNCH_PER_PHASE
    bar = xcd_barrier_post(F.W<unsigned>(WS_CTL + CTL_BAR), misc, F.wave);
#define GRID_BAR() xcd_barrier(bar)
#else
#define GRID_BAR() do { } while (0)
#endif
    const int lo = args.ph_lo, hi = args.ph_hi;
#ifndef ONLY_PHASE
#define ONLY_PHASE -1
#endif
#define IN(k) ((ONLY_PHASE < 0 || ONLY_PHASE == (k)) && lo <= (k) && (k) < hi)
#define BOTH(k) (IN(k) && IN((k) + 1))

    if (IN(0)) { p0_prologue(F); if (BOTH(0)) GRID_BAR(); }
#if REP_PHASE == 0
    if (IN(0)) { p0_prologue(F); if (BOTH(0)) GRID_BAR(); }
#endif
    if (IN(1)) {
        SchedG1F S8{F.G, F.bid, F.W<char>(WS_XB8), F.W<char>(WS_WINT)};
        SchedG1 S{F.G, F.G - 1 - F.bid, F.W<char>(WS_XB), F.W<char>(WS_WINT), F.W<char>(WS_MEMB), F.W<char>(WS_WKVT)};
        EpiG1 E{F.W<float>(WS_RS0), F.W<float>(WS_RSMEM), F.W<float>(WS_ROPEQK), F.W<float>(WS_ROPEI), F.W<bf16_t>(WS_ABUF), F.W<bf16_t>(WS_PBUF), F.W<bf16_t>(WS_GABUF),
                F.W<bf16_t>(WS_QB), F.W<bf16_t>(WS_KB), F.W<bf16_t>(WS_VB), F.W<bf16_t>(WS_QIB), F.W<bf16_t>(WS_KIB), F.W<float>(WS_WIB), F.W<bf16_t>(WS_KX), F.W<bf16_t>(WS_VX), 1.0f / W8_SCALE};
        pg8::SideConv SD{F.I<float>(IN_W_GU), F.W<unsigned char>(WS_WGUT), 1, 0, SJ_GU_P1, F.G, F.bid};
        const int sdone8 = pg8::gemm_phase<EpiG1, SchedG1F, pg8::SideConv, true>(F.lds, DM, S8, E, F.wave, SD);
        E.sc = 1.0f; SD.j0 += sdone8 * F.G;
        const int sdone = pg8::gemm_phase(F.lds, DM * 2, S, E, F.wave, SD);
        SD.leftover(sdone, F.wave, F.lane_());
        if (BOTH(1)) GRID_BAR();
    }
#if REP_PHASE == 1
    if (IN(1)) {
        SchedG1F S8{F.G, F.bid, F.W<char>(WS_XB8), F.W<char>(WS_WINT)};
        SchedG1 S{F.G, F.G - 1 - F.bid, F.W<char>(WS_XB), F.W<char>(WS_WINT), F.W<char>(WS_MEMB), F.W<char>(WS_WKVT)};
        EpiG1 E{F.W<float>(WS_RS0), F.W<float>(WS_RSMEM), F.W<float>(WS_ROPEQK), F.W<float>(WS_ROPEI), F.W<bf16_t>(WS_ABUF), F.W<bf16_t>(WS_PBUF), F.W<bf16_t>(WS_GABUF),
                F.W<bf16_t>(WS_QB), F.W<bf16_t>(WS_KB), F.W<bf16_t>(WS_VB), F.W<bf16_t>(WS_QIB), F.W<bf16_t>(WS_KIB), F.W<float>(WS_WIB), F.W<bf16_t>(WS_KX), F.W<bf16_t>(WS_VX), 1.0f / W8_SCALE};
        pg8::SideConv SD{F.I<float>(IN_W_GU), F.W<unsigned char>(WS_WGUT), 1, 0, SJ_GU_P1, F.G, F.bid};
        const int sdone8 = pg8::gemm_phase<EpiG1, SchedG1F, pg8::SideConv, true>(F.lds, DM, S8, E, F.wave, SD);
        E.sc = 1.0f; SD.j0 += sdone8 * F.G;
        const int sdone = pg8::gemm_phase(F.lds, DM * 2, S, E, F.wave, SD);
        SD.leftover(sdone, F.wave, F.lane_());
        if (BOTH(1)) GRID_BAR();
    }
#endif
#if MILESTONE >= 4
    if (IN(2)) { pg8::SideConv SD{F.I<float>(IN_W_GU), F.W<unsigned char>(WS_WGUT), 1, SJ_GU_P1, SJ_GU_P2, F.G, F.bid};
                 ix::indexer_phase(F, F.W<bf16_t>(WS_QIB), F.W<bf16_t>(WS_KIB), F.W<float>(WS_WIB), F.W<unsigned>(WS_MASK), SD); if (BOTH(2)) GRID_BAR(); }
#if REP_PHASE == 2
    if (IN(2)) { pg8::SideConv SD{F.I<float>(IN_W_GU), F.W<unsigned char>(WS_WGUT), 1, SJ_GU_P1, SJ_GU_P2, F.G, F.bid};
                 ix::indexer_phase(F, F.W<bf16_t>(WS_QIB), F.W<bf16_t>(WS_KIB), F.W<float>(WS_WIB), F.W<unsigned>(WS_MASK), SD); if (BOTH(2)) GRID_BAR(); }
#endif
    if (IN(3)) {
        att::AttnTensors X{F.W<bf16_t>(WS_QB), F.W<bf16_t>(WS_KB), F.W<bf16_t>(WS_VB), F.W<bf16_t>(WS_YATT), F.W<unsigned>(WS_MASK)};
        att::MergeArgs MG{F.ws, F.I<float>(IN_CONV_W)};
        att::attn_phase<DM, 512, DM, true, 6, true>((char*)lds_raw, X, MG, NB, NHEAD, NKVH, SEQ, SEQ, 0, att::ORDER_PAIRED | att::ORDER_XCD, F.G, F.bid, F.wave);
        if (BOTH(3)) GRID_BAR();
    }
#if REP_PHASE == 3
    if (IN(3)) {
        att::AttnTensors X{F.W<bf16_t>(WS_QB), F.W<bf16_t>(WS_KB), F.W<bf16_t>(WS_VB), F.W<bf16_t>(WS_YATT), F.W<unsigned>(WS_MASK)};
        att::MergeArgs MG{F.ws, F.I<float>(IN_CONV_W)};
        att::attn_phase<DM, 512, DM, true, 6, true>((char*)lds_raw, X, MG, NB, NHEAD, NKVH, SEQ, SEQ, 0, att::ORDER_PAIRED | att::ORDER_XCD, F.G, F.bid, F.wave);
        if (BOTH(3)) GRID_BAR();
    }
#endif
#endif
#ifdef PROBE_MASK
    if (IN(4)) { probe_mask_check(F); GRID_BAR(); }
#endif
    if (IN(5)) {
        SchedDense S{F.G, F.bid, 64, 8, F.W<char>(WS_MERGED), F.W<char>(WS_WOUTT), (size_t)256 * DM * 2};
        EpiResid<true> E{F.I<float>(IN_X), F.W<bf16_t>(WS_H1B), F.W<float>(WS_CTL + CTL_SS1)};
        pg8::SideConv SD{F.I<float>(IN_W_GU), F.W<unsigned char>(WS_WGUT), 1, SJ_GU_P2, SJ_GU, F.G, F.bid};
        const int sdone = pg8::gemm_phase(F.lds, DM * 2, S, E, F.wave, SD);
        SD.leftover(sdone, F.wave, F.lane_());
        if (BOTH(5)) GRID_BAR();
    }
#if REP_PHASE == 5
    if (IN(5)) {
        SchedDense S{F.G, F.bid, 64, 8, F.W<char>(WS_MERGED), F.W<char>(WS_WOUTT), (size_t)256 * DM * 2};
        EpiResid<true> E{F.I<float>(IN_X), F.W<bf16_t>(WS_H1B), nullptr};
        pg8::gemm_phase(F.lds, DM * 2, S, E, F.wave);
        if (BOTH(5)) GRID_BAR();
    }
#endif
#if MILESTONE >= 3
    if (IN(6)) {
        SchedDense S{F.G, F.bid, 64, 2, F.W<char>(WS_H1B), F.W<char>(WS_WQT), (size_t)256 * DM * 2};
        EpiScaleBf16 E{F.W<float>(WS_CTL + CTL_SS1), F.W<bf16_t>(WS_QX), 512};
        pg8::gemm_phase(F.lds, DM * 2, S, E, F.wave);
        if (BOTH(6)) GRID_BAR();
    }
#if REP_PHASE == 6
    if (IN(6)) {
        SchedDense S{F.G, F.bid, 64, 2, F.W<char>(WS_H1B), F.W<char>(WS_WQT), (size_t)256 * DM * 2};
        EpiScaleBf16 E{F.W<float>(WS_CTL + CTL_SS1), F.W<bf16_t>(WS_QX), 512};
        pg8::gemm_phase(F.lds, DM * 2, S, E, F.wave);
        if (BOTH(6)) GRID_BAR();
    }
#endif
    if (IN(7)) {
        att::AttnTensors X{F.W<bf16_t>(WS_QX), F.W<bf16_t>(WS_KX), F.W<bf16_t>(WS_VX), F.W<bf16_t>(WS_OX), nullptr};
        att::attn_phase<512, 512, 512, false, 6, false>((char*)lds_raw, X, att::MergeArgs{}, NB, XHEAD, XHEAD, SEQ, MEML, 1 << 20, att::ORDER_NATURAL, F.G, F.bid, F.wave);
        if (BOTH(7)) GRID_BAR();
    }
#if REP_PHASE == 7
    if (IN(7)) {
        att::AttnTensors X{F.W<bf16_t>(WS_QX), F.W<bf16_t>(WS_KX), F.W<bf16_t>(WS_VX), F.W<bf16_t>(WS_OX), nullptr};
        att::attn_phase<512, 512, 512, false, 6, false>((char*)lds_raw, X, att::MergeArgs{}, NB, XHEAD, XHEAD, SEQ, MEML, 1 << 20, att::ORDER_NATURAL, F.G, F.bid, F.wave);
        if (BOTH(7)) GRID_BAR();
    }
#endif
    if (IN(8)) {
        SchedDense S{F.G, F.bid, 64, 8, F.W<char>(WS_OX), F.W<char>(WS_WOXT), (size_t)256 * 512 * 2};
        EpiResid<false> E{F.W<bf16_t>(WS_H1B), F.W<bf16_t>(WS_H2B), nullptr};
        pg8::gemm_phase(F.lds, 512 * 2, S, E, F.wave);
        if (BOTH(8)) GRID_BAR();
    }
#if REP_PHASE == 8
    if (IN(8)) {
        SchedDense S{F.G, F.bid, 64, 8, F.W<char>(WS_OX), F.W<char>(WS_WOXT), (size_t)256 * 512 * 2};
        EpiResid<false> E{F.W<bf16_t>(WS_H1B), F.W<bf16_t>(WS_H2B), nullptr};
        pg8::gemm_phase(F.lds, 512 * 2, S, E, F.wave);
        if (BOTH(8)) GRID_BAR();
    }
#endif
#endif
    const bf16_t* h2b = F.W<bf16_t>(WS_H2B);
#if MILESTONE >= 2
    if (IN(9)) { p9_route(F, h2b); if (BOTH(9)) GRID_BAR(); }
    if (IN(10)) { p10_gather(F, h2b); if (BOTH(10)) GRID_BAR(); }
#if REP_PHASE == 10
    if (IN(10)) { p10_gather(F, h2b); if (BOTH(10)) GRID_BAR(); }
#endif
    if (IN(11)) {
        const int* te = F.W<int>(WS_TILEE); LAS int* tel = (LAS int*)(F.lds + LDS_MISC + 1024);
        tel[F.tid_()] = te[F.tid_()]; __syncthreads();
        SchedMoE S{F.G, F.bid, tel[511], 16, F.W<char>(WS_ASORT), F.W<char>(WS_WGUT), tel, (size_t)256 * DM, (size_t)4096 * DM};
        EpiSwiglu E{F.W<float>(WS_RSS), F.I<float>(IN_B_GU), F.W<unsigned char>(WS_HDN)};
        pg8::SideConv SD{F.I<float>(IN_W_DN), F.W<unsigned char>(WS_WDNT), 0, 0, SJ_DN, F.G, F.bid};
        const int sdone = pg8::gemm_phase<EpiSwiglu, SchedMoE, pg8::SideConv, true>(F.lds, DM, S, E, F.wave, SD);
        SD.leftover(sdone, F.wave, F.lane_());
        if (BOTH(11)) GRID_BAR();
    }
#if REP_PHASE == 11
    if (IN(11)) {
        const int* te = F.W<int>(WS_TILEE); LAS int* tel = (LAS int*)(F.lds + LDS_MISC + 1024);
        tel[F.tid_()] = te[F.tid_()]; __syncthreads();
        SchedMoE S{F.G, F.bid, tel[511], 16, F.W<char>(WS_ASORT), F.W<char>(WS_WGUT), tel, (size_t)256 * DM, (size_t)4096 * DM};
        EpiSwiglu E{F.W<float>(WS_RSS), F.I<float>(IN_B_GU), F.W<unsigned char>(WS_HDN)};
        pg8::SideConv SD{F.I<float>(IN_W_DN), F.W<unsigned char>(WS_WDNT), 0, 0, SJ_DN, F.G, F.bid};
        const int sdone = pg8::gemm_phase<EpiSwiglu, SchedMoE, pg8::SideConv, true>(F.lds, DM, S, E, F.wave, SD);
        SD.leftover(sdone, F.wave, F.lane_());
        if (BOTH(11)) GRID_BAR();
    }
#endif
    if (IN(12)) {
        const int* te = F.W<int>(WS_TILEE); LAS int* tel = (LAS int*)(F.lds + LDS_MISC + 1024);
        tel[F.tid_()] = te[F.tid_()]; __syncthreads();
        SchedMoE S{F.G, F.bid, tel[511], 8, F.W<char>(WS_HDN), F.W<char>(WS_WDNT), tel, (size_t)256 * DFF, (size_t)DM * DFF};
        EpiDown E{F.W<float>(WS_GWS), F.I<float>(IN_B_DN), F.W<unsigned char>(WS_YS)};
        pg8::gemm_phase<EpiDown, SchedMoE, pg8::SideNone, true>(F.lds, DFF, S, E, F.wave);
        if (BOTH(12)) GRID_BAR();
    }
#if REP_PHASE == 12
    if (IN(12)) {
        const int* te = F.W<int>(WS_TILEE); LAS int* tel = (LAS int*)(F.lds + LDS_MISC + 1024);
        tel[F.tid_()] = te[F.tid_()]; __syncthreads();
        SchedMoE S{F.G, F.bid, tel[511], 8, F.W<char>(WS_HDN), F.W<char>(WS_WDNT), tel, (size_t)256 * DFF, (size_t)DM * DFF};
        EpiDown E{F.W<float>(WS_GWS), F.I<float>(IN_B_DN), F.W<unsigned char>(WS_YS)};
        pg8::gemm_phase<EpiDown, SchedMoE, pg8::SideNone, true>(F.lds, DFF, S, E, F.wave);
        if (BOTH(12)) GRID_BAR();
    }
#endif
    if (IN(13)) { p_final(F, h2b); }
#if REP_PHASE == 13
    if (IN(13)) { p_final(F, h2b); }
#endif
#endif
#undef IN
#undef BOTH
}

extern "C" void kernel_launch(void* const* d_in, const int* in_sizes, int n_in, void* d_out, int out_size, void* d_ws, size_t ws_size, hipStream_t stream) {
    static int grid = 0;
    if (grid == 0) {
        if (n_in != 21 || out_size != T * DM || ws_size < WS_END) { fprintf(stderr, "kernel_launch: unexpected shapes (n_in %d, out %d, ws %zu < %zu)\n", n_in, out_size, ws_size, (size_t)WS_END); grid = -1; return; }
        int dev = 0, cus = 0, per_cu = 0;
        if (hipGetDevice(&dev) != hipSuccess || hipDeviceGetAttribute(&cus, hipDeviceAttributeMultiprocessorCount, dev) != hipSuccess) { grid = -1; return; }
        if (hipFuncSetAttribute((const void*)fwd_kernel, hipFuncAttributeMaxDynamicSharedMemorySize, LDS_BYTES) != hipSuccess) { fprintf(stderr, "kernel_launch: hipFuncSetAttribute failed\n"); grid = -1; return; }
        if (hipOccupancyMaxActiveBlocksPerMultiprocessor(&per_cu, (const void*)fwd_kernel, 512, LDS_BYTES) != hipSuccess || per_cu < 1) { fprintf(stderr, "kernel_launch: occupancy query says %d\n", per_cu); (void)hipGetLastError(); per_cu = 1; }
        grid = cus;
    }
    if (grid < 0) return;
    (void)hipMemsetAsync((char*)d_ws + WS_CTL, 0, CTL_BYTES, stream);
    Args a{};
    for (int i = 0; i < 21; ++i) a.in[i] = d_in[i];
    a.out = (float*)d_out; a.ws = (unsigned char*)d_ws;
#if N_LAUNCH_PER_PHASE
    for (int p = 0; p < N_PHASES; ++p) {
#if MILESTONE == 1
        if (!(p == 0 || p == 1 || p == 4 || p == 5 || p == 13)) continue;
#endif
#if MILESTONE == 2
        if (!(p == 0 || p == 1 || p == 4 || p == 5 || p >= 9)) continue;
#endif
#if MILESTONE == 3
        if (!(p == 0 || p == 1 || p >= 4)) continue;
#endif
        a.ph_lo = p; a.ph_hi = p + 1;
        hipLaunchKernelGGL(fwd_kernel, dim3(grid), dim3(512), LDS_BYTES, stream, a);
    }
#else
    a.ph_lo = 0; a.ph_hi = N_PHASES;
    hipLaunchKernelGGL(fwd_kernel, dim3(grid), dim3(512), LDS_BYTES, stream, a);
#endif
}
```
